# Optimizing an MI355X kernel written in HIP

```python
import jax, jax.numpy as jnp
from jax import lax
import numpy as np

D_MODEL = 1024
BATCH = 8
SEQ = 4096
DEPTH = 4

N_A = DEPTH // 2
N_B = DEPTH - N_A
PLE_DIM = 256
EPS = 1e-6
ROPE_THETA = 10000.0

A_HEADS = 4
A_DQK = 128
A_DV = 256
A_QK = A_HEADS * A_DQK
A_VW = A_HEADS * A_DV
A_CONV = 4
A_CHUNK = 64
A_COLS = 2 * A_QK + 3 * A_VW + 2 * A_HEADS

B_KV_HEADS = 4
B_HD = 128
DILATED_GROUPS = ((128, 1), (512, 4), (2048, 16))
B_GROUPS = len(DILATED_GROUPS)
B_QW = B_GROUPS * B_KV_HEADS * B_HD
B_VW = B_KV_HEADS * B_HD
B_COLS = B_QW + B_VW
Q_BLOCK = 128

kernel_name = "yoco_mlstm_dilated_swa_ple"


def rms_norm(x, g):
    xf = x.astype(jnp.float32)
    y = xf * lax.rsqrt(jnp.mean(xf * xf, axis=-1, keepdims=True) + EPS)
    return (y * g.astype(jnp.float32)).astype(x.dtype)


def rope_tables(seq, dim):
    inv = ROPE_THETA ** (-jnp.arange(0, dim, 2, dtype=jnp.float32) / dim)
    ang = jnp.arange(seq, dtype=jnp.float32)[:, None] * inv[None, :]
    return jnp.cos(ang), jnp.sin(ang)


def apply_rope(x, cos, sin):
    shape = (1, cos.shape[0]) + (1,) * (x.ndim - 3) + (cos.shape[1],)
    c = cos.reshape(shape)
    s = sin.reshape(shape)
    x1, x2 = jnp.split(x, 2, axis=-1)
    return jnp.concatenate([x1 * c - x2 * s, x2 * c + x1 * s], axis=-1)


def causal_depthwise_conv(x, w):
    K = w.shape[0]
    S = x.shape[1]
    xp = jnp.pad(x, ((0, 0), (K - 1, 0), (0, 0)))
    out = xp[:, 0:S] * w[0]
    for j in range(1, K):
        out = out + xp[:, j:j + S] * w[j]
    return out


def mlstm_chunkwise(q, k, v, i_pre, logf):
    Bsz, S, H, dk = q.shape
    dv = v.shape[-1]
    L = A_CHUNK
    nc = S // L

    def to_chunks(t):
        t = t.reshape((Bsz, nc, L, H) + t.shape[3:])
        return jnp.moveaxis(t, (1, 3), (0, 2))

    causal = jnp.tril(jnp.ones((L, L), dtype=bool))

    def step(carry, inp):
        C, n, m = carry
        qc, kc, vc, ic, fc = inp
        b = jnp.cumsum(fc, axis=-1)
        D = b[..., :, None] - b[..., None, :] + ic[..., None, :]
        D = jnp.where(causal, D, -jnp.inf)
        m_inter = b + m[..., None]
        m_s = jnp.maximum(m_inter, D.max(axis=-1))
        wts = jnp.exp(D - m_s[..., None]) * jnp.einsum('bhsd,bhjd->bhsj', qc, kc)
        inter = jnp.exp(m_inter - m_s)
        num = wts @ vc + inter[..., None] * jnp.einsum('bhsd,bhvd->bhsv', qc, C)
        den = wts.sum(axis=-1) + inter * jnp.einsum('bhsd,bhd->bhs', qc, n)
        h = num / jnp.maximum(jnp.abs(den), jnp.exp(-m_s))[..., None]
        g = b[..., -1:] - b + ic
        m_new = jnp.maximum(b[..., -1] + m, g.max(axis=-1))
        decay = jnp.exp(b[..., -1] + m - m_new)
        wj = jnp.exp(g - m_new[..., None])
        C = decay[..., None, None] * C + jnp.einsum('bhj,bhjv,bhjd->bhvd', wj, vc, kc)
        n = decay[..., None] * n + jnp.einsum('bhj,bhjd->bhd', wj, kc)
        return (C, n, m_new), h

    init = (jnp.zeros((Bsz, H, dv, dk), jnp.float32),
            jnp.zeros((Bsz, H, dk), jnp.float32),
            jnp.zeros((Bsz, H), jnp.float32))
    _, hs = lax.scan(step, init, (to_chunks(q), to_chunks(k), to_chunks(v),
                                  to_chunks(i_pre), to_chunks(logf)))
    return jnp.moveaxis(hs, (0, 2), (1, 3)).reshape(Bsz, S, H, dv)


def mlstm_layer(h, norm_g, w_in, conv_w, b_gate, hnorm_g, w_out):
    Bsz, S, _ = h.shape
    proj = rms_norm(h, norm_g) @ w_in
    qk, v, o, z, gates = jnp.split(
        proj, [2 * A_QK, 2 * A_QK + A_VW, 2 * A_QK + 2 * A_VW, 2 * A_QK + 3 * A_VW], axis=-1)
    qk = jax.nn.silu(causal_depthwise_conv(qk, conv_w)).astype(jnp.float32)
    q, k = jnp.split(qk, 2, axis=-1)
    q = q.reshape(Bsz, S, A_HEADS, A_DQK)
    k = k.reshape(Bsz, S, A_HEADS, A_DQK) * (A_DQK ** -0.5)
    v = v.astype(jnp.float32).reshape(Bsz, S, A_HEADS, A_DV)
    gates = gates.astype(jnp.float32) + b_gate.astype(jnp.float32)
    i_pre, f_pre = jnp.split(gates, 2, axis=-1)
    ht = mlstm_chunkwise(q, k, v, i_pre, jax.nn.log_sigmoid(f_pre))
    ht = jax.nn.sigmoid(o.astype(jnp.float32)).reshape(Bsz, S, A_HEADS, A_DV) * ht
    ht = rms_norm(ht, hnorm_g.reshape(A_HEADS, A_DV))
    y = ht.reshape(Bsz, S, A_VW) * jax.nn.silu(z.astype(jnp.float32))
    return y.astype(h.dtype) @ w_out


def dilated_window_attention(q, k, v, window, dilation):
    Bsz, S, H, hd = q.shape
    r = dilation
    n_back = window // dilation
    s_sub = S // r
    nb = -(-s_sub // Q_BLOCK)
    P = nb * Q_BLOCK

    def to_blocks(t):
        t = t.reshape(Bsz, s_sub, r, H, hd).transpose(0, 2, 3, 1, 4)
        t = jnp.pad(t, ((0, 0), (0, 0), (0, 0), (0, P - s_sub), (0, 0)))
        return t.reshape(Bsz, r, H, nb, Q_BLOCK, hd)

    def with_prev(t):
        prev = jnp.pad(t, ((0, 0), (0, 0), (0, 0), (1, 0), (0, 0), (0, 0)))[:, :, :, :-1]
        return jnp.concatenate([prev, t], axis=4)

    qb = to_blocks(q)
    kw = with_prev(to_blocks(k))
    vw = with_prev(to_blocks(v))
    s = jnp.einsum('brhnqd,brhnkd->brhnqk', qb, kw) * (hd ** -0.5)
    blk = jnp.arange(nb)[:, None, None]
    qi = jnp.arange(Q_BLOCK)[None, :, None]
    kj = jnp.arange(2 * Q_BLOCK)[None, None, :]
    dist = Q_BLOCK + qi - kj
    kpos = (blk - 1) * Q_BLOCK + kj
    mask = (dist >= 0) & (dist <= n_back) & (kpos >= 0)
    s = jnp.where(mask, s, -jnp.inf)
    mx = s.max(axis=-1, keepdims=True)
    e = jnp.exp(s - mx)
    den = e.sum(axis=-1)
    o = jnp.einsum('brhnqk,brhnkd->brhnqd', e, vw) / den[..., None]
    lse = mx[..., 0] + jnp.log(den)
    o = o.reshape(Bsz, r, H, P, hd)[:, :, :, :s_sub].transpose(0, 3, 1, 2, 4).reshape(Bsz, S, H, hd)
    lse = lse.reshape(Bsz, r, H, P)[..., :s_sub].transpose(0, 3, 1, 2).reshape(Bsz, S, H)
    return o, lse


def shared_kv(h, norm_g, w_kv, knorm_g, cos, sin):
    Bsz, S, _ = h.shape
    kv = (rms_norm(h, norm_g) @ w_kv).astype(jnp.float32)
    k, v = jnp.split(kv, 2, axis=-1)
    k = k.reshape(Bsz, S, B_KV_HEADS, B_HD)
    v = v.reshape(Bsz, S, B_KV_HEADS, B_HD)
    k = apply_rope(rms_norm(k, knorm_g), cos, sin)
    return k, v


def dilated_layer(h, k, v, norm_g, w_in, qnorm_g, w_out, cos, sin):
    Bsz, S, _ = h.shape
    proj = rms_norm(h, norm_g) @ w_in
    q, z = jnp.split(proj, [B_QW], axis=-1)
    q = q.astype(jnp.float32).reshape(Bsz, S, B_GROUPS, B_KV_HEADS, B_HD)
    q = apply_rope(rms_norm(q, qnorm_g), cos, sin)
    outs, lses = [], []
    for g, (window, dilation) in enumerate(DILATED_GROUPS):
        o_g, l_g = dilated_window_attention(q[:, :, g], k, v, window, dilation)
        outs.append(o_g)
        lses.append(l_g)
    wts = jax.nn.softmax(jnp.stack(lses, axis=0), axis=0)
    o = jnp.einsum('gbsh,gbshd->bshd', wts, jnp.stack(outs, axis=0))
    y = o.reshape(Bsz, S, B_VW) * jax.nn.silu(z.astype(jnp.float32))
    return y.astype(h.dtype) @ w_out


def ple_add(h, p_l, norm_g, w_gate, w_proj):
    gate = jax.nn.sigmoid((rms_norm(h, norm_g) @ w_gate).astype(jnp.float32))
    return h + ((p_l @ w_proj).astype(jnp.float32) * gate).astype(h.dtype)


def setup_inputs(seed: int = 0) -> dict:
    key = jax.random.key(seed)
    ks = jax.random.split(key, 24)
    nrm = jax.random.normal
    f32 = jnp.float32
    x = nrm(ks[0], (BATCH, SEQ, D_MODEL), f32)
    p = nrm(ks[1], (DEPTH, BATCH, SEQ, PLE_DIM), f32)
    norm_a = 1.0 + 0.05 * nrm(ks[2], (N_A, D_MODEL), f32)
    w_in_a = nrm(ks[3], (N_A, D_MODEL, A_COLS), f32) * D_MODEL ** -0.5
    conv_a = nrm(ks[4], (N_A, A_CONV, 2 * A_QK), f32) * A_CONV ** -0.5
    b_i = 0.1 * nrm(ks[5], (N_A, A_HEADS), f32)
    b_f = jnp.linspace(3.0, 6.0, A_HEADS, dtype=f32)[None, :] + 0.1 * nrm(ks[6], (N_A, A_HEADS), f32)
    b_gate_a = jnp.concatenate([b_i, b_f], axis=-1)
    hnorm_a = 1.0 + 0.05 * nrm(ks[7], (N_A, A_VW), f32)
    w_out_a = nrm(ks[8], (N_A, A_VW, D_MODEL), f32) * A_VW ** -0.5
    norm_kv = 1.0 + 0.05 * nrm(ks[9], (D_MODEL,), f32)
    w_kv = nrm(ks[10], (D_MODEL, 2 * B_VW), f32) * D_MODEL ** -0.5
    knorm = 1.0 + 0.05 * nrm(ks[11], (B_HD,), f32)
    norm_b = 1.0 + 0.05 * nrm(ks[12], (N_B, D_MODEL), f32)
    w_in_b = nrm(ks[13], (N_B, D_MODEL, B_COLS), f32) * D_MODEL ** -0.5
    qnorm_b = 1.0 + 0.05 * nrm(ks[14], (N_B, B_HD), f32)
    w_out_b = nrm(ks[15], (N_B, B_VW, D_MODEL), f32) * B_VW ** -0.5
    ple_norm = 1.0 + 0.05 * nrm(ks[16], (DEPTH, D_MODEL), f32)
    w_ple_gate = nrm(ks[17], (DEPTH, D_MODEL, D_MODEL), f32) * D_MODEL ** -0.5
    w_ple = nrm(ks[18], (DEPTH, PLE_DIM, D_MODEL), f32) * PLE_DIM ** -0.5
    return {"x": x, "p": p, "norm_a": norm_a, "w_in_a": w_in_a, "conv_a": conv_a,
            "b_gate_a": b_gate_a, "hnorm_a": hnorm_a, "w_out_a": w_out_a,
            "norm_kv": norm_kv, "w_kv": w_kv, "knorm": knorm,
            "norm_b": norm_b, "w_in_b": w_in_b, "qnorm_b": qnorm_b, "w_out_b": w_out_b,
            "ple_norm": ple_norm, "w_ple_gate": w_ple_gate, "w_ple": w_ple}


def reference(x, p, norm_a, w_in_a, conv_a, b_gate_a, hnorm_a, w_out_a,
              norm_kv, w_kv, knorm, norm_b, w_in_b, qnorm_b, w_out_b,
              ple_norm, w_ple_gate, w_ple):
    S = x.shape[1]
    cos, sin = rope_tables(S, B_HD)
    h = x
    k_sh = None
    v_sh = None
    for layer in range(DEPTH):
        if layer < N_A:
            h = h + mlstm_layer(h, norm_a[layer], w_in_a[layer], conv_a[layer],
                                b_gate_a[layer], hnorm_a[layer], w_out_a[layer])
        else:
            if layer == N_A:
                k_sh, v_sh = shared_kv(h, norm_kv, w_kv, knorm, cos, sin)
            j = layer - N_A
            h = h + dilated_layer(h, k_sh, v_sh, norm_b[j], w_in_b[j], qnorm_b[j],
                                  w_out_b[j], cos, sin)
        h = ple_add(h, p[layer], ple_norm[layer], w_ple_gate[layer], w_ple[layer])
    return h
```

```cpp
#include <hip/hip_runtime.h>
#include <cstdio>
#include <cstdint>

#define LAS __attribute__((address_space(3)))
#define GAS __attribute__((address_space(1)))
typedef unsigned short bf16_t;
typedef short bf16x8 __attribute__((ext_vector_type(8)));
typedef float f32x4 __attribute__((ext_vector_type(4)));
typedef unsigned u32x4 __attribute__((ext_vector_type(4)));
typedef unsigned u32x2 __attribute__((ext_vector_type(2)));

constexpr int BATCH = 8, SEQ = 4096, T = BATCH * SEQ, D = 1024, DEPTH = 4, PLE = 256;
constexpr int A_COLS = 4104;
constexpr float EPS = 1e-6f;

typedef __bf16 bf16x2_t __attribute__((ext_vector_type(2)));
typedef float f32x2_t __attribute__((ext_vector_type(2)));
__device__ __forceinline__ unsigned cvt_pk_bf16(float lo, float hi) { const f32x2_t v = {lo, hi}; return __builtin_bit_cast(unsigned, __builtin_convertvector(v, bf16x2_t)); }
__device__ __forceinline__ float bf_lo(unsigned w) { return __uint_as_float(w << 16); }
__device__ __forceinline__ float bf_hi(unsigned w) { return __uint_as_float(w & 0xffff0000u); }
__device__ __forceinline__ float bf2f(bf16_t b) { return __uint_as_float(((unsigned)b) << 16); }
__device__ __forceinline__ bf16_t f2bf(float f) { return (bf16_t)(cvt_pk_bf16(f, 0.f) & 0xffffu); }
__device__ __forceinline__ float sigmoidf_(float x) { return 1.f / (1.f + __expf(-x)); }
__device__ __forceinline__ float ssq16_rstd(const float* ssq, int row) {
    const f32x4* p = (const f32x4*)(ssq + (size_t)row * 16);
    const f32x4 a = p[0], b = p[1], c = p[2], d = p[3];
    const float s = ((a.x + a.y) + (a.z + a.w)) + ((b.x + b.y) + (b.z + b.w)) + ((c.x + c.y) + (c.z + c.w)) + ((d.x + d.y) + (d.z + d.w));
    return rsqrtf(s * (1.f / 1024.f) + EPS);
}

constexpr size_t WS_S0_ = (size_t)208 << 20, WS_S1_ = (size_t)272 << 20, WS_S2_ = (size_t)336 << 20, WS_S3_ = (size_t)400 << 20;
namespace pg8 {
#define PG8_LAS __attribute__((address_space(3)))
constexpr int BM = 256, BK = 64, HALF = 128, HTB = HALF * BK * 2, STAGE_BYTES = 8 * HTB, NXCD = 8, WGM = 8;
__host__ __device__ __forceinline__ int lds_byte(int r, int c) { const int st = (r >> 4) * 2 + (c >> 5), rr = r & 15, cc = c & 31, ob = rr * 64 + cc * 2; return st * 1024 + (ob ^ (((ob >> 9) & 1) << 5)); }
__host__ __device__ __forceinline__ void stage_rc(int b, int& R, int& C) { const int st = b / 1024, sb = b % 1024, swz = sb ^ (((sb >> 9) & 1) << 5); R = (st >> 1) * 16 + swz / 64; C = (st & 1) * 32 + (swz % 64) / 2; }
__host__ __device__ __forceinline__ int perm32(int rho) { const int n = rho >> 4, i = rho & 15; return 8 * (i >> 2) + 4 * n + (i & 3); }

struct Unit { int pm, pn; };
struct Gemm { const bf16_t* A; const bf16_t* Bt; int M, N, K; };
struct StaticOrder {
    int nM, nN, nwg, G, c;
    __host__ __device__ void init(int M, int N, int G_, int c_) { nM = M / BM; nN = N / BM; nwg = nM * nN; G = G_; c = c_; }
    __host__ __device__ bool next(int i, Unit& u) const {
        const long L = (long)i * G + c; if (L >= nwg) return false;
        int wgid = (int)L; { const int q = nwg / NXCD, r = nwg % NXCD, xcd = wgid % NXCD, off = wgid / NXCD; wgid = (xcd < r ? xcd * (q + 1) : r * (q + 1) + (xcd - r) * q) + off; }
        const int nig = WGM * nN, gid = wgid / nig, fm = gid * WGM, gsz = (nM - fm) < WGM ? (nM - fm) : WGM;
        u.pm = fm + ((wgid % nig) % gsz); u.pn = (wgid % nig) / gsz; return true;
    }
    __device__ __forceinline__ void a_ready(const Unit&) const {}
    __device__ __forceinline__ void done(const Unit&) const {}
};


struct EpiP {
    static constexpr bool PERM = true, AFTER_DRAIN = false;
    int mode; const float* ssq; unsigned char* ws;
    __device__ __forceinline__ void operator()(const f32x4 (&acc)[2][2][4][2], const Unit& u, int wr, int wc, int fr, int fq) const {
        const int row0 = u.pm * BM + wr * 64 + fr;
        size_t boff; int ldc, colt, act = 0;
        if (mode == 0) { const int ten = u.pn >> 2; boff = WS_S0_ + (size_t)ten * (64u << 20); ldc = 1024; colt = (u.pn & 3) * 256; act = ten == 2 ? 1 : ten == 3 ? 2 : 0; }
        else if (mode == 1) {
            if (u.pn < 6) { boff = WS_S1_; ldc = 1536; colt = u.pn * 256; }
            else if (u.pn < 8) { boff = WS_S3_; ldc = 512; colt = (u.pn - 6) * 256; act = 2; }
            else if (u.pn < 10) { boff = WS_S0_; ldc = 512; colt = (u.pn - 8) * 256; }
            else { boff = WS_S0_ + (32u << 20); ldc = 512; colt = (u.pn - 10) * 256; }
        } else { boff = WS_S1_; ldc = 1024; colt = u.pn * 256; }
        bf16_t* base = (bf16_t*)(ws + boff);
        const int col0 = colt + wc * 32 + 8 * fq;
#pragma unroll
        for (int ai = 0; ai < 2; ++ai)
#pragma unroll
            for (int m = 0; m < 4; ++m) {
                const int row = row0 + ai * HALF + m * 16;
                const float rs = (mode == 2) ? 1.f : ssq16_rstd(ssq, row);
                bf16_t* rowp = base + (size_t)row * ldc + col0;
#pragma unroll
                for (int bj = 0; bj < 2; ++bj) {
                    f32x4 v0 = acc[ai][bj][m][0] * rs, v1 = acc[ai][bj][m][1] * rs;
                    if (act == 1) {
#pragma unroll
                        for (int j = 0; j < 4; ++j) { v0[j] = sigmoidf_(v0[j]); v1[j] = sigmoidf_(v1[j]); }
                    } else if (act == 2) {
#pragma unroll
                        for (int j = 0; j < 4; ++j) { v0[j] = v0[j] * sigmoidf_(v0[j]); v1[j] = v1[j] * sigmoidf_(v1[j]); }
                    }
                    u32x4 w; w.x = cvt_pk_bf16(v0[0], v0[1]); w.y = cvt_pk_bf16(v0[2], v0[3]); w.z = cvt_pk_bf16(v1[0], v1[1]); w.w = cvt_pk_bf16(v1[2], v1[3]);
                    *(u32x4*)(rowp + bj * HALF) = w;
                }
                asm volatile("" ::: "memory");
            }
    }
};
struct EpiF {
    static constexpr bool PERM = false, AFTER_DRAIN = false;
    int mode; const float* hres; float* hout; bf16_t* hb; float* ssq_out; const float* ssq_in; const bf16_t* pp;
    __device__ __forceinline__ void operator()(const f32x4 (&acc)[2][2][4][2], const Unit& u, int wr, int wc, int fr, int fq) const {
        const int row0 = u.pm * BM + wr * 64 + fr, col0 = u.pn * BM + wc * 32 + 4 * fq;
#pragma unroll
        for (int ai = 0; ai < 2; ++ai)
#pragma unroll
            for (int m = 0; m < 4; ++m) {
                const int row = row0 + ai * HALF + m * 16;
                const size_t off = (size_t)row * 1024 + col0;
                float rs = 1.f; if (mode == 1) rs = ssq16_rstd(ssq_in, row);
                float sq = 0.f;
#pragma unroll
                for (int bj = 0; bj < 2; ++bj)
#pragma unroll
                    for (int n = 0; n < 2; ++n) {
                        const size_t o = off + bj * HALF + n * 16;
                        const f32x4 hr = *(const f32x4*)(hres + o);
                        f32x4 v = acc[ai][bj][m][n];
                        if (mode == 1) {
                            const u32x2 pw = *(const u32x2*)(pp + o);
                            v[0] = bf_lo(pw.x) * sigmoidf_(v[0] * rs); v[1] = bf_hi(pw.x) * sigmoidf_(v[1] * rs);
                            v[2] = bf_lo(pw.y) * sigmoidf_(v[2] * rs); v[3] = bf_hi(pw.y) * sigmoidf_(v[3] * rs);
                        }
                        const f32x4 hn = hr + v;
                        *(f32x4*)(hout + o) = hn;
                        u32x2 w; w.x = cvt_pk_bf16(hn[0], hn[1]); w.y = cvt_pk_bf16(hn[2], hn[3]);
                        *(u32x2*)(hb + o) = w;
                        sq += (hn[0] * hn[0] + hn[1] * hn[1]) + (hn[2] * hn[2] + hn[3] * hn[3]);
                    }
                sq += __shfl_xor(sq, 16); sq += __shfl_xor(sq, 32);
                if (fq == 0) ssq_out[(size_t)row * 16 + u.pn * 4 + wc] = sq;
                asm volatile("" ::: "memory");
            }
    }
};

template <class Epi, class Sched, bool ALIGN_EPI = false, bool SP2 = false>
__device__ __forceinline__ void gemm_phase(PG8_LAS unsigned char* lds, const Gemm g, const Sched& S, const Epi& E) {
    int tid = threadIdx.x; asm volatile("" : "+v"(tid));
    const int wid = __builtin_amdgcn_readfirstlane(tid >> 6), lane = tid & 63, wr = wid >> 2, wc = wid & 3, fr = lane & 15, fq = lane >> 4;
    const int K = g.K, nt = K / BK;
    unsigned voffA[2], voffB[2];
#pragma unroll
    for (int i = 0; i < 2; ++i) { int R, C; stage_rc(tid * 16 + i * 8192, R, C); const int Rb = Epi::PERM ? ((R & ~31) + perm32(R & 31)) : R;
        voffA[i] = (unsigned)(R * K + C) * 2u; voffB[i] = (unsigned)(Rb * K + C) * 2u; }
    const size_t kstep = (size_t)(BK * 2);
    const size_t hstep = (size_t)HALF * K * 2;
    const size_t tstep = 2 * hstep;
    const unsigned ldsw = (unsigned)wid * 1024u;
    const int aoff = lds_byte(wr * 64 + fr, fq * 8), boff = lds_byte(wc * 32 + fr, fq * 8);
#define PG8_SA(b, h) (((b) * 2 + (h)) * HTB)
#define PG8_SB(b, h) ((4 + (b) * 2 + (h)) * HTB)
#define PG8_STAGE(bufoff, gbase, voff) do { _Pragma("unroll") for (int _i = 0; _i < 2; ++_i) \
        __builtin_amdgcn_global_load_lds((const unsigned*)((const char*)(gbase) + (voff)[_i]), (PG8_LAS unsigned*)(lds + (bufoff) + ldsw + _i * 8192), 16, 0, 0); } while (0)
#define PG8_LDA(dst, b, h) do { _Pragma("unroll") for (int m = 0; m < 4; ++m) _Pragma("unroll") for (int k = 0; k < 2; ++k) dst[m][k] = *(const PG8_LAS bf16x8*)(lds + PG8_SA(b, h) + aoff + m * 2048 + k * 1024); } while (0)
#define PG8_LDB(dst, b, h) do { _Pragma("unroll") for (int n = 0; n < 2; ++n) _Pragma("unroll") for (int k = 0; k < 2; ++k) dst[n][k] = *(const PG8_LAS bf16x8*)(lds + PG8_SB(b, h) + boff + n * 2048 + k * 1024); } while (0)
#define PG8_MMA(ai, bj, At, Bt) do { __builtin_amdgcn_s_setprio(1); _Pragma("unroll") for (int m = 0; m < 4; ++m) _Pragma("unroll") for (int n = 0; n < 2; ++n) _Pragma("unroll") for (int k = 0; k < 2; ++k) \
        acc[ai][bj][m][n] = __builtin_amdgcn_mfma_f32_16x16x32_bf16(Bt[n][k], At[m][k], acc[ai][bj][m][n], 0, 0, 0); __builtin_amdgcn_s_setprio(0); } while (0)
#define PG8_WAIT_V(n) asm volatile("s_waitcnt vmcnt(" #n ")" ::: "memory")
#define PG8_WAIT_L(n) asm volatile("s_waitcnt lgkmcnt(" #n ")" ::: "memory")
#define PG8_BAR __builtin_amdgcn_s_barrier()
#define PG8_SCHED __builtin_amdgcn_sched_barrier(0)
    Unit cur, nxt; int ui = 0;
    if (!S.next(0, cur)) return;
    f32x4 acc[2][2][4][2];
#pragma unroll
    for (int a = 0; a < 2; ++a)
#pragma unroll
        for (int b = 0; b < 2; ++b)
#pragma unroll
            for (int m = 0; m < 4; ++m)
#pragma unroll
                for (int n = 0; n < 2; ++n) acc[a][b][m][n] = (f32x4){0.f, 0.f, 0.f, 0.f};
    bf16x8 At[4][2], B0[2][2], B1[2][2];
    const char* cA = (const char*)g.A + (size_t)cur.pm * tstep; const char* cB = (const char*)g.Bt + (size_t)cur.pn * tstep;
    S.a_ready(cur);
    if constexpr (SP2) {
        PG8_STAGE(PG8_SB(0, 0), cB, voffB); PG8_STAGE(PG8_SB(0, 1), cB + hstep, voffB); PG8_STAGE(PG8_SA(0, 0), cA, voffA); PG8_STAGE(PG8_SA(0, 1), cA + hstep, voffA);
        if (wr == 1) PG8_BAR;
        PG8_WAIT_V(2); PG8_BAR;
        PG8_STAGE(PG8_SB(1, 0), cB + kstep, voffB); PG8_STAGE(PG8_SA(1, 0), cA + kstep, voffA); PG8_STAGE(PG8_SB(1, 1), cB + hstep + kstep, voffB);
        PG8_WAIT_V(6); PG8_BAR;
    } else {
        PG8_STAGE(PG8_SB(0, 0), cB, voffB); PG8_STAGE(PG8_SA(0, 0), cA, voffA); PG8_STAGE(PG8_SB(0, 1), cB + hstep, voffB); PG8_STAGE(PG8_SA(0, 1), cA + hstep, voffA);
        if (wr == 1) PG8_BAR;
        PG8_WAIT_V(4); PG8_BAR;
        PG8_STAGE(PG8_SB(1, 0), cB + kstep, voffB); PG8_STAGE(PG8_SA(1, 0), cA + kstep, voffA); PG8_STAGE(PG8_SB(1, 1), cB + hstep + kstep, voffB);
        PG8_WAIT_V(6); PG8_BAR;
    }
    for (;;) {
        const bool has_next = S.next(ui + 1, nxt);
        const char* nA = has_next ? (const char*)g.A + (size_t)nxt.pm * tstep : cA; const char* nB = has_next ? (const char*)g.Bt + (size_t)nxt.pn * tstep : cB;
        for (int t = 0; t < nt; t += 2) {
            const bool last = (t == nt - 2);
            const char* a1 = cA + (size_t)(t + 1) * kstep;
            const char* a2 = last ? nA : cA + (size_t)(t + 2) * kstep; const char* b2 = last ? nB : cB + (size_t)(t + 2) * kstep;
            const char* a3 = a2 + kstep; const char* b3 = b2 + kstep;
            if (last && has_next) S.a_ready(nxt);
            if constexpr (SP2) {
            PG8_LDB(B0, 0, 0); PG8_LDB(B1, 0, 1); PG8_SCHED; PG8_LDA(At, 0, 0); PG8_STAGE(PG8_SA(1, 1), a1 + hstep, voffA);
            PG8_WAIT_V(8); PG8_WAIT_L(0); PG8_BAR; PG8_MMA(0, 0, At, B0); PG8_MMA(0, 1, At, B1); PG8_BAR; PG8_SCHED;
            PG8_LDA(At, 0, 1); PG8_STAGE(PG8_SB(0, 0), b2, voffB); PG8_STAGE(PG8_SB(0, 1), b2 + hstep, voffB); PG8_STAGE(PG8_SA(0, 0), a2, voffA);
            PG8_WAIT_V(8); PG8_WAIT_L(0); PG8_BAR; PG8_MMA(1, 0, At, B0); PG8_MMA(1, 1, At, B1); PG8_BAR; PG8_SCHED;
            PG8_LDB(B0, 1, 0); PG8_LDB(B1, 1, 1); PG8_SCHED; PG8_LDA(At, 1, 0); PG8_STAGE(PG8_SA(0, 1), a2 + hstep, voffA);
            PG8_WAIT_V(8); PG8_WAIT_L(0); PG8_BAR; PG8_MMA(0, 0, At, B0); PG8_MMA(0, 1, At, B1); PG8_BAR; PG8_SCHED;
            PG8_LDA(At, 1, 1); PG8_STAGE(PG8_SB(1, 0), b3, voffB); PG8_STAGE(PG8_SB(1, 1), b3 + hstep, voffB); PG8_STAGE(PG8_SA(1, 0), a3, voffA);
            PG8_WAIT_V(8); PG8_WAIT_L(0); PG8_BAR; PG8_MMA(1, 0, At, B0); PG8_MMA(1, 1, At, B1); PG8_BAR; PG8_SCHED;
            } else {
            PG8_LDB(B0, 0, 0); PG8_SCHED; PG8_LDA(At, 0, 0); PG8_STAGE(PG8_SA(1, 1), a1 + hstep, voffA);
            PG8_WAIT_L(8); PG8_BAR; PG8_WAIT_L(0); PG8_MMA(0, 0, At, B0); PG8_BAR; PG8_SCHED;
            PG8_LDB(B1, 0, 1); PG8_STAGE(PG8_SB(0, 0), b2, voffB);
            PG8_BAR; PG8_WAIT_L(0); PG8_MMA(0, 1, At, B1); PG8_BAR;
            PG8_LDA(At, 0, 1); PG8_STAGE(PG8_SA(0, 0), a2, voffA);
            PG8_BAR; PG8_WAIT_L(0); PG8_MMA(1, 0, At, B0); PG8_BAR; PG8_SCHED;
            PG8_STAGE(PG8_SB(0, 1), b2 + hstep, voffB);
            PG8_WAIT_V(6); PG8_BAR; PG8_MMA(1, 1, At, B1); PG8_BAR;
            PG8_LDB(B0, 1, 0); PG8_SCHED; PG8_LDA(At, 1, 0); PG8_STAGE(PG8_SA(0, 1), a2 + hstep, voffA);
            PG8_WAIT_L(8); PG8_BAR; PG8_WAIT_L(0); PG8_MMA(0, 0, At, B0); PG8_BAR; PG8_SCHED;
            PG8_LDB(B1, 1, 1); PG8_STAGE(PG8_SB(1, 0), b3, voffB);
            PG8_BAR; PG8_WAIT_L(0); PG8_MMA(0, 1, At, B1); PG8_BAR;
            PG8_LDA(At, 1, 1); PG8_STAGE(PG8_SA(1, 0), a3, voffA);
            PG8_BAR; PG8_WAIT_L(0); PG8_MMA(1, 0, At, B0); PG8_BAR; PG8_SCHED;
            PG8_STAGE(PG8_SB(1, 1), b3 + hstep, voffB);
            PG8_WAIT_V(6); PG8_BAR; PG8_MMA(1, 1, At, B1); PG8_BAR;
            }
        }
        if constexpr (ALIGN_EPI) { if (wr == 0) PG8_BAR; }
        if constexpr (!Epi::AFTER_DRAIN) { E(acc, cur, wr, wc, fr, fq); S.done(cur); }
        if (!has_next) break;
#pragma unroll
        for (int a = 0; a < 2; ++a)
#pragma unroll
            for (int b = 0; b < 2; ++b)
#pragma unroll
                for (int m = 0; m < 4; ++m)
#pragma unroll
                    for (int n = 0; n < 2; ++n) acc[a][b][m][n] = (f32x4){0.f, 0.f, 0.f, 0.f};
        cur = nxt; cA = nA; cB = nB; ++ui;
        if constexpr (ALIGN_EPI) { if (wr == 1) PG8_BAR; }
    }
    PG8_WAIT_V(0);
    if constexpr (!ALIGN_EPI) { if (wr == 0) PG8_BAR; }
    PG8_BAR;
#undef PG8_SA
#undef PG8_SB
#undef PG8_STAGE
#undef PG8_LDA
#undef PG8_LDB
#undef PG8_MMA
#undef PG8_WAIT_V
#undef PG8_WAIT_L
#undef PG8_BAR
#undef PG8_SCHED
}
}

constexpr size_t MiB = 1u << 20;
constexpr size_t WS_CTL = 0, CTL_ZERO_BYTES = 1 * MiB;
constexpr size_t WS_COS = 2 * MiB, WS_SIN = 3 * MiB;
constexpr size_t WS_WG8 = 4 * MiB;
constexpr size_t WS_GATES = 5 * MiB;
constexpr size_t WS_LSE = 6 * MiB;
constexpr size_t WS_SSQ0 = 8 * MiB, WS_SSQ1 = 10 * MiB;
constexpr size_t WS_SSQH = 12 * MiB;
constexpr size_t WS_WINA = 16 * MiB;
constexpr size_t WS_WOUTA = 32 * MiB;
constexpr size_t WS_WINB0 = 36 * MiB;
constexpr size_t WS_WINB1 = 42 * MiB;
constexpr size_t WS_WOUTB = 46 * MiB;
constexpr size_t WS_WGATE = 48 * MiB;
constexpr size_t WS_WPLE = 56 * MiB;
constexpr size_t WS_HB0 = 64 * MiB, WS_HB1 = 128 * MiB;
constexpr size_t WS_PB = 192 * MiB;
constexpr size_t WS_S0 = WS_S0_, WS_S1 = WS_S1_, WS_S2 = WS_S2_, WS_S3 = WS_S3_, WS_END = 464 * MiB;
constexpr int CW_BAR = 4096;

#define XB_TMO      128
#define XB_XCNT(j)  (256  + 64 * (j))
#define XB_XSUB(j)  (1280 + 64 * (j))
#define XB_XGEN(j)  (2304 + 64 * (j))
#define XB_TOP      3328
#define XB_TOPGEN   3392
#define XCD_BAR_WORDS 3456
#define XB_SPIN_CAP (1u << 18)
__device__ __forceinline__ unsigned xb_ld(unsigned* p)              { return __hip_atomic_load(p, __ATOMIC_RELAXED, __HIP_MEMORY_SCOPE_AGENT); }
__device__ __forceinline__ unsigned xb_add(unsigned* p, unsigned v) { return __hip_atomic_fetch_add(p, v, __ATOMIC_RELAXED, __HIP_MEMORY_SCOPE_AGENT); }
__device__ __forceinline__ unsigned xb_xcc_id() { return (unsigned)__builtin_amdgcn_s_getreg((3 << 11) | 20) & 0xFu; }
#define XB_SPIN(cond, bar) do { unsigned _sp = 0; while (cond) { __builtin_amdgcn_s_sleep(1); \
    if ((++_sp & 255u) == 0u) { if (xb_ld(&(bar)[XB_TMO])) break; if (_sp > XB_SPIN_CAP) { atomicAdd(&(bar)[XB_TMO], 1u); break; } } } } while (0)
struct XcdBarrier { unsigned* bar; unsigned x; volatile LAS unsigned* st; };
__device__ __forceinline__ XcdBarrier xcd_barrier_post(unsigned* bar, volatile LAS unsigned* st) {
    XcdBarrier b; b.bar = bar; b.x = xb_xcc_id(); b.st = st;
    if (threadIdx.x == 0) (void)xb_add(&bar[XB_XCNT(b.x)], 1u);
    return b;
}
__device__ __forceinline__ void xcd_barrier_complete(unsigned* bar, unsigned x, unsigned& nloc, unsigned& nx) {
    const unsigned G = gridDim.x * gridDim.y * gridDim.z;
    unsigned sum, cnt, mine, sp = 0u;
    for (;;) {
        sum = 0u; cnt = 0u; mine = 0u;
#pragma unroll
        for (unsigned j = 0; j < 16; ++j) { const unsigned c = xb_ld(&bar[XB_XCNT(j)]); sum += c; cnt += (c > 0u) ? 1u : 0u; mine = (j == x) ? c : mine; }
        if (sum == G) break;
        __builtin_amdgcn_s_sleep(1);
        if ((++sp & 255u) == 0u) { if (xb_ld(&bar[XB_TMO])) break; if (sp > XB_SPIN_CAP) { atomicAdd(&bar[XB_TMO], 1u); break; } }
    }
    nloc = mine > 0u ? mine : 1u; nx = cnt > 0u ? cnt : 1u;
}
__device__ __forceinline__ void xcd_barrier(const XcdBarrier& b) {
    asm volatile("s_waitcnt vmcnt(0)" ::: "memory");
    __syncthreads();
    if (threadIdx.x == 0) {
        unsigned* bar = b.bar;
        __builtin_amdgcn_s_waitcnt(0);
        unsigned nloc = b.st[0], nx = b.st[1];
        if (nloc == 0u) { xcd_barrier_complete(bar, b.x, nloc, nx); b.st[0] = nloc; b.st[1] = nx; }
        const unsigned old = xb_add(&bar[XB_XSUB(b.x)], 1u);
        const unsigned gen = old / nloc;
        if (old + 1u == (gen + 1u) * nloc) {
            __builtin_amdgcn_fence(__ATOMIC_RELEASE, "agent");
            asm volatile("s_waitcnt vmcnt(0)" ::: "memory");
            const unsigned og = xb_add(&bar[XB_TOP], 1u);
            const unsigned tg = og / nx;
            if (og + 1u == (tg + 1u) * nx) xb_add(&bar[XB_TOPGEN], 1u);
            else XB_SPIN(xb_ld(&bar[XB_TOPGEN]) == tg, bar);
            __builtin_amdgcn_fence(__ATOMIC_ACQUIRE, "agent");
            xb_add(&bar[XB_XGEN(b.x)], 1u);
            asm volatile("s_waitcnt vmcnt(0)" ::: "memory");
        } else {
            XB_SPIN(xb_ld(&bar[XB_XGEN(b.x)]) == gen, bar);
            __builtin_amdgcn_fence(__ATOMIC_ACQUIRE, "agent");
            asm volatile("s_waitcnt vmcnt(0)" ::: "memory");
        }
    }
    __syncthreads();
}

struct Args {
    const float* x; const float* p; const float* norm_a; const float* w_in_a; const float* conv_a; const float* b_gate_a; const float* hnorm_a; const float* w_out_a;
    const float* norm_kv; const float* w_kv; const float* knorm; const float* norm_b; const float* w_in_b; const float* qnorm_b; const float* w_out_b;
    const float* ple_norm; const float* w_ple_gate; const float* w_ple;
    float* out; unsigned char* ws;
};

constexpr int NWAVES = 8, NTHR = 512;
constexpr int RING_OFF = 0;
constexpr int MISC_OFF = 160 * 1024 - 256;
constexpr int LDS_BYTES = 160 * 1024;

#define LDS_WAIT() asm volatile("s_waitcnt lgkmcnt(0)" ::: "memory")

__device__ __forceinline__ void transpose_item(const float* W, int K, int ldw, int ncol0, int nblk, const float* gain, bf16_t* WT, int row_off, LAS float* scr, int item, int lane) {
    const int kb = item / nblk, nb = item % nblk, k0 = 64 * kb, n0 = 32 * nb;
#pragma unroll 8
    for (int i = 0; i < 32; ++i) { const int kk = 2 * i + (lane >> 5); const float gv = gain ? gain[k0 + kk] : 1.f; scr[kk * 33 + (lane & 31)] = W[(size_t)(k0 + kk) * ldw + ncol0 + n0 + (lane & 31)] * gv; }
    LDS_WAIT(); asm volatile("" ::: "memory");
    const int c = lane & 7;
#pragma unroll
    for (int j = 0; j < 4; ++j) { const int n = (lane >> 3) + 8 * j; const LAS float* s = scr + (8 * c) * 33 + n;
        u32x4 o; o.x = cvt_pk_bf16(s[0 * 33], s[1 * 33]); o.y = cvt_pk_bf16(s[2 * 33], s[3 * 33]); o.z = cvt_pk_bf16(s[4 * 33], s[5 * 33]); o.w = cvt_pk_bf16(s[6 * 33], s[7 * 33]);
        *(u32x4*)(WT + (size_t)(row_off + n0 + n) * K + k0 + 8 * c) = o; }
    LDS_WAIT(); asm volatile("" ::: "memory");
}

__device__ __forceinline__ void prologue(const Args& a, LAS unsigned char* lds, int gw, int NGW, int lane, int wave) {
    unsigned char* ws = a.ws;
    LAS float* scr = (LAS float*)(lds + wave * 16384);
    struct TJ { const float* W; int K, ldw, ncol0, ncols; const float* gain; bf16_t* dst; int row_off; };
    int it = gw;
    for (int job = 0; job < 17; ++job) {
        TJ j;
        if (job < 2)       j = TJ{a.w_in_a + (size_t)job * 1024 * A_COLS, 1024, A_COLS, 0, 4096, a.norm_a + job * 1024, (bf16_t*)(ws + WS_WINA) + (size_t)job * 4096 * 1024, 0};
        else if (job < 4)  j = TJ{a.w_out_a + (size_t)(job - 2) * 1024 * 1024, 1024, 1024, 0, 1024, a.hnorm_a + (job - 2) * 1024, (bf16_t*)(ws + WS_WOUTA) + (size_t)(job - 2) * 1024 * 1024, 0};
        else if (job == 4) j = TJ{a.w_in_b, 1024, 2048, 0, 2048, a.norm_b, (bf16_t*)(ws + WS_WINB0), 0};
        else if (job == 5) j = TJ{a.w_in_b + (size_t)1024 * 2048, 1024, 2048, 0, 2048, a.norm_b + 1024, (bf16_t*)(ws + WS_WINB1), 0};
        else if (job == 6) j = TJ{a.w_kv, 1024, 1024, 0, 1024, a.norm_kv, (bf16_t*)(ws + WS_WINB0), 2048};
        else if (job < 9)  j = TJ{a.w_out_b + (size_t)(job - 7) * 512 * 1024, 512, 1024, 0, 1024, nullptr, (bf16_t*)(ws + WS_WOUTB) + (size_t)(job - 7) * 1024 * 512, 0};
        else if (job < 13) j = TJ{a.w_ple_gate + (size_t)(job - 9) * 1024 * 1024, 1024, 1024, 0, 1024, a.ple_norm + (job - 9) * 1024, (bf16_t*)(ws + WS_WGATE) + (size_t)(job - 9) * 1024 * 1024, 0};
        else               j = TJ{a.w_ple + (size_t)(job - 13) * 256 * 1024, 256, 1024, 0, 1024, nullptr, (bf16_t*)(ws + WS_WPLE) + (size_t)(job - 13) * 1024 * 256, 0};
        const int nblk = j.ncols / 32, nitems = (j.K / 64) * nblk;
        for (; it < nitems; it += NGW) transpose_item(j.W, j.K, j.ldw, j.ncol0, nblk, j.gain, j.dst, j.row_off, scr, it, lane);
        it -= nitems;
    }
    {
        bf16_t* HB = (bf16_t*)(ws + WS_HB0); float* SSQ = (float*)(ws + WS_SSQ0);
        for (int m = gw; m < T; m += NGW) {
            const f32x4* xr = (const f32x4*)(a.x + (size_t)m * D) + lane;
            f32x4 v[4]; float s = 0.f;
#pragma unroll
            for (int jj = 0; jj < 4; ++jj) { v[jj] = xr[64 * jj]; s += (v[jj].x * v[jj].x + v[jj].y * v[jj].y) + (v[jj].z * v[jj].z + v[jj].w * v[jj].w); }
#pragma unroll
            for (int o = 1; o < 64; o <<= 1) s += __shfl_xor(s, o);
            u32x2* o8 = (u32x2*)(HB + (size_t)m * D) + lane;
#pragma unroll
            for (int jj = 0; jj < 4; ++jj) { u32x2 w; w.x = cvt_pk_bf16(v[jj].x, v[jj].y); w.y = cvt_pk_bf16(v[jj].z, v[jj].w); o8[64 * jj] = w; }
            if (lane < 16) SSQ[(size_t)m * 16 + lane] = lane == 0 ? s : 0.f;
        }
    }
    {
        float* COS = (float*)(ws + WS_COS); float* SIN = (float*)(ws + WS_SIN);
        for (int i = gw * 64 + lane; i < SEQ * 64; i += NGW * 64) {
            const int pos = i >> 6, fi = i & 63;
            const double inv = exp(-(double)fi * (9.210340371976184 / 64.0));
            const double ang = (double)pos * inv;
            COS[i] = (float)cos(ang); SIN[i] = (float)sin(ang);
        }
    }
    {
        float* WG8 = (float*)(ws + WS_WG8);
        for (int i = gw * 64 + lane; i < 2 * 1024 * 8; i += NGW * 64) {
            const int l = i >> 13, k = (i >> 3) & 1023, jj = i & 7;
            WG8[i] = a.w_in_a[(size_t)l * 1024 * A_COLS + (size_t)k * A_COLS + 4096 + jj] * a.norm_a[l * 1024 + k];
        }
    }
}

__device__ __forceinline__ void convert_p(const Args& a, int layer, int gtid, int NGT) {
    const f32x4* src = (const f32x4*)(a.p + (size_t)layer * T * PLE);
    u32x4* dst = (u32x4*)(a.ws + WS_PB);
    for (int i = gtid; i < T * PLE / 8; i += NGT) {
        const f32x4 v0 = src[2 * i], v1 = src[2 * i + 1];
        u32x4 w; w.x = cvt_pk_bf16(v0.x, v0.y); w.y = cvt_pk_bf16(v0.z, v0.w); w.z = cvt_pk_bf16(v1.x, v1.y); w.w = cvt_pk_bf16(v1.z, v1.w);
        dst[i] = w;
    }
}

__device__ __forceinline__ void gates_job(const Args& a, int layer, const bf16_t* HB, const float* SSQ, int gw, int NGW, int lane) {
    const float* WG8 = (const float*)(a.ws + WS_WG8) + (size_t)layer * 1024 * 8;
    float* GATES = (float*)(a.ws + WS_GATES);
    for (int t0 = gw * 8; t0 < T; t0 += NGW * 8) {
        float acc[8][8];
#pragma unroll
        for (int tt = 0; tt < 8; ++tt)
#pragma unroll
            for (int j = 0; j < 8; ++j) acc[tt][j] = 0.f;
        for (int kc = 0; kc < 16; ++kc) {
            const int k = kc * 64 + lane;
            const f32x4 w0 = *(const f32x4*)(WG8 + k * 8), w1 = *(const f32x4*)(WG8 + k * 8 + 4);
#pragma unroll
            for (int tt = 0; tt < 8; ++tt) {
                const float hv = bf2f(HB[(size_t)(t0 + tt) * D + k]);
                acc[tt][0] += hv * w0.x; acc[tt][1] += hv * w0.y; acc[tt][2] += hv * w0.z; acc[tt][3] += hv * w0.w;
                acc[tt][4] += hv * w1.x; acc[tt][5] += hv * w1.y; acc[tt][6] += hv * w1.z; acc[tt][7] += hv * w1.w;
            }
        }
        float mine = 0.f;
#pragma unroll
        for (int tt = 0; tt < 8; ++tt)
#pragma unroll
            for (int j = 0; j < 8; ++j) {
                float v = acc[tt][j];
#pragma unroll
                for (int o = 1; o < 64; o <<= 1) v += __shfl_xor(v, o);
                if (lane == tt * 8 + j) mine = v;
            }
        const int tt = lane >> 3, j = lane & 7;
        const float rs = ssq16_rstd(SSQ, t0 + tt);
        GATES[(size_t)(t0 + tt) * 8 + j] = mine * rs + a.b_gate_a[layer * 8 + j];
    }
}

namespace scan {
constexpr int QS = 0, KS = 17408, KTS = 34816, VTS = 53248, WS_ = 57856, CS = 67072, HS = 84480, GA = 92928;
constexpr int QSTR = 272, TSTR = 144;
constexpr int O_GA = 0, O_GM = 64, O_GW = 128, O_GI = 192, O_GF = 256, O_RS = 320, O_QN = 448, O_NV = 512;

__device__ __forceinline__ void phase(const Args& a, LAS unsigned char* lds, int layer, int G) {
    int tid = threadIdx.x; asm volatile("" : "+v"(tid));
    const int w = __builtin_amdgcn_readfirstlane(tid >> 6), lane = tid & 63, grp = lane >> 4, ql = lane & 15;
    unsigned char* ws = a.ws;
    const bf16_t* QKb = (const bf16_t*)(ws + WS_S0); const bf16_t* Vb = (const bf16_t*)(ws + WS_S1);
    bf16_t* OGb = (bf16_t*)(ws + WS_S2); const bf16_t* SZb = (const bf16_t*)(ws + WS_S3);
    const float* GATES = (const float*)(ws + WS_GATES); float* SSQH = (float*)(ws + WS_SSQH);
    LAS float* ga = (LAS float*)(lds + GA);
    for (int item = blockIdx.x; item < 256; item += G) {
        const int xx = item & 7, kk = item >> 3, bh = xx * 4 + (kk >> 3), s = kk & 7, b = bh >> 2, h = bh & 3;
        const size_t rowbase = (size_t)b * SEQ;
        const int cg = tid & 31, ts = tid >> 5;
        const int ch0 = (cg < 16) ? (h * 128 + 8 * cg) : (512 + h * 128 + 8 * (cg - 16));
        float cw[4][8];
#pragma unroll
        for (int j = 0; j < 4; ++j)
#pragma unroll
            for (int e = 0; e < 8; ++e) cw[j][e] = a.conv_a[(size_t)layer * 4 * 1024 + j * 1024 + ch0 + e];
        const int tokv = (tid >> 2) & 63, c4 = tid & 3;
        const int vcol = h * 256 + s * 32 + 8 * c4;
        for (int i = tid; i < 2 * 32 * 136 / 2; i += NTHR) ((LAS unsigned*)(lds + CS))[i] = 0u;
        if (tid < 128) ga[O_NV + tid] = 0.f;
        f32x4 Cacc[2] = {(f32x4){0.f, 0.f, 0.f, 0.f}, (f32x4){0.f, 0.f, 0.f, 0.f}};
        float mprev = 0.f;
        u32x4 raw[7]; u32x4 vraw = (u32x4){0u, 0u, 0u, 0u}, ograw = vraw, szraw = vraw; float gi = 0.f, gf = 0.f;
        {
#pragma unroll
            for (int rr = 0; rr < 7; ++rr) { const int t = 4 * ts - 3 + rr; raw[rr] = (t >= 0) ? *(const u32x4*)(QKb + (rowbase + t) * 1024 + ch0) : (u32x4){0u, 0u, 0u, 0u}; }
            if (tid < 256) vraw = *(const u32x4*)(Vb + (rowbase + tokv) * 1024 + vcol);
            gi = GATES[(rowbase + lane) * 8 + h]; gf = GATES[(rowbase + lane) * 8 + 4 + h];
        }
        __syncthreads();
        for (int c = 0; c < 64; ++c) {
            const int t0 = c * 64, cur = c & 1, nxt = cur ^ 1;
            float decay;
            {
                const float lf = fminf(gf, 0.f) - log1pf(expf(-fabsf(gf)));
                float bc = lf;
#pragma unroll
                for (int o = 1; o < 64; o <<= 1) { const float t = __shfl_up(bc, o); if (lane >= o) bc += t; }
                const float av = gi - bc;
                float pm = av;
#pragma unroll
                for (int o = 1; o < 64; o <<= 1) { const float t = __shfl_up(pm, o); if (lane >= o) pm = fmaxf(pm, t); }
                const float Mv = fmaxf(mprev, pm);
                const float blast = __shfl(bc, 63), Mlast = __shfl(Mv, 63);
                decay = expf(mprev - Mlast);
                if (w == 0) { ga[O_GA + lane] = av; ga[O_GM + lane] = Mv; ga[O_GW + lane] = expf(av - Mlast); ga[O_GI + lane] = expf(mprev - Mv); ga[O_GF + lane] = expf(-(bc + Mv)); }
                mprev = blast + Mlast;
            }
            {
                float xv[7][8];
#pragma unroll
                for (int rr = 0; rr < 7; ++rr) { xv[rr][0] = bf_lo(raw[rr].x); xv[rr][1] = bf_hi(raw[rr].x); xv[rr][2] = bf_lo(raw[rr].y); xv[rr][3] = bf_hi(raw[rr].y);
                    xv[rr][4] = bf_lo(raw[rr].z); xv[rr][5] = bf_hi(raw[rr].z); xv[rr][6] = bf_lo(raw[rr].w); xv[rr][7] = bf_hi(raw[rr].w); }
                float yv[4][8];
#pragma unroll
                for (int q = 0; q < 4; ++q)
#pragma unroll
                    for (int e = 0; e < 8; ++e) {
                        float y = cw[0][e] * xv[q][e] + cw[1][e] * xv[q + 1][e] + cw[2][e] * xv[q + 2][e] + cw[3][e] * xv[q + 3][e];
                        y = y * sigmoidf_(y);
                        if (cg >= 16) y *= 0.08838834764831845f;
                        yv[q][e] = y;
                    }
                if (cg < 16) {
#pragma unroll
                    for (int q = 0; q < 4; ++q) { u32x4 o; o.x = cvt_pk_bf16(yv[q][0], yv[q][1]); o.y = cvt_pk_bf16(yv[q][2], yv[q][3]); o.z = cvt_pk_bf16(yv[q][4], yv[q][5]); o.w = cvt_pk_bf16(yv[q][6], yv[q][7]);
                        *(LAS u32x4*)(lds + QS + (4 * ts + q) * QSTR + cg * 16) = o; }
                } else {
#pragma unroll
                    for (int q = 0; q < 4; ++q) { u32x4 o; o.x = cvt_pk_bf16(yv[q][0], yv[q][1]); o.y = cvt_pk_bf16(yv[q][2], yv[q][3]); o.z = cvt_pk_bf16(yv[q][4], yv[q][5]); o.w = cvt_pk_bf16(yv[q][6], yv[q][7]);
                        *(LAS u32x4*)(lds + KS + (4 * ts + q) * QSTR + (cg - 16) * 16) = o; }
#pragma unroll
                    for (int e = 0; e < 8; ++e) { u32x2 o; o.x = cvt_pk_bf16(yv[0][e], yv[1][e]); o.y = cvt_pk_bf16(yv[2][e], yv[3][e]);
                        *(LAS u32x2*)(lds + KTS + (8 * (cg - 16) + e) * TSTR + (4 * ts) * 2) = o; }
                }
                if (tid < 256) {
                    const unsigned vw[4] = {vraw.x, vraw.y, vraw.z, vraw.w};
#pragma unroll
                    for (int e = 0; e < 4; ++e) {
                        *(LAS bf16_t*)(lds + VTS + (8 * c4 + 2 * e) * TSTR + tokv * 2) = (bf16_t)(vw[e] & 0xffffu);
                        *(LAS bf16_t*)(lds + VTS + (8 * c4 + 2 * e + 1) * TSTR + tokv * 2) = (bf16_t)(vw[e] >> 16);
                    }
                }
            }
            if (c > 0 && tid < 256) {
                const LAS float* hs = (const LAS float*)(lds + HS) + tokv * 33 + 8 * c4;
                const unsigned ow[4] = {ograw.x, ograw.y, ograw.z, ograw.w}, zw[4] = {szraw.x, szraw.y, szraw.z, szraw.w};
                float sq = 0.f; unsigned outw[4];
#pragma unroll
                for (int e = 0; e < 4; ++e) {
                    const float g0 = bf_lo(ow[e]) * hs[2 * e], g1 = bf_hi(ow[e]) * hs[2 * e + 1];
                    sq += g0 * g0 + g1 * g1;
                    outw[e] = cvt_pk_bf16(g0 * bf_lo(zw[e]), g1 * bf_hi(zw[e]));
                }
                sq += __shfl_xor(sq, 1); sq += __shfl_xor(sq, 2);
                const size_t row = rowbase + (t0 - 64) + tokv;
                *(u32x4*)(OGb + row * 1024 + vcol) = (u32x4){outw[0], outw[1], outw[2], outw[3]};
                if (c4 == 0) SSQH[row * 32 + h * 8 + s] = sq;
            }
            if (tid < 256) { const size_t row = rowbase + t0 + tokv; ograw = *(const u32x4*)(OGb + row * 1024 + vcol); szraw = *(const u32x4*)(SZb + row * 1024 + vcol); }
            if (c < 63) {
#pragma unroll
                for (int rr = 0; rr < 7; ++rr) { const size_t t = rowbase + t0 + 64 + 4 * ts - 3 + rr; raw[rr] = *(const u32x4*)(QKb + t * 1024 + ch0); }
                if (tid < 256) vraw = *(const u32x4*)(Vb + (rowbase + t0 + 64 + tokv) * 1024 + vcol);
                gi = GATES[(rowbase + t0 + 64 + lane) * 8 + h]; gf = GATES[(rowbase + t0 + 64 + lane) * 8 + 4 + h];
            }
            __syncthreads();
            const int ti = w >> 1;
            bf16x8 Aq[4];
#pragma unroll
            for (int ks = 0; ks < 4; ++ks) Aq[ks] = *(const LAS bf16x8*)(lds + QS + (16 * ti + ql) * QSTR + (32 * ks + 8 * grp) * 2);
            {
                float rsum[4] = {0.f, 0.f, 0.f, 0.f};
                float gMi[4];
#pragma unroll
                for (int ii = 0; ii < 4; ++ii) gMi[ii] = ga[O_GM + 16 * ti + 4 * grp + ii];
#pragma unroll
                for (int tjj = 0; tjj < 2; ++tjj) {
                    const int tj = (w & 1) * 2 + tjj;
                    f32x4 sacc = (f32x4){0.f, 0.f, 0.f, 0.f};
#pragma unroll
                    for (int ks = 0; ks < 4; ++ks) {
                        const bf16x8 Bk = *(const LAS bf16x8*)(lds + KS + (16 * tj + ql) * QSTR + (32 * ks + 8 * grp) * 2);
                        sacc = __builtin_amdgcn_mfma_f32_16x16x32_bf16(Aq[ks], Bk, sacc, 0, 0, 0);
                    }
                    const int j = 16 * tj + ql; const float gaj = ga[O_GA + j];
#pragma unroll
                    for (int ii = 0; ii < 4; ++ii) {
                        const int i = 16 * ti + 4 * grp + ii;
                        const float wv = (j <= i) ? __expf(gaj - gMi[ii]) * sacc[ii] : 0.f;
                        rsum[ii] += wv;
                        *(LAS bf16_t*)(lds + WS_ + i * TSTR + j * 2) = f2bf(wv);
                    }
                }
#pragma unroll
                for (int ii = 0; ii < 4; ++ii) { float v = rsum[ii]; v += __shfl_xor(v, 1); v += __shfl_xor(v, 2); v += __shfl_xor(v, 4); v += __shfl_xor(v, 8);
                    if (ql == 0) ga[O_RS + (16 * ti + 4 * grp + ii) * 2 + (w & 1)] = v; }
            }
            {
                const int i = tid >> 3, part = tid & 7;
                const u32x4 q0 = *(const LAS u32x4*)(lds + QS + i * QSTR + part * 32), q1 = *(const LAS u32x4*)(lds + QS + i * QSTR + part * 32 + 16);
                const LAS float* nv = ga + O_NV + part * 16;
                float sacc = bf_lo(q0.x) * nv[0] + bf_hi(q0.x) * nv[1] + bf_lo(q0.y) * nv[2] + bf_hi(q0.y) * nv[3] + bf_lo(q0.z) * nv[4] + bf_hi(q0.z) * nv[5] + bf_lo(q0.w) * nv[6] + bf_hi(q0.w) * nv[7]
                           + bf_lo(q1.x) * nv[8] + bf_hi(q1.x) * nv[9] + bf_lo(q1.y) * nv[10] + bf_hi(q1.y) * nv[11] + bf_lo(q1.z) * nv[12] + bf_hi(q1.z) * nv[13] + bf_lo(q1.w) * nv[14] + bf_hi(q1.w) * nv[15];
                sacc += __shfl_xor(sacc, 1); sacc += __shfl_xor(sacc, 2); sacc += __shfl_xor(sacc, 4);
                if (part == 0) ga[O_QN + i] = sacc;
            }
            __syncthreads();
            {
                const int tn = w & 1;
                f32x4 acc1 = (f32x4){0.f, 0.f, 0.f, 0.f}, acc2 = acc1;
#pragma unroll
                for (int ks = 0; ks < 2; ++ks) {
                    const bf16x8 Aw = *(const LAS bf16x8*)(lds + WS_ + (16 * ti + ql) * TSTR + (32 * ks + 8 * grp) * 2);
                    const bf16x8 Bv = *(const LAS bf16x8*)(lds + VTS + (16 * tn + ql) * TSTR + (32 * ks + 8 * grp) * 2);
                    acc1 = __builtin_amdgcn_mfma_f32_16x16x32_bf16(Aw, Bv, acc1, 0, 0, 0);
                }
#pragma unroll
                for (int ks = 0; ks < 4; ++ks) {
                    const bf16x8 Bc = *(const LAS bf16x8*)(lds + CS + cur * 8704 + (16 * tn + ql) * QSTR + (32 * ks + 8 * grp) * 2);
                    acc2 = __builtin_amdgcn_mfma_f32_16x16x32_bf16(Aq[ks], Bc, acc2, 0, 0, 0);
                }
#pragma unroll
                for (int ii = 0; ii < 4; ++ii) {
                    const int i = 16 * ti + 4 * grp + ii;
                    const float inter = ga[O_GI + i];
                    const float num = acc1[ii] + inter * acc2[ii];
                    const float den = ga[O_RS + 2 * i] + ga[O_RS + 2 * i + 1] + inter * ga[O_QN + i];
                    ((LAS float*)(lds + HS))[i * 33 + 16 * tn + ql] = num / fmaxf(fabsf(den), ga[O_GF + i]);
                }
            }
            {
                Cacc[0] = Cacc[0] * decay; Cacc[1] = Cacc[1] * decay;
#pragma unroll
                for (int ks = 0; ks < 2; ++ks) {
                    const bf16x8 Bk = *(const LAS bf16x8*)(lds + KTS + (16 * w + ql) * TSTR + (32 * ks + 8 * grp) * 2);
                    const f32x4 g0 = *(const LAS f32x4*)(ga + O_GW + 32 * ks + 8 * grp), g1 = *(const LAS f32x4*)(ga + O_GW + 32 * ks + 8 * grp + 4);
#pragma unroll
                    for (int vt = 0; vt < 2; ++vt) {
                        const u32x4 vv = *(const LAS u32x4*)(lds + VTS + (16 * vt + ql) * TSTR + (32 * ks + 8 * grp) * 2);
                        u32x4 aw; aw.x = cvt_pk_bf16(bf_lo(vv.x) * g0.x, bf_hi(vv.x) * g0.y); aw.y = cvt_pk_bf16(bf_lo(vv.y) * g0.z, bf_hi(vv.y) * g0.w);
                        aw.z = cvt_pk_bf16(bf_lo(vv.z) * g1.x, bf_hi(vv.z) * g1.y); aw.w = cvt_pk_bf16(bf_lo(vv.w) * g1.z, bf_hi(vv.w) * g1.w);
                        Cacc[vt] = __builtin_amdgcn_mfma_f32_16x16x32_bf16(__builtin_bit_cast(bf16x8, aw), Bk, Cacc[vt], 0, 0, 0);
                    }
                }
#pragma unroll
                for (int vt = 0; vt < 2; ++vt)
#pragma unroll
                    for (int ii = 0; ii < 4; ++ii) *(LAS bf16_t*)(lds + CS + nxt * 8704 + (16 * vt + 4 * grp + ii) * QSTR + (16 * w + ql) * 2) = f2bf(Cacc[vt][ii]);
                const int d = tid >> 2, part = tid & 3;
                const u32x4 k0 = *(const LAS u32x4*)(lds + KTS + d * TSTR + part * 32), k1 = *(const LAS u32x4*)(lds + KTS + d * TSTR + part * 32 + 16);
                const LAS float* gw = ga + O_GW + part * 16;
                float sacc = bf_lo(k0.x) * gw[0] + bf_hi(k0.x) * gw[1] + bf_lo(k0.y) * gw[2] + bf_hi(k0.y) * gw[3] + bf_lo(k0.z) * gw[4] + bf_hi(k0.z) * gw[5] + bf_lo(k0.w) * gw[6] + bf_hi(k0.w) * gw[7]
                           + bf_lo(k1.x) * gw[8] + bf_hi(k1.x) * gw[9] + bf_lo(k1.y) * gw[10] + bf_hi(k1.y) * gw[11] + bf_lo(k1.z) * gw[12] + bf_hi(k1.z) * gw[13] + bf_lo(k1.w) * gw[14] + bf_hi(k1.w) * gw[15];
                sacc += __shfl_xor(sacc, 1); sacc += __shfl_xor(sacc, 2);
                if (part == 0) ga[O_NV + d] = decay * ga[O_NV + d] + sacc;
            }
            __syncthreads();
        }
        if (tid < 256) {
            const LAS float* hs = (const LAS float*)(lds + HS) + tokv * 33 + 8 * c4;
            const unsigned ow[4] = {ograw.x, ograw.y, ograw.z, ograw.w}, zw[4] = {szraw.x, szraw.y, szraw.z, szraw.w};
            float sq = 0.f; unsigned outw[4];
#pragma unroll
            for (int e = 0; e < 4; ++e) {
                const float g0 = bf_lo(ow[e]) * hs[2 * e], g1 = bf_hi(ow[e]) * hs[2 * e + 1];
                sq += g0 * g0 + g1 * g1;
                outw[e] = cvt_pk_bf16(g0 * bf_lo(zw[e]), g1 * bf_hi(zw[e]));
            }
            sq += __shfl_xor(sq, 1); sq += __shfl_xor(sq, 2);
            const size_t row = rowbase + 63 * 64 + tokv;
            *(u32x4*)(OGb + row * 1024 + vcol) = (u32x4){outw[0], outw[1], outw[2], outw[3]};
            if (c4 == 0) SSQH[row * 32 + h * 8 + s] = sq;
        }
        __syncthreads();
    }
}
}

__device__ __forceinline__ void mlstm_norm_phase(const Args& a, int gtid, int NGT) {
    const u32x4* A = (const u32x4*)(a.ws + WS_S2); u32x4* Y = (u32x4*)(a.ws + WS_S0); const float* SSQH = (const float*)(a.ws + WS_SSQH);
    for (int i = gtid; i < T * 128; i += NGT) {
        const int t = i >> 7, c8 = i & 127, h = c8 >> 5;
        const f32x4 s0 = *(const f32x4*)(SSQH + (size_t)t * 32 + h * 8), s1 = *(const f32x4*)(SSQH + (size_t)t * 32 + h * 8 + 4);
        const float rs = rsqrtf((((s0.x + s0.y) + (s0.z + s0.w)) + ((s1.x + s1.y) + (s1.z + s1.w))) * (1.f / 256.f) + EPS);
        const u32x4 v = A[i]; u32x4 o;
        o.x = cvt_pk_bf16(bf_lo(v.x) * rs, bf_hi(v.x) * rs); o.y = cvt_pk_bf16(bf_lo(v.y) * rs, bf_hi(v.y) * rs);
        o.z = cvt_pk_bf16(bf_lo(v.z) * rs, bf_hi(v.z) * rs); o.w = cvt_pk_bf16(bf_lo(v.w) * rs, bf_hi(v.w) * rs);
        Y[i] = o;
    }
}

namespace attn {
constexpr int KS = 0, VTS = 69632;
constexpr int KSTR = 272, VSTR = 528;
__device__ __forceinline__ void phase(const Args& a, LAS unsigned char* lds, int jl, int G) {
    int tid = threadIdx.x; asm volatile("" : "+v"(tid));
    const int w = __builtin_amdgcn_readfirstlane(tid >> 6), lane = tid & 63, grp = lane >> 4, ql = lane & 15;
    unsigned char* ws = a.ws;
    const bf16_t* Kb = (const bf16_t*)(ws + WS_S0); const bf16_t* Vb = (const bf16_t*)(ws + WS_S0 + 32 * MiB);
    bf16_t* Qb = (bf16_t*)(ws + WS_S1);
    float* LSE = (float*)(ws + WS_LSE);
    const float* COS = (const float*)(ws + WS_COS); const float* SIN = (const float*)(ws + WS_SIN);
    const float* qg = a.qnorm_b + jl * 128; const float* kg = a.knorm;
    for (int item = blockIdx.x; item < 3072; item += G) {
        const int bhh = item / 96, gi = item % 96, b = bhh >> 2, head = bhh & 3;
        int g, res, blk, r;
        if (gi < 32) { g = 0; res = 0; blk = gi; r = 1; } else if (gi < 64) { g = 1; res = (gi - 32) >> 3; blk = (gi - 32) & 7; r = 4; } else { g = 2; res = (gi - 64) >> 1; blk = (gi - 64) & 1; r = 16; }
        const size_t rowbase = (size_t)b * SEQ;
        {
            const int kj = tid >> 1, half = tid & 1;
            const int u = (blk - 1) * 128 + kj;
            LAS unsigned char* krow = lds + KS + kj * KSTR;
            if (u >= 0) {
                const int pos = u * r + res;
                const bf16_t* src = Kb + (rowbase + pos) * 512 + head * 128;
                u32x4 lo[4], hi[4];
#pragma unroll
                for (int c = 0; c < 4; ++c) { lo[c] = *(const u32x4*)(src + (4 * half + c) * 8); hi[c] = *(const u32x4*)(src + (4 * half + c + 8) * 8); }
                float sq = 0.f;
#pragma unroll
                for (int c = 0; c < 4; ++c) {
                    const unsigned lw[4] = {lo[c].x, lo[c].y, lo[c].z, lo[c].w}, hw[4] = {hi[c].x, hi[c].y, hi[c].z, hi[c].w};
#pragma unroll
                    for (int e = 0; e < 4; ++e) { const float a0 = bf_lo(lw[e]), a1 = bf_hi(lw[e]), b0 = bf_lo(hw[e]), b1 = bf_hi(hw[e]); sq += (a0 * a0 + a1 * a1) + (b0 * b0 + b1 * b1); }
                }
                sq += __shfl_xor(sq, 1);
                const float rs = rsqrtf(sq * (1.f / 128.f) + EPS);
#pragma unroll
                for (int c = 0; c < 4; ++c) {
                    const int d0 = (4 * half + c) * 8;
                    const unsigned lw[4] = {lo[c].x, lo[c].y, lo[c].z, lo[c].w}, hw[4] = {hi[c].x, hi[c].y, hi[c].z, hi[c].w};
                    const f32x4 c0 = *(const f32x4*)(COS + pos * 64 + d0), c1 = *(const f32x4*)(COS + pos * 64 + d0 + 4), s0 = *(const f32x4*)(SIN + pos * 64 + d0), s1 = *(const f32x4*)(SIN + pos * 64 + d0 + 4);
                    const f32x4 g0 = *(const f32x4*)(kg + d0), g1 = *(const f32x4*)(kg + d0 + 4), g2 = *(const f32x4*)(kg + 64 + d0), g3 = *(const f32x4*)(kg + 64 + d0 + 4);
                    const float cc[8] = {c0.x, c0.y, c0.z, c0.w, c1.x, c1.y, c1.z, c1.w}, ss[8] = {s0.x, s0.y, s0.z, s0.w, s1.x, s1.y, s1.z, s1.w};
                    const float gl[8] = {g0.x, g0.y, g0.z, g0.w, g1.x, g1.y, g1.z, g1.w}, gh[8] = {g2.x, g2.y, g2.z, g2.w, g3.x, g3.y, g3.z, g3.w};
                    float o1[8], o2[8];
#pragma unroll
                    for (int e = 0; e < 4; ++e) {
                        const float x1a = bf_lo(lw[e]) * rs * gl[2 * e], x1b = bf_hi(lw[e]) * rs * gl[2 * e + 1], x2a = bf_lo(hw[e]) * rs * gh[2 * e], x2b = bf_hi(hw[e]) * rs * gh[2 * e + 1];
                        o1[2 * e] = x1a * cc[2 * e] - x2a * ss[2 * e]; o1[2 * e + 1] = x1b * cc[2 * e + 1] - x2b * ss[2 * e + 1];
                        o2[2 * e] = x2a * cc[2 * e] + x1a * ss[2 * e]; o2[2 * e + 1] = x2b * cc[2 * e + 1] + x1b * ss[2 * e + 1];
                    }
                    u32x4 w1, w2; w1.x = cvt_pk_bf16(o1[0], o1[1]); w1.y = cvt_pk_bf16(o1[2], o1[3]); w1.z = cvt_pk_bf16(o1[4], o1[5]); w1.w = cvt_pk_bf16(o1[6], o1[7]);
                    w2.x = cvt_pk_bf16(o2[0], o2[1]); w2.y = cvt_pk_bf16(o2[2], o2[3]); w2.z = cvt_pk_bf16(o2[4], o2[5]); w2.w = cvt_pk_bf16(o2[6], o2[7]);
                    *(LAS u32x4*)(krow + d0 * 2) = w1; *(LAS u32x4*)(krow + (64 + d0) * 2) = w2;
                }
            } else {
#pragma unroll
                for (int c = 0; c < 4; ++c) { *(LAS u32x4*)(krow + (4 * half + c) * 16) = (u32x4){0u, 0u, 0u, 0u}; *(LAS u32x4*)(krow + (4 * half + c + 8) * 16) = (u32x4){0u, 0u, 0u, 0u}; }
            }
            const bf16_t* vsrc = Vb + (rowbase + (u >= 0 ? (size_t)(u * r + res) : 0)) * 512 + head * 128 + 64 * half;
#pragma unroll
            for (int c = 0; c < 8; ++c) {
                u32x4 vv = (u32x4){0u, 0u, 0u, 0u};
                if (u >= 0) vv = *(const u32x4*)(vsrc + c * 8);
                const unsigned vw[4] = {vv.x, vv.y, vv.z, vv.w};
#pragma unroll
                for (int e = 0; e < 4; ++e) {
                    *(LAS bf16_t*)(lds + VTS + (64 * half + 8 * c + 2 * e) * VSTR + kj * 2) = (bf16_t)(vw[e] & 0xffffu);
                    *(LAS bf16_t*)(lds + VTS + (64 * half + 8 * c + 2 * e + 1) * VSTR + kj * 2) = (bf16_t)(vw[e] >> 16);
                }
            }
        }
        const int qi = 16 * w + ql;
        const int posq = (128 * blk + qi) * r + res;
        bf16_t* qrow = Qb + (rowbase + posq) * 1536 + (g * 4 + head) * 128;
        bf16x8 Qf[4];
        {
            u32x4 qr[4];
#pragma unroll
            for (int ks = 0; ks < 4; ++ks) qr[ks] = *(const u32x4*)(qrow + 32 * ks + 8 * grp);
            float qv[4][8]; float sq = 0.f;
#pragma unroll
            for (int ks = 0; ks < 4; ++ks) { qv[ks][0] = bf_lo(qr[ks].x); qv[ks][1] = bf_hi(qr[ks].x); qv[ks][2] = bf_lo(qr[ks].y); qv[ks][3] = bf_hi(qr[ks].y); qv[ks][4] = bf_lo(qr[ks].z); qv[ks][5] = bf_hi(qr[ks].z); qv[ks][6] = bf_lo(qr[ks].w); qv[ks][7] = bf_hi(qr[ks].w);
#pragma unroll
                for (int e = 0; e < 8; ++e) sq += qv[ks][e] * qv[ks][e]; }
            sq += __shfl_xor(sq, 16); sq += __shfl_xor(sq, 32);
            const float rs = rsqrtf(sq * (1.f / 128.f) + EPS);
#pragma unroll
            for (int ks = 0; ks < 2; ++ks) {
                const int d0 = 32 * ks + 8 * grp;
                const f32x4 c0 = *(const f32x4*)(COS + posq * 64 + d0), c1 = *(const f32x4*)(COS + posq * 64 + d0 + 4), s0 = *(const f32x4*)(SIN + posq * 64 + d0), s1 = *(const f32x4*)(SIN + posq * 64 + d0 + 4);
                const f32x4 g0 = *(const f32x4*)(qg + d0), g1 = *(const f32x4*)(qg + d0 + 4), g2 = *(const f32x4*)(qg + 64 + d0), g3 = *(const f32x4*)(qg + 64 + d0 + 4);
                const float cc[8] = {c0.x, c0.y, c0.z, c0.w, c1.x, c1.y, c1.z, c1.w}, ss[8] = {s0.x, s0.y, s0.z, s0.w, s1.x, s1.y, s1.z, s1.w};
                const float gl[8] = {g0.x, g0.y, g0.z, g0.w, g1.x, g1.y, g1.z, g1.w}, gh[8] = {g2.x, g2.y, g2.z, g2.w, g3.x, g3.y, g3.z, g3.w};
                float o1[8], o2[8];
#pragma unroll
                for (int e = 0; e < 8; ++e) { const float x1 = qv[ks][e] * rs * gl[e], x2 = qv[ks + 2][e] * rs * gh[e]; o1[e] = x1 * cc[e] - x2 * ss[e]; o2[e] = x2 * cc[e] + x1 * ss[e]; }
                u32x4 w1, w2; w1.x = cvt_pk_bf16(o1[0], o1[1]); w1.y = cvt_pk_bf16(o1[2], o1[3]); w1.z = cvt_pk_bf16(o1[4], o1[5]); w1.w = cvt_pk_bf16(o1[6], o1[7]);
                w2.x = cvt_pk_bf16(o2[0], o2[1]); w2.y = cvt_pk_bf16(o2[2], o2[3]); w2.z = cvt_pk_bf16(o2[4], o2[5]); w2.w = cvt_pk_bf16(o2[6], o2[7]);
                Qf[ks] = __builtin_bit_cast(bf16x8, w1); Qf[ks + 2] = __builtin_bit_cast(bf16x8, w2);
            }
        }
        __syncthreads();
        f32x4 sc[9];
        float mx = -__builtin_inff();
#pragma unroll
        for (int tt = 0; tt < 9; ++tt) {
            f32x4 acc = (f32x4){0.f, 0.f, 0.f, 0.f};
#pragma unroll
            for (int ks = 0; ks < 4; ++ks) {
                const bf16x8 Ak = *(const LAS bf16x8*)(lds + KS + (16 * (w + tt) + ql) * KSTR + (32 * ks + 8 * grp) * 2);
                acc = __builtin_amdgcn_mfma_f32_16x16x32_bf16(Ak, Qf[ks], acc, 0, 0, 0);
            }
#pragma unroll
            for (int ii = 0; ii < 4; ++ii) {
                const int dist = 128 + ql - 16 * tt - 4 * grp - ii;
                const int kj = 16 * (w + tt) + 4 * grp + ii;
                const bool valid = (dist >= 0) && (dist <= 128) && (blk > 0 || kj >= 128);
                const float v = valid ? acc[ii] * 0.08838834764831845f : -__builtin_inff();
                sc[tt][ii] = v; mx = fmaxf(mx, v);
            }
        }
        mx = fmaxf(mx, __shfl_xor(mx, 16)); mx = fmaxf(mx, __shfl_xor(mx, 32));
        float den = 0.f;
#pragma unroll
        for (int tt = 0; tt < 9; ++tt)
#pragma unroll
            for (int ii = 0; ii < 4; ++ii) { const float e = __expf(sc[tt][ii] - mx); sc[tt][ii] = e; den += e; }
        den += __shfl_xor(den, 16); den += __shfl_xor(den, 32);
        f32x4 oacc[8];
#pragma unroll
        for (int dt = 0; dt < 8; ++dt) oacc[dt] = (f32x4){0.f, 0.f, 0.f, 0.f};
#pragma unroll
        for (int pp = 0; pp < 5; ++pp) {
            u32x4 pw;
            pw.x = cvt_pk_bf16(sc[2 * pp][0], sc[2 * pp][1]); pw.y = cvt_pk_bf16(sc[2 * pp][2], sc[2 * pp][3]);
            if (pp < 4) { pw.z = cvt_pk_bf16(sc[2 * pp + 1][0], sc[2 * pp + 1][1]); pw.w = cvt_pk_bf16(sc[2 * pp + 1][2], sc[2 * pp + 1][3]); } else { pw.z = 0u; pw.w = 0u; }
            const bf16x8 Pf = __builtin_bit_cast(bf16x8, pw);
            const int k0 = 16 * (w + 2 * pp) + 4 * grp;
            int kt1 = w + 2 * pp + 1; kt1 = kt1 > 15 ? 15 : kt1;
            const int k1 = 16 * kt1 + 4 * grp;
#pragma unroll
            for (int dt = 0; dt < 8; ++dt) {
                const u32x2 lo = *(const LAS u32x2*)(lds + VTS + (16 * dt + ql) * VSTR + k0 * 2), hi = *(const LAS u32x2*)(lds + VTS + (16 * dt + ql) * VSTR + k1 * 2);
                const u32x4 av = (u32x4){lo.x, lo.y, hi.x, hi.y};
                oacc[dt] = __builtin_amdgcn_mfma_f32_16x16x32_bf16(__builtin_bit_cast(bf16x8, av), Pf, oacc[dt], 0, 0, 0);
            }
        }
        const float inv = 1.f / den;
#pragma unroll
        for (int dt = 0; dt < 8; ++dt) { u32x2 o; o.x = cvt_pk_bf16(oacc[dt][0] * inv, oacc[dt][1] * inv); o.y = cvt_pk_bf16(oacc[dt][2] * inv, oacc[dt][3] * inv);
            *(u32x2*)(qrow + 16 * dt + 4 * grp) = o; }
        if (grp == 0) LSE[((size_t)g * T + rowbase + posq) * 4 + head] = mx + __logf(den);
        __syncthreads();
    }
}
}

__device__ __forceinline__ void attn_combine_phase(const Args& a, int gtid, int NGT) {
    const bf16_t* O = (const bf16_t*)(a.ws + WS_S1); const u32x4* SZ = (const u32x4*)(a.ws + WS_S3); u32x4* Y = (u32x4*)(a.ws + WS_S3 + 32 * MiB);
    const float* LSE = (const float*)(a.ws + WS_LSE);
    for (int i = gtid; i < T * 64; i += NGT) {
        const int t = i >> 6, c8 = i & 63, h = c8 >> 4;
        const float l0 = LSE[((size_t)0 * T + t) * 4 + h], l1 = LSE[((size_t)1 * T + t) * 4 + h], l2 = LSE[((size_t)2 * T + t) * 4 + h];
        const float m = fmaxf(l0, fmaxf(l1, l2));
        float w0 = __expf(l0 - m), w1 = __expf(l1 - m), w2 = __expf(l2 - m);
        const float inv = 1.f / (w0 + w1 + w2); w0 *= inv; w1 *= inv; w2 *= inv;
        const u32x4 o0 = *(const u32x4*)(O + (size_t)t * 1536 + c8 * 8), o1 = *(const u32x4*)(O + (size_t)t * 1536 + 512 + c8 * 8), o2 = *(const u32x4*)(O + (size_t)t * 1536 + 1024 + c8 * 8);
        const u32x4 z = SZ[i];
        const unsigned a0[4] = {o0.x, o0.y, o0.z, o0.w}, a1[4] = {o1.x, o1.y, o1.z, o1.w}, a2[4] = {o2.x, o2.y, o2.z, o2.w}, zz[4] = {z.x, z.y, z.z, z.w};
        unsigned ow[4];
#pragma unroll
        for (int e = 0; e < 4; ++e) {
            const float lo = (w0 * bf_lo(a0[e]) + w1 * bf_lo(a1[e]) + w2 * bf_lo(a2[e])) * bf_lo(zz[e]);
            const float hi = (w0 * bf_hi(a0[e]) + w1 * bf_hi(a1[e]) + w2 * bf_hi(a2[e])) * bf_hi(zz[e]);
            ow[e] = cvt_pk_bf16(lo, hi);
        }
        Y[i] = (u32x4){ow[0], ow[1], ow[2], ow[3]};
    }
}

typedef const __attribute__((address_space(4))) Args* KArgs;
#define LOADARGS(name) Args name; { KArgs _k = kp; asm volatile("" : "+s"(_k)); name = *_k; }

__global__ void __launch_bounds__(NTHR, 2) fwd_megakernel(Args args_unused) {
#if defined(__HIP_DEVICE_COMPILE__)
    extern __shared__ __attribute__((aligned(16))) unsigned char lds_raw[];
    LAS unsigned char* lds = (LAS unsigned char*)lds_raw;
    KArgs kp = (KArgs)__builtin_amdgcn_kernarg_segment_ptr();
    const int G = gridDim.x, bx = blockIdx.x;
    {
        const int tid = threadIdx.x;
        volatile LAS unsigned* MISC0 = (volatile LAS unsigned*)(lds + MISC_OFF);
        if (tid < 64) MISC0[tid] = 0u;
        __syncthreads();
    }
    { LOADARGS(a); (void)xcd_barrier_post((unsigned*)(a.ws + WS_CTL) + CW_BAR, (volatile LAS unsigned*)(lds + MISC_OFF) + 8); }
#define GRID_BAR() do { LOADARGS(a_); XcdBarrier b_; b_.bar = (unsigned*)(a_.ws + WS_CTL) + CW_BAR; b_.x = xb_xcc_id(); b_.st = (volatile LAS unsigned*)(lds + MISC_OFF) + 8; xcd_barrier(b_); } while (0)
#define THREAD_IDS() int tid = threadIdx.x; asm volatile("" : "+v"(tid)); const int lane = tid & 63, wave = __builtin_amdgcn_readfirstlane(tid >> 6); \
    const int vcu = (G % 8 == 0) ? (bx % 8) * (G / 8) + bx / 8 : bx; const int gw = vcu * NWAVES + wave, NGW = G * NWAVES, gtid = vcu * NTHR + tid, NGT = G * NTHR; (void)lane; (void)gw; (void)NGW; (void)gtid; (void)NGT;

    { LOADARGS(a); THREAD_IDS(); prologue(a, lds, gw, NGW, lane, wave); }
    GRID_BAR();

#pragma nounroll
    for (int layer = 0; layer < DEPTH; ++layer) {
        if (layer < 2) {
            {
                LOADARGS(a); unsigned char* ws = a.ws;
                pg8::Gemm g{(const bf16_t*)(ws + WS_HB0), (const bf16_t*)(ws + WS_WINA) + (size_t)layer * 4096 * 1024, T, 4096, 1024};
                pg8::StaticOrder S; S.init(T, 4096, G, bx);
                pg8::EpiP E{0, (const float*)(ws + WS_SSQ0), ws};
                pg8::gemm_phase<pg8::EpiP, pg8::StaticOrder, true, true>(lds + RING_OFF, g, S, E);
            }
            { LOADARGS(a); THREAD_IDS(); gates_job(a, layer, (const bf16_t*)(a.ws + WS_HB0), (const float*)(a.ws + WS_SSQ0), gw, NGW, lane); }
            { LOADARGS(a); THREAD_IDS(); convert_p(a, layer, gtid, NGT); }
            GRID_BAR();
            { LOADARGS(a); scan::phase(a, lds, layer, G); }
            GRID_BAR();
            { LOADARGS(a); THREAD_IDS(); mlstm_norm_phase(a, gtid, NGT); }
            GRID_BAR();
            {
                LOADARGS(a); unsigned char* ws = a.ws;
                const float* hres = (layer == 0) ? a.x : a.out;
                pg8::Gemm g{(const bf16_t*)(ws + WS_S0), (const bf16_t*)(ws + WS_WOUTA) + (size_t)layer * 1024 * 1024, T, 1024, 1024};
                pg8::StaticOrder S; S.init(T, 1024, G, bx);
                pg8::EpiF E{0, hres, a.out, (bf16_t*)(ws + WS_HB1), (float*)(ws + WS_SSQ1), nullptr, nullptr};
                pg8::gemm_phase<pg8::EpiF, pg8::StaticOrder, true, true>(lds + RING_OFF, g, S, E);
            }
        } else {
            const int jl = layer - 2;
            {
                LOADARGS(a); unsigned char* ws = a.ws;
                const int N = (jl == 0) ? 3072 : 2048;
                pg8::Gemm g{(const bf16_t*)(ws + WS_HB0), (const bf16_t*)(ws + (jl == 0 ? WS_WINB0 : WS_WINB1)), T, N, 1024};
                pg8::StaticOrder S; S.init(T, N, G, bx);
                pg8::EpiP E{1, (const float*)(ws + WS_SSQ0), ws};
                pg8::gemm_phase<pg8::EpiP, pg8::StaticOrder, true, true>(lds + RING_OFF, g, S, E);
            }
            { LOADARGS(a); THREAD_IDS(); convert_p(a, layer, gtid, NGT); }
            GRID_BAR();
            { LOADARGS(a); attn::phase(a, lds, jl, G); }
            GRID_BAR();
            { LOADARGS(a); THREAD_IDS(); attn_combine_phase(a, gtid, NGT); }
            GRID_BAR();
            {
                LOADARGS(a); unsigned char* ws = a.ws;
                pg8::Gemm g{(const bf16_t*)(ws + WS_S3 + 32 * MiB), (const bf16_t*)(ws + WS_WOUTB) + (size_t)jl * 1024 * 512, T, 1024, 512};
                pg8::StaticOrder S; S.init(T, 1024, G, bx);
                pg8::EpiF E{0, a.out, a.out, (bf16_t*)(ws + WS_HB1), (float*)(ws + WS_SSQ1), nullptr, nullptr};
                pg8::gemm_phase<pg8::EpiF, pg8::StaticOrder, true, true>(lds + RING_OFF, g, S, E);
            }
        }
        {
            LOADARGS(a); unsigned char* ws = a.ws;
            pg8::Gemm g2{(const bf16_t*)(ws + WS_PB), (const bf16_t*)(ws + WS_WPLE) + (size_t)layer * 1024 * 256, T, 1024, 256};
            pg8::StaticOrder S; S.init(T, 1024, G, bx);
            pg8::EpiP E2{2, nullptr, ws};
            pg8::gemm_phase<pg8::EpiP, pg8::StaticOrder, true, true>(lds + RING_OFF, g2, S, E2);
        }
        GRID_BAR();
        {
            LOADARGS(a); unsigned char* ws = a.ws;
            pg8::Gemm g{(const bf16_t*)(ws + WS_HB1), (const bf16_t*)(ws + WS_WGATE) + (size_t)layer * 1024 * 1024, T, 1024, 1024};
            pg8::StaticOrder S; S.init(T, 1024, G, bx);
            pg8::EpiF E{1, a.out, a.out, (bf16_t*)(ws + WS_HB0), (float*)(ws + WS_SSQ0), (const float*)(ws + WS_SSQ1), (const bf16_t*)(ws + WS_S1)};
            pg8::gemm_phase<pg8::EpiF, pg8::StaticOrder, true, true>(lds + RING_OFF, g, S, E);
        }
        if (layer < DEPTH - 1) GRID_BAR();
    }
#endif
}

extern "C" void kernel_launch(void* const* d_in, const int* in_sizes, int n_in, void* d_out, int out_size, void* d_ws, size_t ws_size, hipStream_t stream) {
    static int grid = 0;
    if (grid == 0) {
        if (n_in != 18 || in_sizes[0] != T * D || out_size != T * D || ws_size < WS_END) { fprintf(stderr, "kernel_launch: unexpected shapes (n_in %d, in0 %d, out %d, ws %zu)\n", n_in, n_in > 0 ? in_sizes[0] : -1, out_size, ws_size); grid = -1; return; }
        int dev = 0, cus = 0, per_cu = 0;
        if (hipGetDevice(&dev) != hipSuccess || hipDeviceGetAttribute(&cus, hipDeviceAttributeMultiprocessorCount, dev) != hipSuccess) { fprintf(stderr, "kernel_launch: device query failed\n"); grid = -1; return; }
        if (hipFuncSetAttribute((const void*)fwd_megakernel, hipFuncAttributeMaxDynamicSharedMemorySize, LDS_BYTES) != hipSuccess) { fprintf(stderr, "kernel_launch: hipFuncSetAttribute failed\n"); grid = -1; return; }
        if (hipOccupancyMaxActiveBlocksPerMultiprocessor(&per_cu, (const void*)fwd_megakernel, NTHR, LDS_BYTES) != hipSuccess || per_cu < 1)
            fprintf(stderr, "kernel_launch: note: occupancy query reports %d workgroups per CU\n", per_cu);
        (void)hipGetLastError();
        grid = cus;
        if (grid > 256) grid = 256;
    }
    if (grid < 0) return;
    if (hipMemsetAsync((char*)d_ws + WS_CTL, 0, CTL_ZERO_BYTES, stream) != hipSuccess) { fprintf(stderr, "kernel_launch: memset failed\n"); return; }
    Args a{};
    a.x = (const float*)d_in[0]; a.p = (const float*)d_in[1]; a.norm_a = (const float*)d_in[2]; a.w_in_a = (const float*)d_in[3]; a.conv_a = (const float*)d_in[4];
    a.b_gate_a = (const float*)d_in[5]; a.hnorm_a = (const float*)d_in[6]; a.w_out_a = (const float*)d_in[7]; a.norm_kv = (const float*)d_in[8]; a.w_kv = (const float*)d_in[9];
    a.knorm = (const float*)d_in[10]; a.norm_b = (const float*)d_in[11]; a.w_in_b = (const float*)d_in[12]; a.qnorm_b = (const float*)d_in[13]; a.w_out_b = (const float*)d_in[14];
    a.ple_norm = (const float*)d_in[15]; a.w_ple_gate = (const float*)d_in[16]; a.w_ple = (const float*)d_in[17];
    a.out = (float*)d_out; a.ws = (unsigned char*)d_ws;
    hipLaunchKernelGGL(fwd_megakernel, dim3(grid), dim3(NTHR), LDS_BYTES, stream, a);
    const hipError_t le = hipPeekAtLastError();
    if (le != hipSuccess) fprintf(stderr, "kernel_launch: launch failed: %s\n", hipGetErrorName(le));
}
```

```cpp
#include <hip/hip_runtime.h>
#include <cstdio>
#include <cstdint>

#define LAS __attribute__((address_space(3)))
#define GAS __attribute__((address_space(1)))
typedef unsigned short bf16_t;
typedef short bf16x8 __attribute__((ext_vector_type(8)));
typedef float f32x4 __attribute__((ext_vector_type(4)));
typedef unsigned u32x4 __attribute__((ext_vector_type(4)));
typedef unsigned u32x2 __attribute__((ext_vector_type(2)));

constexpr int BATCH = 8, SEQ = 4096, T = BATCH * SEQ, D = 1024, DEPTH = 4, PLE = 256;
constexpr int A_COLS = 4104;
constexpr float EPS = 1e-6f;

typedef __bf16 bf16x2_t __attribute__((ext_vector_type(2)));
typedef float f32x2_t __attribute__((ext_vector_type(2)));
__device__ __forceinline__ unsigned cvt_pk_bf16(float lo, float hi) { const f32x2_t v = {lo, hi}; return __builtin_bit_cast(unsigned, __builtin_convertvector(v, bf16x2_t)); }
__device__ __forceinline__ float bf_lo(unsigned w) { return __uint_as_float(w << 16); }
__device__ __forceinline__ float bf_hi(unsigned w) { return __uint_as_float(w & 0xffff0000u); }
__device__ __forceinline__ float bf2f(bf16_t b) { return __uint_as_float(((unsigned)b) << 16); }
__device__ __forceinline__ bf16_t f2bf(float f) { return (bf16_t)(cvt_pk_bf16(f, 0.f) & 0xffffu); }
__device__ __forceinline__ float sigmoidf_(float x) { return 1.f / (1.f + __expf(-x)); }
__device__ __forceinline__ float ssq16_rstd(const float* ssq, int row) {
    const f32x4* p = (const f32x4*)(ssq + (size_t)row * 16);
    const f32x4 a = p[0], b = p[1], c = p[2], d = p[3];
    const float s = ((a.x + a.y) + (a.z + a.w)) + ((b.x + b.y) + (b.z + b.w)) + ((c.x + c.y) + (c.z + c.w)) + ((d.x + d.y) + (d.z + d.w));
    return rsqrtf(s * (1.f / 1024.f) + EPS);
}

constexpr size_t WS_S0_ = (size_t)208 << 20, WS_S1_ = (size_t)272 << 20, WS_S2_ = (size_t)336 << 20, WS_S3_ = (size_t)400 << 20;
namespace pg8 {
#define PG8_LAS __attribute__((address_space(3)))
constexpr int BM = 256, BK = 64, HALF = 128, HTB = HALF * BK * 2, STAGE_BYTES = 8 * HTB, NXCD = 8, WGM = 8;
__host__ __device__ __forceinline__ int lds_byte(int r, int c) { const int st = (r >> 4) * 2 + (c >> 5), rr = r & 15, cc = c & 31, ob = rr * 64 + cc * 2; return st * 1024 + (ob ^ (((ob >> 9) & 1) << 5)); }
__host__ __device__ __forceinline__ void stage_rc(int b, int& R, int& C) { const int st = b / 1024, sb = b % 1024, swz = sb ^ (((sb >> 9) & 1) << 5); R = (st >> 1) * 16 + swz / 64; C = (st & 1) * 32 + (swz % 64) / 2; }
__host__ __device__ __forceinline__ int perm32(int rho) { const int n = rho >> 4, i = rho & 15; return 8 * (i >> 2) + 4 * n + (i & 3); }

struct Unit { int pm, pn; };
struct Gemm { const bf16_t* A; const bf16_t* Bt; int M, N, K; };
struct StaticOrder {
    int nM, nN, nwg, G, c;
    __host__ __device__ void init(int M, int N, int G_, int c_) { nM = M / BM; nN = N / BM; nwg = nM * nN; G = G_; c = c_; }
    __host__ __device__ bool next(int i, Unit& u) const {
        const long L = (long)i * G + c; if (L >= nwg) return false;
        int wgid = (int)L; { const int q = nwg / NXCD, r = nwg % NXCD, xcd = wgid % NXCD, off = wgid / NXCD; wgid = (xcd < r ? xcd * (q + 1) : r * (q + 1) + (xcd - r) * q) + off; }
        const int nig = WGM * nN, gid = wgid / nig, fm = gid * WGM, gsz = (nM - fm) < WGM ? (nM - fm) : WGM;
        u.pm = fm + ((wgid % nig) % gsz); u.pn = (wgid % nig) / gsz; return true;
    }
    __device__ __forceinline__ void a_ready(const Unit&) const {}
    __device__ __forceinline__ void done(const Unit&) const {}
};


struct EpiP {
    static constexpr bool PERM = true, AFTER_DRAIN = false;
    int mode; const float* ssq; unsigned char* ws;
    __device__ __forceinline__ void operator()(const f32x4 (&acc)[2][2][4][2], const Unit& u, int wr, int wc, int fr, int fq) const {
        const int row0 = u.pm * BM + wr * 64 + fr;
        size_t boff; int ldc, colt, act = 0;
        if (mode == 0) { const int ten = u.pn >> 2; boff = WS_S0_ + (size_t)ten * (64u << 20); ldc = 1024; colt = (u.pn & 3) * 256; act = ten == 2 ? 1 : ten == 3 ? 2 : 0; }
        else if (mode == 1) {
            if (u.pn < 6) { boff = WS_S1_; ldc = 1536; colt = u.pn * 256; }
            else if (u.pn < 8) { boff = WS_S3_; ldc = 512; colt = (u.pn - 6) * 256; act = 2; }
            else if (u.pn < 10) { boff = WS_S0_; ldc = 512; colt = (u.pn - 8) * 256; }
            else { boff = WS_S0_ + (32u << 20); ldc = 512; colt = (u.pn - 10) * 256; }
        } else { boff = WS_S1_; ldc = 1024; colt = u.pn * 256; }
        bf16_t* base = (bf16_t*)(ws + boff);
        const int col0 = colt + wc * 32 + 8 * fq;
#pragma unroll
        for (int ai = 0; ai < 2; ++ai)
#pragma unroll
            for (int m = 0; m < 4; ++m) {
                const int row = row0 + ai * HALF + m * 16;
                const float rs = (mode == 2) ? 1.f : ssq16_rstd(ssq, row);
                bf16_t* rowp = base + (size_t)row * ldc + col0;
#pragma unroll
                for (int bj = 0; bj < 2; ++bj) {
                    f32x4 v0 = acc[ai][bj][m][0] * rs, v1 = acc[ai][bj][m][1] * rs;
                    if (act == 1) {
#pragma unroll
                        for (int j = 0; j < 4; ++j) { v0[j] = sigmoidf_(v0[j]); v1[j] = sigmoidf_(v1[j]); }
                    } else if (act == 2) {
#pragma unroll
                        for (int j = 0; j < 4; ++j) { v0[j] = v0[j] * sigmoidf_(v0[j]); v1[j] = v1[j] * sigmoidf_(v1[j]); }
                    }
                    u32x4 w; w.x = cvt_pk_bf16(v0[0], v0[1]); w.y = cvt_pk_bf16(v0[2], v0[3]); w.z = cvt_pk_bf16(v1[0], v1[1]); w.w = cvt_pk_bf16(v1[2], v1[3]);
                    *(u32x4*)(rowp + bj * HALF) = w;
                }
                asm volatile("" ::: "memory");
            }
    }
};
struct EpiF {
    static constexpr bool PERM = false, AFTER_DRAIN = false;
    int mode; const bf16_t* hres; bf16_t* hb; float* ssq_out; const float* ssq_in; const bf16_t* pp; float* fout;
    __device__ __forceinline__ void operator()(const f32x4 (&acc)[2][2][4][2], const Unit& u, int wr, int wc, int fr, int fq) const {
        const int row0 = u.pm * BM + wr * 64 + fr, col0 = u.pn * BM + wc * 32 + 4 * fq;
#pragma unroll
        for (int ai = 0; ai < 2; ++ai)
#pragma unroll
            for (int m = 0; m < 4; ++m) {
                const int row = row0 + ai * HALF + m * 16;
                const size_t off = (size_t)row * 1024 + col0;
                float rs = 1.f; if (mode == 1) rs = ssq16_rstd(ssq_in, row);
                float sq = 0.f;
#pragma unroll
                for (int bj = 0; bj < 2; ++bj)
#pragma unroll
                    for (int n = 0; n < 2; ++n) {
                        const size_t o = off + bj * HALF + n * 16;
                        const u32x2 hw = *(const u32x2*)(hres + o);
                        f32x4 v = acc[ai][bj][m][n];
                        if (mode == 1) {
                            const u32x2 pw = *(const u32x2*)(pp + o);
                            v[0] = bf_lo(pw.x) * sigmoidf_(v[0] * rs); v[1] = bf_hi(pw.x) * sigmoidf_(v[1] * rs);
                            v[2] = bf_lo(pw.y) * sigmoidf_(v[2] * rs); v[3] = bf_hi(pw.y) * sigmoidf_(v[3] * rs);
                        }
                        f32x4 hn; hn[0] = bf_lo(hw.x) + v[0]; hn[1] = bf_hi(hw.x) + v[1]; hn[2] = bf_lo(hw.y) + v[2]; hn[3] = bf_hi(hw.y) + v[3];
                        if (fout) *(f32x4*)(fout + o) = hn;
                        else { u32x2 w; w.x = cvt_pk_bf16(hn[0], hn[1]); w.y = cvt_pk_bf16(hn[2], hn[3]); *(u32x2*)(hb + o) = w; }
                        sq += (hn[0] * hn[0] + hn[1] * hn[1]) + (hn[2] * hn[2] + hn[3] * hn[3]);
                    }
                sq += __shfl_xor(sq, 16); sq += __shfl_xor(sq, 32);
                if (fq == 0 && !fout) ssq_out[(size_t)row * 16 + u.pn * 4 + wc] = sq;
                asm volatile("" ::: "memory");
            }
    }
};

template <class Epi, class Sched, bool ALIGN_EPI = false, bool SP2 = false>
__device__ __forceinline__ void gemm_phase(PG8_LAS unsigned char* lds, const Gemm g, const Sched& S, const Epi& E) {
    int tid = threadIdx.x; asm volatile("" : "+v"(tid));
    const int wid = __builtin_amdgcn_readfirstlane(tid >> 6), lane = tid & 63, wr = wid >> 2, wc = wid & 3, fr = lane & 15, fq = lane >> 4;
    const int K = g.K, nt = K / BK;
    unsigned voffA[2], voffB[2];
#pragma unroll
    for (int i = 0; i < 2; ++i) { int R, C; stage_rc(tid * 16 + i * 8192, R, C); const int Rb = Epi::PERM ? ((R & ~31) + perm32(R & 31)) : R;
        voffA[i] = (unsigned)(R * K + C) * 2u; voffB[i] = (unsigned)(Rb * K + C) * 2u; }
    const size_t kstep = (size_t)(BK * 2);
    const size_t hstep = (size_t)HALF * K * 2;
    const size_t tstep = 2 * hstep;
    const unsigned ldsw = (unsigned)wid * 1024u;
    const int aoff = lds_byte(wr * 64 + fr, fq * 8), boff = lds_byte(wc * 32 + fr, fq * 8);
#define PG8_SA(b, h) (((b) * 2 + (h)) * HTB)
#define PG8_SB(b, h) ((4 + (b) * 2 + (h)) * HTB)
#define PG8_STAGE(bufoff, gbase, voff) do { _Pragma("unroll") for (int _i = 0; _i < 2; ++_i) \
        __builtin_amdgcn_global_load_lds((const unsigned*)((const char*)(gbase) + (voff)[_i]), (PG8_LAS unsigned*)(lds + (bufoff) + ldsw + _i * 8192), 16, 0, 0); } while (0)
#define PG8_LDA(dst, b, h) do { _Pragma("unroll") for (int m = 0; m < 4; ++m) _Pragma("unroll") for (int k = 0; k < 2; ++k) dst[m][k] = *(const PG8_LAS bf16x8*)(lds + PG8_SA(b, h) + aoff + m * 2048 + k * 1024); } while (0)
#define PG8_LDB(dst, b, h) do { _Pragma("unroll") for (int n = 0; n < 2; ++n) _Pragma("unroll") for (int k = 0; k < 2; ++k) dst[n][k] = *(const PG8_LAS bf16x8*)(lds + PG8_SB(b, h) + boff + n * 2048 + k * 1024); } while (0)
#define PG8_MMA(ai, bj, At, Bt) do { __builtin_amdgcn_s_setprio(1); _Pragma("unroll") for (int m = 0; m < 4; ++m) _Pragma("unroll") for (int n = 0; n < 2; ++n) _Pragma("unroll") for (int k = 0; k < 2; ++k) \
        acc[ai][bj][m][n] = __builtin_amdgcn_mfma_f32_16x16x32_bf16(Bt[n][k], At[m][k], acc[ai][bj][m][n], 0, 0, 0); __builtin_amdgcn_s_setprio(0); } while (0)
#define PG8_WAIT_V(n) asm volatile("s_waitcnt vmcnt(" #n ")" ::: "memory")
#define PG8_WAIT_L(n) asm volatile("s_waitcnt lgkmcnt(" #n ")" ::: "memory")
#define PG8_BAR __builtin_amdgcn_s_barrier()
#define PG8_SCHED __builtin_amdgcn_sched_barrier(0)
    Unit cur, nxt; int ui = 0;
    if (!S.next(0, cur)) return;
    f32x4 acc[2][2][4][2];
#pragma unroll
    for (int a = 0; a < 2; ++a)
#pragma unroll
        for (int b = 0; b < 2; ++b)
#pragma unroll
            for (int m = 0; m < 4; ++m)
#pragma unroll
                for (int n = 0; n < 2; ++n) acc[a][b][m][n] = (f32x4){0.f, 0.f, 0.f, 0.f};
    bf16x8 At[4][2], B0[2][2], B1[2][2];
    const char* cA = (const char*)g.A + (size_t)cur.pm * tstep; const char* cB = (const char*)g.Bt + (size_t)cur.pn * tstep;
    S.a_ready(cur);
    if constexpr (SP2) {
        PG8_STAGE(PG8_SB(0, 0), cB, voffB); PG8_STAGE(PG8_SB(0, 1), cB + hstep, voffB); PG8_STAGE(PG8_SA(0, 0), cA, voffA); PG8_STAGE(PG8_SA(0, 1), cA + hstep, voffA);
        if (wr == 1) PG8_BAR;
        PG8_WAIT_V(2); PG8_BAR;
        PG8_STAGE(PG8_SB(1, 0), cB + kstep, voffB); PG8_STAGE(PG8_SA(1, 0), cA + kstep, voffA); PG8_STAGE(PG8_SB(1, 1), cB + hstep + kstep, voffB);
        PG8_WAIT_V(6); PG8_BAR;
    } else {
        PG8_STAGE(PG8_SB(0, 0), cB, voffB); PG8_STAGE(PG8_SA(0, 0), cA, voffA); PG8_STAGE(PG8_SB(0, 1), cB + hstep, voffB); PG8_STAGE(PG8_SA(0, 1), cA + hstep, voffA);
        if (wr == 1) PG8_BAR;
        PG8_WAIT_V(4); PG8_BAR;
        PG8_STAGE(PG8_SB(1, 0), cB + kstep, voffB); PG8_STAGE(PG8_SA(1, 0), cA + kstep, voffA); PG8_STAGE(PG8_SB(1, 1), cB + hstep + kstep, voffB);
        PG8_WAIT_V(6); PG8_BAR;
    }
    for (;;) {
        const bool has_next = S.next(ui + 1, nxt);
        const char* nA = has_next ? (const char*)g.A + (size_t)nxt.pm * tstep : cA; const char* nB = has_next ? (const char*)g.Bt + (size_t)nxt.pn * tstep : cB;
        for (int t = 0; t < nt; t += 2) {
            const bool last = (t == nt - 2);
            const char* a1 = cA + (size_t)(t + 1) * kstep;
            const char* a2 = last ? nA : cA + (size_t)(t + 2) * kstep; const char* b2 = last ? nB : cB + (size_t)(t + 2) * kstep;
            const char* a3 = a2 + kstep; const char* b3 = b2 + kstep;
            if (last && has_next) S.a_ready(nxt);
            if constexpr (SP2) {
            PG8_LDB(B0, 0, 0); PG8_LDB(B1, 0, 1); PG8_SCHED; PG8_LDA(At, 0, 0); PG8_STAGE(PG8_SA(1, 1), a1 + hstep, voffA);
            PG8_WAIT_V(8); PG8_WAIT_L(0); PG8_BAR; PG8_MMA(0, 0, At, B0); PG8_MMA(0, 1, At, B1); PG8_BAR; PG8_SCHED;
            PG8_LDA(At, 0, 1); PG8_STAGE(PG8_SB(0, 0), b2, voffB); PG8_STAGE(PG8_SB(0, 1), b2 + hstep, voffB); PG8_STAGE(PG8_SA(0, 0), a2, voffA);
            PG8_WAIT_V(8); PG8_WAIT_L(0); PG8_BAR; PG8_MMA(1, 0, At, B0); PG8_MMA(1, 1, At, B1); PG8_BAR; PG8_SCHED;
            PG8_LDB(B0, 1, 0); PG8_LDB(B1, 1, 1); PG8_SCHED; PG8_LDA(At, 1, 0); PG8_STAGE(PG8_SA(0, 1), a2 + hstep, voffA);
            PG8_WAIT_V(8); PG8_WAIT_L(0); PG8_BAR; PG8_MMA(0, 0, At, B0); PG8_MMA(0, 1, At, B1); PG8_BAR; PG8_SCHED;
            PG8_LDA(At, 1, 1); PG8_STAGE(PG8_SB(1, 0), b3, voffB); PG8_STAGE(PG8_SB(1, 1), b3 + hstep, voffB); PG8_STAGE(PG8_SA(1, 0), a3, voffA);
            PG8_WAIT_V(8); PG8_WAIT_L(0); PG8_BAR; PG8_MMA(1, 0, At, B0); PG8_MMA(1, 1, At, B1); PG8_BAR; PG8_SCHED;
            } else {
            PG8_LDB(B0, 0, 0); PG8_SCHED; PG8_LDA(At, 0, 0); PG8_STAGE(PG8_SA(1, 1), a1 + hstep, voffA);
            PG8_WAIT_L(8); PG8_BAR; PG8_WAIT_L(0); PG8_MMA(0, 0, At, B0); PG8_BAR; PG8_SCHED;
            PG8_LDB(B1, 0, 1); PG8_STAGE(PG8_SB(0, 0), b2, voffB);
            PG8_BAR; PG8_WAIT_L(0); PG8_MMA(0, 1, At, B1); PG8_BAR;
            PG8_LDA(At, 0, 1); PG8_STAGE(PG8_SA(0, 0), a2, voffA);
            PG8_BAR; PG8_WAIT_L(0); PG8_MMA(1, 0, At, B0); PG8_BAR; PG8_SCHED;
            PG8_STAGE(PG8_SB(0, 1), b2 + hstep, voffB);
            PG8_WAIT_V(6); PG8_BAR; PG8_MMA(1, 1, At, B1); PG8_BAR;
            PG8_LDB(B0, 1, 0); PG8_SCHED; PG8_LDA(At, 1, 0); PG8_STAGE(PG8_SA(0, 1), a2 + hstep, voffA);
            PG8_WAIT_L(8); PG8_BAR; PG8_WAIT_L(0); PG8_MMA(0, 0, At, B0); PG8_BAR; PG8_SCHED;
            PG8_LDB(B1, 1, 1); PG8_STAGE(PG8_SB(1, 0), b3, voffB);
            PG8_BAR; PG8_WAIT_L(0); PG8_MMA(0, 1, At, B1); PG8_BAR;
            PG8_LDA(At, 1, 1); PG8_STAGE(PG8_SA(1, 0), a3, voffA);
            PG8_BAR; PG8_WAIT_L(0); PG8_MMA(1, 0, At, B0); PG8_BAR; PG8_SCHED;
            PG8_STAGE(PG8_SB(1, 1), b3 + hstep, voffB);
            PG8_WAIT_V(6); PG8_BAR; PG8_MMA(1, 1, At, B1); PG8_BAR;
            }
        }
        if constexpr (ALIGN_EPI) { if (wr == 0) PG8_BAR; }
        if constexpr (!Epi::AFTER_DRAIN) { E(acc, cur, wr, wc, fr, fq); S.done(cur); }
        if (!has_next) break;
#pragma unroll
        for (int a = 0; a < 2; ++a)
#pragma unroll
            for (int b = 0; b < 2; ++b)
#pragma unroll
                for (int m = 0; m < 4; ++m)
#pragma unroll
                    for (int n = 0; n < 2; ++n) acc[a][b][m][n] = (f32x4){0.f, 0.f, 0.f, 0.f};
        cur = nxt; cA = nA; cB = nB; ++ui;
        if constexpr (ALIGN_EPI) { if (wr == 1) PG8_BAR; }
    }
    PG8_WAIT_V(0);
    if constexpr (!ALIGN_EPI) { if (wr == 0) PG8_BAR; }
    PG8_BAR;
#undef PG8_SA
#undef PG8_SB
#undef PG8_STAGE
#undef PG8_LDA
#undef PG8_LDB
#undef PG8_MMA
#undef PG8_WAIT_V
#undef PG8_WAIT_L
#undef PG8_BAR
#undef PG8_SCHED
}
}

constexpr size_t MiB = 1u << 20;
constexpr size_t WS_CTL = 0, CTL_ZERO_BYTES = 1 * MiB;
constexpr size_t WS_COS = 2 * MiB, WS_SIN = 3 * MiB;
constexpr size_t WS_WG8 = 4 * MiB;
constexpr size_t WS_GATES = 5 * MiB;
constexpr size_t WS_LSE = 6 * MiB;
constexpr size_t WS_SSQ0 = 8 * MiB, WS_SSQ1 = 10 * MiB;
constexpr size_t WS_SSQH = 12 * MiB;
constexpr size_t WS_WINA = 16 * MiB;
constexpr size_t WS_WOUTA = 32 * MiB;
constexpr size_t WS_WINB0 = 36 * MiB;
constexpr size_t WS_WINB1 = 42 * MiB;
constexpr size_t WS_WOUTB = 46 * MiB;
constexpr size_t WS_WGATE = 48 * MiB;
constexpr size_t WS_WPLE = 56 * MiB;
constexpr size_t WS_HB0 = 64 * MiB, WS_HB1 = 128 * MiB;
constexpr size_t WS_PB = 192 * MiB;
constexpr size_t WS_S0 = WS_S0_, WS_S1 = WS_S1_, WS_S2 = WS_S2_, WS_S3 = WS_S3_, WS_END = 464 * MiB;
constexpr int CW_BAR = 4096;

#define XB_TMO      128
#define XB_XCNT(j)  (256  + 64 * (j))
#define XB_XSUB(j)  (1280 + 64 * (j))
#define XB_XGEN(j)  (2304 + 64 * (j))
#define XB_TOP      3328
#define XB_TOPGEN   3392
#define XCD_BAR_WORDS 3456
#define XB_SPIN_CAP (1u << 18)
__device__ __forceinline__ unsigned xb_ld(unsigned* p)              { return __hip_atomic_load(p, __ATOMIC_RELAXED, __HIP_MEMORY_SCOPE_AGENT); }
__device__ __forceinline__ unsigned xb_add(unsigned* p, unsigned v) { return __hip_atomic_fetch_add(p, v, __ATOMIC_RELAXED, __HIP_MEMORY_SCOPE_AGENT); }
__device__ __forceinline__ unsigned xb_xcc_id() { return (unsigned)__builtin_amdgcn_s_getreg((3 << 11) | 20) & 0xFu; }
#define XB_SPIN(cond, bar) do { unsigned _sp = 0; while (cond) { __builtin_amdgcn_s_sleep(1); \
    if ((++_sp & 255u) == 0u) { if (xb_ld(&(bar)[XB_TMO])) break; if (_sp > XB_SPIN_CAP) { atomicAdd(&(bar)[XB_TMO], 1u); break; } } } } while (0)
struct XcdBarrier { unsigned* bar; unsigned x; volatile LAS unsigned* st; };
__device__ __forceinline__ XcdBarrier xcd_barrier_post(unsigned* bar, volatile LAS unsigned* st) {
    XcdBarrier b; b.bar = bar; b.x = xb_xcc_id(); b.st = st;
    if (threadIdx.x == 0) (void)xb_add(&bar[XB_XCNT(b.x)], 1u);
    return b;
}
__device__ __forceinline__ void xcd_barrier_complete(unsigned* bar, unsigned x, unsigned& nloc, unsigned& nx) {
    const unsigned G = gridDim.x * gridDim.y * gridDim.z;
    unsigned sum, cnt, mine, sp = 0u;
    for (;;) {
        sum = 0u; cnt = 0u; mine = 0u;
#pragma unroll
        for (unsigned j = 0; j < 16; ++j) { const unsigned c = xb_ld(&bar[XB_XCNT(j)]); sum += c; cnt += (c > 0u) ? 1u : 0u; mine = (j == x) ? c : mine; }
        if (sum == G) break;
        __builtin_amdgcn_s_sleep(1);
        if ((++sp & 255u) == 0u) { if (xb_ld(&bar[XB_TMO])) break; if (sp > XB_SPIN_CAP) { atomicAdd(&bar[XB_TMO], 1u); break; } }
    }
    nloc = mine > 0u ? mine : 1u; nx = cnt > 0u ? cnt : 1u;
}
__device__ __forceinline__ void xcd_barrier(const XcdBarrier& b) {
    asm volatile("s_waitcnt vmcnt(0)" ::: "memory");
    __syncthreads();
    if (threadIdx.x == 0) {
        unsigned* bar = b.bar;
        __builtin_amdgcn_s_waitcnt(0);
        unsigned nloc = b.st[0], nx = b.st[1];
        if (nloc == 0u) { xcd_barrier_complete(bar, b.x, nloc, nx); b.st[0] = nloc; b.st[1] = nx; }
        const unsigned old = xb_add(&bar[XB_XSUB(b.x)], 1u);
        const unsigned gen = old / nloc;
        if (old + 1u == (gen + 1u) * nloc) {
            __builtin_amdgcn_fence(__ATOMIC_RELEASE, "agent");
            asm volatile("s_waitcnt vmcnt(0)" ::: "memory");
            const unsigned og = xb_add(&bar[XB_TOP], 1u);
            const unsigned tg = og / nx;
            if (og + 1u == (tg + 1u) * nx) xb_add(&bar[XB_TOPGEN], 1u);
            else XB_SPIN(xb_ld(&bar[XB_TOPGEN]) == tg, bar);
            __builtin_amdgcn_fence(__ATOMIC_ACQUIRE, "agent");
            xb_add(&bar[XB_XGEN(b.x)], 1u);
            asm volatile("s_waitcnt vmcnt(0)" ::: "memory");
        } else {
            XB_SPIN(xb_ld(&bar[XB_XGEN(b.x)]) == gen, bar);
            __builtin_amdgcn_fence(__ATOMIC_ACQUIRE, "agent");
            asm volatile("s_waitcnt vmcnt(0)" ::: "memory");
        }
    }
    __syncthreads();
}

struct Args {
    const float* x; const float* p; const float* norm_a; const float* w_in_a; const float* conv_a; const float* b_gate_a; const float* hnorm_a; const float* w_out_a;
    const float* norm_kv; const float* w_kv; const float* knorm; const float* norm_b; const float* w_in_b; const float* qnorm_b; const float* w_out_b;
    const float* ple_norm; const float* w_ple_gate; const float* w_ple;
    float* out; unsigned char* ws;
};

constexpr int NWAVES = 8, NTHR = 512;
constexpr int RING_OFF = 0;
constexpr int MISC_OFF = 160 * 1024 - 256;
constexpr int LDS_BYTES = 160 * 1024;

#define LDS_WAIT() asm volatile("s_waitcnt lgkmcnt(0)" ::: "memory")
#define LDS_BARRIER() do { asm volatile("s_waitcnt lgkmcnt(0)" ::: "memory"); __builtin_amdgcn_s_barrier(); asm volatile("" ::: "memory"); } while (0)

__device__ __forceinline__ void transpose_item(const float* W, int K, int ldw, int ncol0, int nblk, const float* gain, bf16_t* WT, int row_off, LAS float* scr, int item, int lane) {
    const int kb = item / nblk, nb = item % nblk, k0 = 64 * kb, n0 = 32 * nb;
#pragma unroll 8
    for (int i = 0; i < 32; ++i) { const int kk = 2 * i + (lane >> 5); const float gv = gain ? gain[k0 + kk] : 1.f; scr[kk * 33 + (lane & 31)] = W[(size_t)(k0 + kk) * ldw + ncol0 + n0 + (lane & 31)] * gv; }
    LDS_WAIT(); asm volatile("" ::: "memory");
    const int c = lane & 7;
#pragma unroll
    for (int j = 0; j < 4; ++j) { const int n = (lane >> 3) + 8 * j; const LAS float* s = scr + (8 * c) * 33 + n;
        u32x4 o; o.x = cvt_pk_bf16(s[0 * 33], s[1 * 33]); o.y = cvt_pk_bf16(s[2 * 33], s[3 * 33]); o.z = cvt_pk_bf16(s[4 * 33], s[5 * 33]); o.w = cvt_pk_bf16(s[6 * 33], s[7 * 33]);
        *(u32x4*)(WT + (size_t)(row_off + n0 + n) * K + k0 + 8 * c) = o; }
    LDS_WAIT(); asm volatile("" ::: "memory");
}

__device__ __forceinline__ void prologue(const Args& a, LAS unsigned char* lds, int gw, int NGW, int lane, int wave) {
    unsigned char* ws = a.ws;
    LAS float* scr = (LAS float*)(lds + wave * 16384);
    struct TJ { const float* W; int K, ldw, ncol0, ncols; const float* gain; bf16_t* dst; int row_off; };
    int it = gw;
    for (int job = 0; job < 17; ++job) {
        TJ j;
        if (job < 2)       j = TJ{a.w_in_a + (size_t)job * 1024 * A_COLS, 1024, A_COLS, 0, 4096, a.norm_a + job * 1024, (bf16_t*)(ws + WS_WINA) + (size_t)job * 4096 * 1024, 0};
        else if (job < 4)  j = TJ{a.w_out_a + (size_t)(job - 2) * 1024 * 1024, 1024, 1024, 0, 1024, a.hnorm_a + (job - 2) * 1024, (bf16_t*)(ws + WS_WOUTA) + (size_t)(job - 2) * 1024 * 1024, 0};
        else if (job == 4) j = TJ{a.w_in_b, 1024, 2048, 0, 2048, a.norm_b, (bf16_t*)(ws + WS_WINB0), 0};
        else if (job == 5) j = TJ{a.w_in_b + (size_t)1024 * 2048, 1024, 2048, 0, 2048, a.norm_b + 1024, (bf16_t*)(ws + WS_WINB1), 0};
        else if (job == 6) j = TJ{a.w_kv, 1024, 1024, 0, 1024, a.norm_kv, (bf16_t*)(ws + WS_WINB0), 2048};
        else if (job < 9)  j = TJ{a.w_out_b + (size_t)(job - 7) * 512 * 1024, 512, 1024, 0, 1024, nullptr, (bf16_t*)(ws + WS_WOUTB) + (size_t)(job - 7) * 1024 * 512, 0};
        else if (job < 13) j = TJ{a.w_ple_gate + (size_t)(job - 9) * 1024 * 1024, 1024, 1024, 0, 1024, a.ple_norm + (job - 9) * 1024, (bf16_t*)(ws + WS_WGATE) + (size_t)(job - 9) * 1024 * 1024, 0};
        else               j = TJ{a.w_ple + (size_t)(job - 13) * 256 * 1024, 256, 1024, 0, 1024, nullptr, (bf16_t*)(ws + WS_WPLE) + (size_t)(job - 13) * 1024 * 256, 0};
        const int nblk = j.ncols / 32, nitems = (j.K / 64) * nblk;
        for (; it < nitems; it += NGW) transpose_item(j.W, j.K, j.ldw, j.ncol0, nblk, j.gain, j.dst, j.row_off, scr, it, lane);
        it -= nitems;
    }
    {
        bf16_t* HB = (bf16_t*)(ws + WS_HB0); float* SSQ = (float*)(ws + WS_SSQ0);
        for (int m = gw; m < T; m += NGW) {
            const f32x4* xr = (const f32x4*)(a.x + (size_t)m * D) + lane;
            f32x4 v[4]; float s = 0.f;
#pragma unroll
            for (int jj = 0; jj < 4; ++jj) { v[jj] = xr[64 * jj]; s += (v[jj].x * v[jj].x + v[jj].y * v[jj].y) + (v[jj].z * v[jj].z + v[jj].w * v[jj].w); }
#pragma unroll
            for (int o = 1; o < 64; o <<= 1) s += __shfl_xor(s, o);
            u32x2* o8 = (u32x2*)(HB + (size_t)m * D) + lane;
#pragma unroll
            for (int jj = 0; jj < 4; ++jj) { u32x2 w; w.x = cvt_pk_bf16(v[jj].x, v[jj].y); w.y = cvt_pk_bf16(v[jj].z, v[jj].w); o8[64 * jj] = w; }
            if (lane < 16) SSQ[(size_t)m * 16 + lane] = lane == 0 ? s : 0.f;
        }
    }
    {
        float* COS = (float*)(ws + WS_COS); float* SIN = (float*)(ws + WS_SIN);
        for (int i = gw * 64 + lane; i < SEQ * 64; i += NGW * 64) {
            const int pos = i >> 6, fi = i & 63;
            const float crev = exp2f(-(float)fi * (13.287712379549449f / 64.0f)) * 0.15915494309189535f;
            float tr = (float)pos * crev; tr -= rintf(tr);
            COS[i] = __builtin_amdgcn_cosf(tr); SIN[i] = __builtin_amdgcn_sinf(tr);
        }
    }
    {
        bf16_t* WG = (bf16_t*)(ws + WS_WG8);
        for (int i = gw * 64 + lane; i < 2 * 16 * 1024; i += NGW * 64) {
            const int l = i >> 14, jj = (i >> 10) & 15, k = i & 1023;
            WG[i] = (jj < 8) ? f2bf(a.w_in_a[(size_t)l * 1024 * A_COLS + (size_t)k * A_COLS + 4096 + jj] * a.norm_a[l * 1024 + k]) : (bf16_t)0;
        }
    }
}

__device__ __forceinline__ void convert_p(const Args& a, int layer, int gtid, int NGT) {
    const f32x4* src = (const f32x4*)(a.p + (size_t)layer * T * PLE);
    u32x4* dst = (u32x4*)(a.ws + WS_PB);
    for (int i = gtid; i < T * PLE / 8; i += NGT) {
        const f32x4 v0 = src[2 * i], v1 = src[2 * i + 1];
        u32x4 w; w.x = cvt_pk_bf16(v0.x, v0.y); w.y = cvt_pk_bf16(v0.z, v0.w); w.z = cvt_pk_bf16(v1.x, v1.y); w.w = cvt_pk_bf16(v1.z, v1.w);
        dst[i] = w;
    }
}

__device__ __forceinline__ void gates_job(const Args& a, int layer, const bf16_t* HB, const float* SSQ, int gw, int NGW, int lane) {
    const bf16_t* WG = (const bf16_t*)(a.ws + WS_WG8) + (size_t)layer * 16 * 1024;
    float* GATES = (float*)(a.ws + WS_GATES);
    const int ql = lane & 15, grp = lane >> 4;
#pragma nounroll
    for (int t0 = gw * 16; t0 < T; t0 += NGW * 16) {
        const bf16_t* arow = HB + (size_t)(t0 + ql) * D + 8 * grp;
        const bf16_t* brow = WG + ql * 1024 + 8 * grp;
        f32x4 acc = (f32x4){0.f, 0.f, 0.f, 0.f};
#pragma unroll 8
        for (int ks = 0; ks < 32; ++ks) acc = __builtin_amdgcn_mfma_f32_16x16x32_bf16(*(const bf16x8*)(arow + 32 * ks), *(const bf16x8*)(brow + 32 * ks), acc, 0, 0, 0);
        if (ql < 8) {
            const float bias = a.b_gate_a[layer * 8 + ql];
#pragma unroll
            for (int ii = 0; ii < 4; ++ii) { const int t = t0 + 4 * grp + ii; GATES[(size_t)t * 8 + ql] = acc[ii] * ssq16_rstd(SSQ, t) + bias; }
        }
    }
}

__device__ __forceinline__ void conv_phase(const Args& a, int layer, int gtid, int NGT) {
    const bf16_t* QKb = (const bf16_t*)(a.ws + WS_S0); bf16_t* QC = (bf16_t*)(a.ws + WS_HB1);
#pragma nounroll
    for (int task = gtid; task < (T / 16) * 128; task += NGT) {
        const int cgp = task & 127, run = task >> 7, t0 = run * 16, ch0 = cgp * 8;
        float cw[4][8];
#pragma unroll
        for (int jj = 0; jj < 4; ++jj) { const f32x4 c0 = *(const f32x4*)(a.conv_a + (size_t)layer * 4096 + jj * 1024 + ch0), c1 = *(const f32x4*)(a.conv_a + (size_t)layer * 4096 + jj * 1024 + ch0 + 4);
            cw[jj][0] = c0.x; cw[jj][1] = c0.y; cw[jj][2] = c0.z; cw[jj][3] = c0.w; cw[jj][4] = c1.x; cw[jj][5] = c1.y; cw[jj][6] = c1.z; cw[jj][7] = c1.w; }
        const float scl = (ch0 >= 512) ? 0.08838834764831845f : 1.f;
        const bool first = (t0 & (SEQ - 1)) == 0;
        const bf16_t* src = QKb + (size_t)t0 * 1024 + ch0; bf16_t* dst = QC + (size_t)t0 * 1024 + ch0;
        u32x4 r0 = (u32x4){0u, 0u, 0u, 0u}, r1 = r0, r2 = r0;
        if (!first) { r0 = *(const u32x4*)(src - 3 * 1024); r1 = *(const u32x4*)(src - 2 * 1024); r2 = *(const u32x4*)(src - 1 * 1024); }
#pragma unroll 4
        for (int q = 0; q < 16; ++q) {
            const u32x4 r3 = *(const u32x4*)(src + (size_t)q * 1024);
            const unsigned w0[4] = {r0.x, r0.y, r0.z, r0.w}, w1[4] = {r1.x, r1.y, r1.z, r1.w}, w2[4] = {r2.x, r2.y, r2.z, r2.w}, w3[4] = {r3.x, r3.y, r3.z, r3.w};
            unsigned ow[4];
#pragma unroll
            for (int e = 0; e < 4; ++e) {
                float u0 = cw[0][2 * e] * bf_lo(w0[e]) + cw[1][2 * e] * bf_lo(w1[e]) + cw[2][2 * e] * bf_lo(w2[e]) + cw[3][2 * e] * bf_lo(w3[e]);
                float u1 = cw[0][2 * e + 1] * bf_hi(w0[e]) + cw[1][2 * e + 1] * bf_hi(w1[e]) + cw[2][2 * e + 1] * bf_hi(w2[e]) + cw[3][2 * e + 1] * bf_hi(w3[e]);
                u0 = u0 * sigmoidf_(u0) * scl; u1 = u1 * sigmoidf_(u1) * scl;
                ow[e] = cvt_pk_bf16(u0, u1);
            }
            *(u32x4*)(dst + (size_t)q * 1024) = (u32x4){ow[0], ow[1], ow[2], ow[3]};
            r0 = r1; r1 = r2; r2 = r3;
        }
    }
}

namespace scan {
constexpr int QS = 0, KS = 17408, VT = 34816, WS_ = 41728, CS = 50944, HS = 77056, GA = 85504, TA = 86784, TPM = TA + 16384, TB = TPM + 16384;
constexpr int QSTR = 272, TSTR = 144, CBUF = 48 * 272;
constexpr int O_GW = 0;

__device__ __forceinline__ void flush_out(LAS unsigned char* lds, bf16_t* OGb, float* SSQH, size_t row, int vcol, int tokv, int c4, int h, int s, u32x4 ograw, u32x4 szraw) {
    const LAS float* hs = (const LAS float*)(lds + HS) + tokv * 33 + 8 * c4;
    const unsigned ow[4] = {ograw.x, ograw.y, ograw.z, ograw.w}, zw[4] = {szraw.x, szraw.y, szraw.z, szraw.w};
    float sq = 0.f; unsigned outw[4];
#pragma unroll
    for (int e = 0; e < 4; ++e) {
        const float g0 = bf_lo(ow[e]) * hs[2 * e], g1 = bf_hi(ow[e]) * hs[2 * e + 1];
        sq += g0 * g0 + g1 * g1;
        outw[e] = cvt_pk_bf16(g0 * bf_lo(zw[e]), g1 * bf_hi(zw[e]));
    }
    sq += __shfl_xor(sq, 1); sq += __shfl_xor(sq, 2);
    *(u32x4*)(OGb + row * 1024 + vcol) = (u32x4){outw[0], outw[1], outw[2], outw[3]};
    if (c4 == 0) SSQH[row * 32 + h * 8 + s] = sq;
}

__device__ __forceinline__ void phase(const Args& a, LAS unsigned char* lds, int layer, int G) {
    int tid = threadIdx.x; asm volatile("" : "+v"(tid));
    unsigned char* ws = a.ws;
    const bf16_t* QCb = (const bf16_t*)(ws + WS_HB1); const bf16_t* Vb = (const bf16_t*)(ws + WS_S1);
    bf16_t* OGb = (bf16_t*)(ws + WS_S2); const bf16_t* SZb = (const bf16_t*)(ws + WS_S3);
    const float* GATES = (const float*)(ws + WS_GATES); float* SSQH = (float*)(ws + WS_SSQH);
    for (int item = blockIdx.x; item < 256; item += G) {
        const int xx = item & 7, kk = item >> 3, bh = xx * 4 + (kk >> 3), s = kk & 7, b = bh >> 2, h = bh & 3;
        const size_t rowbase = (size_t)b * SEQ;
        {
            for (int i = tid; i < 2 * CBUF / 4; i += NTHR) ((LAS unsigned*)(lds + CS))[i] = 0u;
            for (int i = tid; i < 16 * TSTR / 4; i += NTHR) ((LAS unsigned*)(lds + VT + 32 * TSTR))[i] = (i < 32) ? 0x3f803f80u : 0u;
        }
        f32x4 Cacc[3] = {(f32x4){0.f, 0.f, 0.f, 0.f}, (f32x4){0.f, 0.f, 0.f, 0.f}, (f32x4){0.f, 0.f, 0.f, 0.f}};
        float mprev = 0.f;
        u32x4 qk[4]; u32x4 vraw = (u32x4){0u, 0u, 0u, 0u}, ograw = vraw, szraw = vraw;
        {
#pragma unroll
            for (int i = 0; i < 4; ++i) { const int p = (tid + 512 * i) & 1023, row = p >> 4, c16 = p & 15;
                qk[i] = *(const u32x4*)(QCb + (rowbase + row) * 1024 + (i >= 2 ? 512 : 0) + h * 128 + c16 * 8); }
            if (tid < 256) vraw = *(const u32x4*)(Vb + (rowbase + ((tid >> 2) & 63)) * 1024 + h * 256 + s * 32 + 8 * (tid & 3));
        }
        {
            const int lane = tid & 63, w0 = __builtin_amdgcn_readfirstlane(tid >> 6);
#pragma nounroll
            for (int cc = w0; cc < 64; cc += 8) {
                const int t = cc * 64 + lane;
                const float gi = GATES[(rowbase + t) * 8 + h], gf = GATES[(rowbase + t) * 8 + 4 + h];
                const float lf = fminf(gf, 0.f) - log1pf(expf(-fabsf(gf)));
                float bc = lf;
#pragma unroll
                for (int o = 1; o < 64; o <<= 1) { const float tt = __shfl_up(bc, o); if (lane >= o) bc += tt; }
                const float av = gi - bc;
                float pm = av;
#pragma unroll
                for (int o = 1; o < 64; o <<= 1) { const float tt = __shfl_up(pm, o); if (lane >= o) pm = fmaxf(pm, tt); }
                ((LAS float*)(lds + TA))[t] = av; ((LAS float*)(lds + TPM))[t] = pm; ((LAS float*)(lds + TB))[t] = bc;
            }
        }
        __syncthreads();
#pragma nounroll
        for (int c = 0; c < 64; ++c) {
            int tl = tid; asm volatile("" : "+v"(tl));
            const int w = __builtin_amdgcn_readfirstlane(tl >> 6), lane = tl & 63, grp = lane >> 4, ql = lane & 15;
            const int tokv = (tl >> 2) & 63, c4 = tl & 3;
            const int vcol = h * 256 + s * 32 + 8 * c4;
            LAS float* ga = (LAS float*)(lds + GA);
            const int t0 = c * 64, cur = c & 1, nxt = cur ^ 1;
            {
                const int p0 = tl, p1 = tl + 512;
                *(LAS u32x4*)(lds + QS + (p0 >> 4) * QSTR + (p0 & 15) * 16) = qk[0];
                *(LAS u32x4*)(lds + QS + (p1 >> 4) * QSTR + (p1 & 15) * 16) = qk[1];
                *(LAS u32x4*)(lds + KS + (p0 >> 4) * QSTR + (p0 & 15) * 16) = qk[2];
                *(LAS u32x4*)(lds + KS + (p1 >> 4) * QSTR + (p1 & 15) * 16) = qk[3];
                if (tl < 256) {
                    const unsigned vw[4] = {vraw.x, vraw.y, vraw.z, vraw.w};
#pragma unroll
                    for (int e = 0; e < 4; ++e) {
                        *(LAS bf16_t*)(lds + VT + (8 * c4 + 2 * e) * TSTR + tokv * 2) = (bf16_t)(vw[e] & 0xffffu);
                        *(LAS bf16_t*)(lds + VT + (8 * c4 + 2 * e + 1) * TSTR + tokv * 2) = (bf16_t)(vw[e] >> 16);
                    }
                }
            }
            const LAS float* tA = (const LAS float*)(lds + TA) + c * 64; const LAS float* tPM = (const LAS float*)(lds + TPM) + c * 64; const LAS float* tB = (const LAS float*)(lds + TB) + c * 64;
            const float mcur = mprev;
            const float Mlast = fmaxf(mcur, tPM[63]);
            const float decay = __expf(mcur - Mlast);
            mprev = tB[63] + Mlast;
            if (w == 0) ga[O_GW + lane] = __expf(tA[lane] - Mlast);
            if (c > 0 && tl < 256) flush_out(lds, OGb, SSQH, rowbase + (t0 - 64) + tokv, vcol, tokv, c4, h, s, ograw, szraw);
            if (tl < 256) { const size_t row = rowbase + t0 + tokv; ograw = *(const u32x4*)(OGb + row * 1024 + vcol); szraw = *(const u32x4*)(SZb + row * 1024 + vcol); }
            if (c < 63) {
#pragma unroll
                for (int i = 0; i < 4; ++i) { const int p = (tl + 512 * i) & 1023, row = p >> 4, c16 = p & 15;
                    qk[i] = *(const u32x4*)(QCb + (rowbase + t0 + 64 + row) * 1024 + (i >= 2 ? 512 : 0) + h * 128 + c16 * 8); }
                if (tl < 256) vraw = *(const u32x4*)(Vb + (rowbase + t0 + 64 + tokv) * 1024 + vcol);
            }
            LDS_BARRIER();
            const int ti = w >> 1;
            bf16x8 Aq[4];
            {
                const LAS unsigned char* qb = lds + QS + (16 * ti + ql) * QSTR + grp * 16;
#pragma unroll
                for (int ks = 0; ks < 4; ++ks) Aq[ks] = *(const LAS bf16x8*)(qb + ks * 64);
            }
            {
                f32x4 gMi = *(const LAS f32x4*)(tPM + 16 * ti + 4 * grp);
                gMi[0] = fmaxf(gMi[0], mcur); gMi[1] = fmaxf(gMi[1], mcur); gMi[2] = fmaxf(gMi[2], mcur); gMi[3] = fmaxf(gMi[3], mcur);
                const LAS unsigned char* kb = lds + KS + (32 * (w & 1) + ql) * QSTR + grp * 16;
                LAS unsigned char* wb = lds + WS_ + (16 * ti + 4 * grp) * TSTR + (32 * (w & 1) + ql) * 2;
#pragma unroll
                for (int tjj = 0; tjj < 2; ++tjj) {
                    f32x4 sacc = (f32x4){0.f, 0.f, 0.f, 0.f};
#pragma unroll
                    for (int ks = 0; ks < 4; ++ks) sacc = __builtin_amdgcn_mfma_f32_16x16x32_bf16(Aq[ks], *(const LAS bf16x8*)(kb + tjj * 16 * QSTR + ks * 64), sacc, 0, 0, 0);
                    const int j = 32 * (w & 1) + 16 * tjj + ql; const float gaj = tA[j];
#pragma unroll
                    for (int ii = 0; ii < 4; ++ii) {
                        const int i = 16 * ti + 4 * grp + ii;
                        const float wv = (j <= i) ? __expf(gaj - gMi[ii]) * sacc[ii] : 0.f;
                        *(LAS bf16_t*)(wb + ii * TSTR + tjj * 32) = f2bf(wv);
                    }
                }
            }
            LDS_BARRIER();
            {
                const int tn = w & 1;
                f32x4 acc1 = (f32x4){0.f, 0.f, 0.f, 0.f}, acc2 = acc1, acc1a = acc1, acc2a = acc1;
                const LAS unsigned char* wb = lds + WS_ + (16 * ti + ql) * TSTR + grp * 16;
                const LAS unsigned char* vb = lds + VT + (16 * tn + ql) * TSTR + grp * 16;
                const LAS unsigned char* va = lds + VT + (32 + ql) * TSTR + grp * 16;
                const LAS unsigned char* cb = lds + CS + cur * CBUF + (16 * tn + ql) * QSTR + grp * 16;
                const LAS unsigned char* ca = lds + CS + cur * CBUF + (32 + ql) * QSTR + grp * 16;
#pragma unroll
                for (int ks = 0; ks < 2; ++ks) { const bf16x8 Aw = *(const LAS bf16x8*)(wb + ks * 64);
                    acc1 = __builtin_amdgcn_mfma_f32_16x16x32_bf16(Aw, *(const LAS bf16x8*)(vb + ks * 64), acc1, 0, 0, 0);
                    acc1a = __builtin_amdgcn_mfma_f32_16x16x32_bf16(Aw, *(const LAS bf16x8*)(va + ks * 64), acc1a, 0, 0, 0); }
#pragma unroll
                for (int ks = 0; ks < 4; ++ks) {
                    acc2 = __builtin_amdgcn_mfma_f32_16x16x32_bf16(Aq[ks], *(const LAS bf16x8*)(cb + ks * 64), acc2, 0, 0, 0);
                    acc2a = __builtin_amdgcn_mfma_f32_16x16x32_bf16(Aq[ks], *(const LAS bf16x8*)(ca + ks * 64), acc2a, 0, 0, 0); }
                const int i0 = 16 * ti + 4 * grp;
                const f32x4 pmi = *(const LAS f32x4*)(tPM + i0), bi = *(const LAS f32x4*)(tB + i0);
                f32x4 inter, flr;
#pragma unroll
                for (int ii = 0; ii < 4; ++ii) { const float Mi = fmaxf(mcur, pmi[ii]); inter[ii] = __expf(mcur - Mi); flr[ii] = __expf(-(bi[ii] + Mi)); }
                LAS float* hsw = (LAS float*)(lds + HS) + i0 * 33 + 16 * tn + ql;
#pragma unroll
                for (int ii = 0; ii < 4; ++ii) {
                    const float num = acc1[ii] + inter[ii] * acc2[ii];
                    const float den = __shfl(acc1a[ii] + inter[ii] * acc2a[ii], lane & 48);
                    hsw[ii * 33] = num / fmaxf(fabsf(den), flr[ii]);
                }
            }
            {
                Cacc[0] = Cacc[0] * decay; Cacc[1] = Cacc[1] * decay; Cacc[2] = Cacc[2] * decay;
                const LAS unsigned char* kcol = lds + KS + (8 * grp) * QSTR + (16 * w + ql) * 2;
                const LAS unsigned char* vb = lds + VT + ql * TSTR + grp * 16;
#pragma unroll
                for (int ks = 0; ks < 2; ++ks) {
                    unsigned kw[4];
#pragma unroll
                    for (int e = 0; e < 4; ++e) { const unsigned lo = *(const LAS bf16_t*)(kcol + (32 * ks + 2 * e) * QSTR), hi = *(const LAS bf16_t*)(kcol + (32 * ks + 2 * e + 1) * QSTR); kw[e] = lo | (hi << 16); }
                    const bf16x8 Bk = __builtin_bit_cast(bf16x8, (u32x4){kw[0], kw[1], kw[2], kw[3]});
                    const f32x4 g0 = *(const LAS f32x4*)(ga + O_GW + 32 * ks + 8 * grp), g1 = *(const LAS f32x4*)(ga + O_GW + 32 * ks + 8 * grp + 4);
#pragma unroll
                    for (int vt = 0; vt < 3; ++vt) {
                        const u32x4 vv = *(const LAS u32x4*)(vb + vt * 16 * TSTR + ks * 64);
                        u32x4 aw; aw.x = cvt_pk_bf16(bf_lo(vv.x) * g0.x, bf_hi(vv.x) * g0.y); aw.y = cvt_pk_bf16(bf_lo(vv.y) * g0.z, bf_hi(vv.y) * g0.w);
                        aw.z = cvt_pk_bf16(bf_lo(vv.z) * g1.x, bf_hi(vv.z) * g1.y); aw.w = cvt_pk_bf16(bf_lo(vv.w) * g1.z, bf_hi(vv.w) * g1.w);
                        Cacc[vt] = __builtin_amdgcn_mfma_f32_16x16x32_bf16(__builtin_bit_cast(bf16x8, aw), Bk, Cacc[vt], 0, 0, 0);
                    }
                }
                LAS unsigned char* cw_ = lds + CS + nxt * CBUF + (4 * grp) * QSTR + (16 * w + ql) * 2;
#pragma unroll
                for (int vt = 0; vt < 2; ++vt)
#pragma unroll
                    for (int ii = 0; ii < 4; ++ii) *(LAS bf16_t*)(cw_ + (16 * vt + ii) * QSTR) = f2bf(Cacc[vt][ii]);
                if (grp == 0) *(LAS bf16_t*)(cw_ + 32 * QSTR) = f2bf(Cacc[2][0]);
            }
            LDS_BARRIER();
        }
        if (tid < 256) flush_out(lds, OGb, SSQH, rowbase + 63 * 64 + ((tid >> 2) & 63), h * 256 + s * 32 + 8 * (tid & 3), (tid >> 2) & 63, tid & 3, h, s, ograw, szraw);
        __syncthreads();
    }
}
}

__device__ __forceinline__ void mlstm_norm_phase(const Args& a, int gtid, int NGT) {
    const u32x4* A = (const u32x4*)(a.ws + WS_S2); u32x4* Y = (u32x4*)(a.ws + WS_S0); const float* SSQH = (const float*)(a.ws + WS_SSQH);
    for (int i = gtid; i < T * 128; i += NGT) {
        const int t = i >> 7, c8 = i & 127, h = c8 >> 5;
        const f32x4 s0 = *(const f32x4*)(SSQH + (size_t)t * 32 + h * 8), s1 = *(const f32x4*)(SSQH + (size_t)t * 32 + h * 8 + 4);
        const float rs = rsqrtf((((s0.x + s0.y) + (s0.z + s0.w)) + ((s1.x + s1.y) + (s1.z + s1.w))) * (1.f / 256.f) + EPS);
        const u32x4 v = A[i]; u32x4 o;
        o.x = cvt_pk_bf16(bf_lo(v.x) * rs, bf_hi(v.x) * rs); o.y = cvt_pk_bf16(bf_lo(v.y) * rs, bf_hi(v.y) * rs);
        o.z = cvt_pk_bf16(bf_lo(v.z) * rs, bf_hi(v.z) * rs); o.w = cvt_pk_bf16(bf_lo(v.w) * rs, bf_hi(v.w) * rs);
        Y[i] = o;
    }
}

namespace attn {
constexpr int KS = 0, VTS = 69632;
constexpr int KSTR = 272, VSTR = 560;
__device__ __forceinline__ void phase(const Args& a, LAS unsigned char* lds, int jl, int G) {
    int tid = threadIdx.x; asm volatile("" : "+v"(tid));
    unsigned char* ws = a.ws;
    const bf16_t* Kb = (const bf16_t*)(ws + WS_S0); const bf16_t* Vb = (const bf16_t*)(ws + WS_S0 + 32 * MiB);
    bf16_t* Qb = (bf16_t*)(ws + WS_S1);
    float* LSE = (float*)(ws + WS_LSE);
    const float* COS = (const float*)(ws + WS_COS); const float* SIN = (const float*)(ws + WS_SIN);
    const float* qg = a.qnorm_b + jl * 128; const float* kg = a.knorm;
    if (tid < 128) { *(LAS u32x4*)(lds + VTS + tid * VSTR + 512) = (u32x4){0u, 0u, 0u, 0u}; *(LAS u32x4*)(lds + VTS + tid * VSTR + 528) = (u32x4){0u, 0u, 0u, 0u}; }
#pragma nounroll
    for (int item = blockIdx.x; item < 3072; item += G) {
        int tl = tid; asm volatile("" : "+v"(tl));
        const int w = __builtin_amdgcn_readfirstlane(tl >> 6), lane = tl & 63, grp = lane >> 4, ql = lane & 15;
        const int bhh = item / 96, gi = item % 96, b = bhh >> 2, head = bhh & 3;
        int g, res, blk, r;
        if (gi < 32) { g = 0; res = 0; blk = gi; r = 1; } else if (gi < 64) { g = 1; res = (gi - 32) >> 3; blk = (gi - 32) & 7; r = 4; } else { g = 2; res = (gi - 64) >> 1; blk = (gi - 64) & 1; r = 16; }
        const size_t rowbase = (size_t)b * SEQ;
        {
            const int kj = tl >> 1, half = tl & 1;
            const int u = (blk - 1) * 128 + kj;
            LAS unsigned char* krow = lds + KS + kj * KSTR + half * 64;
            const int pos = u >= 0 ? u * r + res : 0;
            const bf16_t* src = Kb + (rowbase + pos) * 512 + head * 128 + 32 * half;
            u32x4 lo[4], hi[4];
#pragma unroll
            for (int c = 0; c < 4; ++c) { lo[c] = *(const u32x4*)(src + c * 8); hi[c] = *(const u32x4*)(src + 64 + c * 8); }
            float sq = 0.f;
#pragma unroll
            for (int c = 0; c < 4; ++c) {
                const unsigned lw[4] = {lo[c].x, lo[c].y, lo[c].z, lo[c].w}, hw[4] = {hi[c].x, hi[c].y, hi[c].z, hi[c].w};
#pragma unroll
                for (int e = 0; e < 4; ++e) { const float a0 = bf_lo(lw[e]), a1 = bf_hi(lw[e]), b0 = bf_lo(hw[e]), b1 = bf_hi(hw[e]); sq += (a0 * a0 + a1 * a1) + (b0 * b0 + b1 * b1); }
            }
            sq += __shfl_xor(sq, 1);
            const float rs = (u >= 0) ? rsqrtf(sq * (1.f / 128.f) + EPS) : 0.f;
            const float* cs = COS + pos * 64 + 32 * half; const float* sn = SIN + pos * 64 + 32 * half; const float* kgl = kg + 32 * half;
#pragma unroll
            for (int c = 0; c < 4; ++c) {
                const unsigned lw[4] = {lo[c].x, lo[c].y, lo[c].z, lo[c].w}, hw[4] = {hi[c].x, hi[c].y, hi[c].z, hi[c].w};
                const f32x4 c0 = *(const f32x4*)(cs + 8 * c), c1 = *(const f32x4*)(cs + 8 * c + 4), s0 = *(const f32x4*)(sn + 8 * c), s1 = *(const f32x4*)(sn + 8 * c + 4);
                const f32x4 g0 = *(const f32x4*)(kgl + 8 * c), g1 = *(const f32x4*)(kgl + 8 * c + 4), g2 = *(const f32x4*)(kgl + 64 + 8 * c), g3 = *(const f32x4*)(kgl + 64 + 8 * c + 4);
                const float cc[8] = {c0.x, c0.y, c0.z, c0.w, c1.x, c1.y, c1.z, c1.w}, ss[8] = {s0.x, s0.y, s0.z, s0.w, s1.x, s1.y, s1.z, s1.w};
                const float gl[8] = {g0.x, g0.y, g0.z, g0.w, g1.x, g1.y, g1.z, g1.w}, gh[8] = {g2.x, g2.y, g2.z, g2.w, g3.x, g3.y, g3.z, g3.w};
                unsigned w1[4], w2[4];
#pragma unroll
                for (int e = 0; e < 4; ++e) {
                    const float x1a = bf_lo(lw[e]) * rs * gl[2 * e], x1b = bf_hi(lw[e]) * rs * gl[2 * e + 1], x2a = bf_lo(hw[e]) * rs * gh[2 * e], x2b = bf_hi(hw[e]) * rs * gh[2 * e + 1];
                    w1[e] = cvt_pk_bf16(x1a * cc[2 * e] - x2a * ss[2 * e], x1b * cc[2 * e + 1] - x2b * ss[2 * e + 1]);
                    w2[e] = cvt_pk_bf16(x2a * cc[2 * e] + x1a * ss[2 * e], x2b * cc[2 * e + 1] + x1b * ss[2 * e + 1]);
                }
                *(LAS u32x4*)(krow + c * 16) = (u32x4){w1[0], w1[1], w1[2], w1[3]}; *(LAS u32x4*)(krow + 128 + c * 16) = (u32x4){w2[0], w2[1], w2[2], w2[3]};
            }
            const bf16_t* vsrc = Vb + (rowbase + pos) * 512 + head * 128 + 64 * half;
            LAS unsigned char* vcol = lds + VTS + (64 * half) * VSTR + kj * 2;
#pragma unroll
            for (int c = 0; c < 8; ++c) {
                u32x4 vv = *(const u32x4*)(vsrc + c * 8);
                if (u < 0) vv = (u32x4){0u, 0u, 0u, 0u};
                const unsigned vw[4] = {vv.x, vv.y, vv.z, vv.w};
#pragma unroll
                for (int e = 0; e < 4; ++e) {
                    *(LAS bf16_t*)(vcol + (8 * c + 2 * e) * VSTR) = (bf16_t)(vw[e] & 0xffffu);
                    *(LAS bf16_t*)(vcol + (8 * c + 2 * e + 1) * VSTR) = (bf16_t)(vw[e] >> 16);
                }
            }
        }
        const int qi = 16 * w + ql;
        const int posq = (128 * blk + qi) * r + res;
        bf16_t* qrow = Qb + (rowbase + posq) * 1536 + (g * 4 + head) * 128 + 8 * grp;
        bf16x8 Qf[4];
        {
            u32x4 qr[4];
#pragma unroll
            for (int ks = 0; ks < 4; ++ks) qr[ks] = *(const u32x4*)(qrow + 32 * ks);
            float qv[4][8]; float sq = 0.f;
#pragma unroll
            for (int ks = 0; ks < 4; ++ks) { qv[ks][0] = bf_lo(qr[ks].x); qv[ks][1] = bf_hi(qr[ks].x); qv[ks][2] = bf_lo(qr[ks].y); qv[ks][3] = bf_hi(qr[ks].y); qv[ks][4] = bf_lo(qr[ks].z); qv[ks][5] = bf_hi(qr[ks].z); qv[ks][6] = bf_lo(qr[ks].w); qv[ks][7] = bf_hi(qr[ks].w);
#pragma unroll
                for (int e = 0; e < 8; ++e) sq += qv[ks][e] * qv[ks][e]; }
            sq += __shfl_xor(sq, 16); sq += __shfl_xor(sq, 32);
            const float rs = rsqrtf(sq * (1.f / 128.f) + EPS);
#pragma unroll
            for (int ks = 0; ks < 2; ++ks) {
                const int d0 = 32 * ks + 8 * grp;
                const f32x4 c0 = *(const f32x4*)(COS + posq * 64 + d0), c1 = *(const f32x4*)(COS + posq * 64 + d0 + 4), s0 = *(const f32x4*)(SIN + posq * 64 + d0), s1 = *(const f32x4*)(SIN + posq * 64 + d0 + 4);
                const f32x4 g0 = *(const f32x4*)(qg + d0), g1 = *(const f32x4*)(qg + d0 + 4), g2 = *(const f32x4*)(qg + 64 + d0), g3 = *(const f32x4*)(qg + 64 + d0 + 4);
                const float cc[8] = {c0.x, c0.y, c0.z, c0.w, c1.x, c1.y, c1.z, c1.w}, ss[8] = {s0.x, s0.y, s0.z, s0.w, s1.x, s1.y, s1.z, s1.w};
                const float gl[8] = {g0.x, g0.y, g0.z, g0.w, g1.x, g1.y, g1.z, g1.w}, gh[8] = {g2.x, g2.y, g2.z, g2.w, g3.x, g3.y, g3.z, g3.w};
                float o1[8], o2[8];
#pragma unroll
                for (int e = 0; e < 8; ++e) { const float x1 = qv[ks][e] * rs * gl[e], x2 = qv[ks + 2][e] * rs * gh[e]; o1[e] = x1 * cc[e] - x2 * ss[e]; o2[e] = x2 * cc[e] + x1 * ss[e]; }
                u32x4 w1, w2; w1.x = cvt_pk_bf16(o1[0], o1[1]); w1.y = cvt_pk_bf16(o1[2], o1[3]); w1.z = cvt_pk_bf16(o1[4], o1[5]); w1.w = cvt_pk_bf16(o1[6], o1[7]);
                w2.x = cvt_pk_bf16(o2[0], o2[1]); w2.y = cvt_pk_bf16(o2[2], o2[3]); w2.z = cvt_pk_bf16(o2[4], o2[5]); w2.w = cvt_pk_bf16(o2[6], o2[7]);
                Qf[ks] = __builtin_bit_cast(bf16x8, w1); Qf[ks + 2] = __builtin_bit_cast(bf16x8, w2);
            }
        }
        __syncthreads();
        f32x4 sc[9];
        float mx = -__builtin_inff();
        const int dbase = 128 + ql - 4 * grp; const unsigned dmax = (blk > 0) ? 128u : (unsigned)qi;
        const LAS unsigned char* kbase = lds + KS + (16 * w + ql) * KSTR + grp * 16;
#pragma unroll
        for (int tt = 0; tt < 9; ++tt) {
            f32x4 acc = (f32x4){0.f, 0.f, 0.f, 0.f};
#pragma unroll
            for (int ks = 0; ks < 4; ++ks) acc = __builtin_amdgcn_mfma_f32_16x16x32_bf16(*(const LAS bf16x8*)(kbase + tt * 16 * KSTR + ks * 64), Qf[ks], acc, 0, 0, 0);
#pragma unroll
            for (int ii = 0; ii < 4; ++ii) {
                const int dist = dbase - 16 * tt - ii;
                const float v = ((unsigned)dist <= dmax) ? acc[ii] * 0.08838834764831845f : -__builtin_inff();
                sc[tt][ii] = v; mx = fmaxf(mx, v);
            }
        }
        mx = fmaxf(mx, __shfl_xor(mx, 16)); mx = fmaxf(mx, __shfl_xor(mx, 32));
        float den = 0.f;
#pragma unroll
        for (int tt = 0; tt < 9; ++tt)
#pragma unroll
            for (int ii = 0; ii < 4; ++ii) { const float e = __expf(sc[tt][ii] - mx); sc[tt][ii] = e; den += e; }
        den += __shfl_xor(den, 16); den += __shfl_xor(den, 32);
        f32x4 oacc[8];
#pragma unroll
        for (int dt = 0; dt < 8; ++dt) oacc[dt] = (f32x4){0.f, 0.f, 0.f, 0.f};
        const LAS unsigned char* vbase = lds + VTS + ql * VSTR + (16 * w + 4 * grp) * 2;
#pragma unroll
        for (int pp = 0; pp < 5; ++pp) {
            u32x4 pw;
            pw.x = cvt_pk_bf16(sc[2 * pp][0], sc[2 * pp][1]); pw.y = cvt_pk_bf16(sc[2 * pp][2], sc[2 * pp][3]);
            if (pp < 4) { pw.z = cvt_pk_bf16(sc[2 * pp + 1][0], sc[2 * pp + 1][1]); pw.w = cvt_pk_bf16(sc[2 * pp + 1][2], sc[2 * pp + 1][3]); } else { pw.z = 0u; pw.w = 0u; }
            const bf16x8 Pf = __builtin_bit_cast(bf16x8, pw);
#pragma unroll
            for (int dt = 0; dt < 8; ++dt) {
                const u32x2 lo = *(const LAS u32x2*)(vbase + dt * 16 * VSTR + pp * 64), hi = *(const LAS u32x2*)(vbase + dt * 16 * VSTR + pp * 64 + 32);
                const u32x4 av = (u32x4){lo.x, lo.y, hi.x, hi.y};
                oacc[dt] = __builtin_amdgcn_mfma_f32_16x16x32_bf16(__builtin_bit_cast(bf16x8, av), Pf, oacc[dt], 0, 0, 0);
            }
        }
        const float inv = 1.f / den;
        bf16_t* orow = qrow - 4 * grp;
#pragma unroll
        for (int dt = 0; dt < 8; ++dt) { u32x2 o; o.x = cvt_pk_bf16(oacc[dt][0] * inv, oacc[dt][1] * inv); o.y = cvt_pk_bf16(oacc[dt][2] * inv, oacc[dt][3] * inv);
            *(u32x2*)(orow + 16 * dt) = o; }
        if (grp == 0) LSE[((size_t)g * T + rowbase + posq) * 4 + head] = mx + __logf(den);
        __syncthreads();
    }
}
}

__device__ __forceinline__ void attn_combine_phase(const Args& a, int gtid, int NGT) {
    const bf16_t* O = (const bf16_t*)(a.ws + WS_S1); const u32x4* SZ = (const u32x4*)(a.ws + WS_S3); u32x4* Y = (u32x4*)(a.ws + WS_S3 + 32 * MiB);
    const float* LSE = (const float*)(a.ws + WS_LSE);
    for (int i = gtid; i < T * 64; i += NGT) {
        const int t = i >> 6, c8 = i & 63, h = c8 >> 4;
        const float l0 = LSE[((size_t)0 * T + t) * 4 + h], l1 = LSE[((size_t)1 * T + t) * 4 + h], l2 = LSE[((size_t)2 * T + t) * 4 + h];
        const float m = fmaxf(l0, fmaxf(l1, l2));
        float w0 = __expf(l0 - m), w1 = __expf(l1 - m), w2 = __expf(l2 - m);
        const float inv = 1.f / (w0 + w1 + w2); w0 *= inv; w1 *= inv; w2 *= inv;
        const u32x4 o0 = *(const u32x4*)(O + (size_t)t * 1536 + c8 * 8), o1 = *(const u32x4*)(O + (size_t)t * 1536 + 512 + c8 * 8), o2 = *(const u32x4*)(O + (size_t)t * 1536 + 1024 + c8 * 8);
        const u32x4 z = SZ[i];
        const unsigned a0[4] = {o0.x, o0.y, o0.z, o0.w}, a1[4] = {o1.x, o1.y, o1.z, o1.w}, a2[4] = {o2.x, o2.y, o2.z, o2.w}, zz[4] = {z.x, z.y, z.z, z.w};
        unsigned ow[4];
#pragma unroll
        for (int e = 0; e < 4; ++e) {
            const float lo = (w0 * bf_lo(a0[e]) + w1 * bf_lo(a1[e]) + w2 * bf_lo(a2[e])) * bf_lo(zz[e]);
            const float hi = (w0 * bf_hi(a0[e]) + w1 * bf_hi(a1[e]) + w2 * bf_hi(a2[e])) * bf_hi(zz[e]);
            ow[e] = cvt_pk_bf16(lo, hi);
        }
        Y[i] = (u32x4){ow[0], ow[1], ow[2], ow[3]};
    }
}

typedef const __attribute__((address_space(4))) Args* KArgs;
#define LOADARGS(name) Args name; { KArgs _k = kp; asm volatile("" : "+s"(_k)); name = *_k; }

__global__ void __launch_bounds__(NTHR, 2) fwd_megakernel(Args args_unused) {
#if defined(__HIP_DEVICE_COMPILE__)
    extern __shared__ __attribute__((aligned(16))) unsigned char lds_raw[];
    LAS unsigned char* lds = (LAS unsigned char*)lds_raw;
    KArgs kp = (KArgs)__builtin_amdgcn_kernarg_segment_ptr();
    const int G = gridDim.x, bx = blockIdx.x;
    {
        const int tid = threadIdx.x;
        volatile LAS unsigned* MISC0 = (volatile LAS unsigned*)(lds + MISC_OFF);
        if (tid < 64) MISC0[tid] = 0u;
        __syncthreads();
    }
    { LOADARGS(a); (void)xcd_barrier_post((unsigned*)(a.ws + WS_CTL) + CW_BAR, (volatile LAS unsigned*)(lds + MISC_OFF) + 8); }
#define GRID_BAR() do { LOADARGS(a_); XcdBarrier b_; b_.bar = (unsigned*)(a_.ws + WS_CTL) + CW_BAR; b_.x = xb_xcc_id(); b_.st = (volatile LAS unsigned*)(lds + MISC_OFF) + 8; xcd_barrier(b_); } while (0)
#define THREAD_IDS() int tid = threadIdx.x; asm volatile("" : "+v"(tid)); const int lane = tid & 63, wave = __builtin_amdgcn_readfirstlane(tid >> 6); \
    const int vcu = (G % 8 == 0) ? (bx % 8) * (G / 8) + bx / 8 : bx; const int gw = vcu * NWAVES + wave, NGW = G * NWAVES, gtid = vcu * NTHR + tid, NGT = G * NTHR; (void)lane; (void)gw; (void)NGW; (void)gtid; (void)NGT;

#define PH_PROLOGUE() { LOADARGS(a); THREAD_IDS(); prologue(a, lds, gw, NGW, lane, wave); }
#define PH_P1A(layer) { \
            { LOADARGS(a); unsigned char* ws = a.ws; \
              pg8::Gemm g{(const bf16_t*)(ws + WS_HB0), (const bf16_t*)(ws + WS_WINA) + (size_t)(layer) * 4096 * 1024, T, 4096, 1024}; \
              pg8::StaticOrder S; S.init(T, 4096, G, bx); \
              pg8::EpiP E{0, (const float*)(ws + WS_SSQ0), ws}; \
              pg8::gemm_phase<pg8::EpiP, pg8::StaticOrder, true, true>(lds + RING_OFF, g, S, E); } \
            { LOADARGS(a); THREAD_IDS(); gates_job(a, (layer), (const bf16_t*)(a.ws + WS_HB0), (const float*)(a.ws + WS_SSQ0), gw, NGW, lane); } \
            { LOADARGS(a); THREAD_IDS(); convert_p(a, (layer), gtid, NGT); } }
#define PH_CONV(layer) { LOADARGS(a); THREAD_IDS(); conv_phase(a, (layer), gtid, NGT); }
#define PH_SCAN(layer) { LOADARGS(a); scan::phase(a, lds, (layer), G); }
#define PH_NORM() { LOADARGS(a); THREAD_IDS(); mlstm_norm_phase(a, gtid, NGT); }
#define PH_P3A(layer) { \
              LOADARGS(a); unsigned char* ws = a.ws; \
              pg8::Gemm g{(const bf16_t*)(ws + WS_S0), (const bf16_t*)(ws + WS_WOUTA) + (size_t)(layer) * 1024 * 1024, T, 1024, 1024}; \
              pg8::StaticOrder S; S.init(T, 1024, G, bx); \
              pg8::EpiF E{0, (const bf16_t*)(ws + WS_HB0), (bf16_t*)(ws + WS_HB1), (float*)(ws + WS_SSQ1), nullptr, nullptr, nullptr}; \
              pg8::gemm_phase<pg8::EpiF, pg8::StaticOrder, true, true>(lds + RING_OFF, g, S, E); }
#define PH_P1B(jl, layer) { \
            { LOADARGS(a); unsigned char* ws = a.ws; \
              const int N = ((jl) == 0) ? 3072 : 2048; \
              pg8::Gemm g{(const bf16_t*)(ws + WS_HB0), (const bf16_t*)(ws + ((jl) == 0 ? WS_WINB0 : WS_WINB1)), T, N, 1024}; \
              pg8::StaticOrder S; S.init(T, N, G, bx); \
              pg8::EpiP E{1, (const float*)(ws + WS_SSQ0), ws}; \
              pg8::gemm_phase<pg8::EpiP, pg8::StaticOrder, true, true>(lds + RING_OFF, g, S, E); } \
            { LOADARGS(a); THREAD_IDS(); convert_p(a, (layer), gtid, NGT); } }
#define PH_ATTN(jl) { LOADARGS(a); attn::phase(a, lds, (jl), G); }
#define PH_COMBINE() { LOADARGS(a); THREAD_IDS(); attn_combine_phase(a, gtid, NGT); }
#define PH_P3B(jl) { \
              LOADARGS(a); unsigned char* ws = a.ws; \
              pg8::Gemm g{(const bf16_t*)(ws + WS_S3 + 32 * MiB), (const bf16_t*)(ws + WS_WOUTB) + (size_t)(jl) * 1024 * 512, T, 1024, 512}; \
              pg8::StaticOrder S; S.init(T, 1024, G, bx); \
              pg8::EpiF E{0, (const bf16_t*)(ws + WS_HB0), (bf16_t*)(ws + WS_HB1), (float*)(ws + WS_SSQ1), nullptr, nullptr, nullptr}; \
              pg8::gemm_phase<pg8::EpiF, pg8::StaticOrder, true, true>(lds + RING_OFF, g, S, E); }
#define PH_PP(layer) { \
            LOADARGS(a); unsigned char* ws = a.ws; \
            pg8::Gemm g2{(const bf16_t*)(ws + WS_PB), (const bf16_t*)(ws + WS_WPLE) + (size_t)(layer) * 1024 * 256, T, 1024, 256}; \
            pg8::StaticOrder S; S.init(T, 1024, G, bx); \
            pg8::EpiP E2{2, nullptr, ws}; \
            pg8::gemm_phase<pg8::EpiP, pg8::StaticOrder, true, true>(lds + RING_OFF, g2, S, E2); }
#define PH_P4(layer) { \
            LOADARGS(a); unsigned char* ws = a.ws; \
            pg8::Gemm g{(const bf16_t*)(ws + WS_HB1), (const bf16_t*)(ws + WS_WGATE) + (size_t)(layer) * 1024 * 1024, T, 1024, 1024}; \
            pg8::StaticOrder S; S.init(T, 1024, G, bx); \
            pg8::EpiF E{1, (const bf16_t*)(ws + WS_HB1), (bf16_t*)(ws + WS_HB0), (float*)(ws + WS_SSQ0), (const float*)(ws + WS_SSQ1), (const bf16_t*)(ws + WS_S1), ((layer) == DEPTH - 1) ? a.out : nullptr}; \
            pg8::gemm_phase<pg8::EpiF, pg8::StaticOrder, true, true>(lds + RING_OFF, g, S, E); }

#if defined(PROBE_KIND)
#define REP(kind) _Pragma("nounroll") for (int r_ = 0; r_ < ((PROBE_KIND == (kind) && pass == 0) ? PROBE_REPS : 1); ++r_)
#define LASTBAR() GRID_BAR()
#pragma nounroll
    for (int pass = 0; pass < 2; ++pass) {
#else
#define REP(kind)
#define LASTBAR() if (layer < DEPTH - 1) GRID_BAR()
    {
#endif
    REP(1) { PH_PROLOGUE(); GRID_BAR(); }
#pragma nounroll
    for (int layer = 0; layer < DEPTH; ++layer) {
        if (layer < 2) {
            REP(4) { PH_P1A(layer); GRID_BAR(); }
            REP(12) { PH_CONV(layer); GRID_BAR(); }
            REP(2) { PH_SCAN(layer); GRID_BAR(); }
            REP(6) { PH_NORM(); GRID_BAR(); }
            REP(9) { PH_P3A(layer); }
        } else {
            const int jl = layer - 2;
            REP(11) { PH_P1B(jl, layer); GRID_BAR(); }
            REP(3) { PH_ATTN(jl); GRID_BAR(); }
            REP(7) { PH_COMBINE(); GRID_BAR(); }
            REP(10) { PH_P3B(jl); }
        }
        REP(8) { PH_PP(layer); }
        GRID_BAR();
        REP(5) { PH_P4(layer); LASTBAR(); }
    }
    }
#endif
}

extern "C" void kernel_launch(void* const* d_in, const int* in_sizes, int n_in, void* d_out, int out_size, void* d_ws, size_t ws_size, hipStream_t stream) {
    static int grid = 0;
    if (grid == 0) {
        if (n_in != 18 || in_sizes[0] != T * D || out_size != T * D || ws_size < WS_END) { fprintf(stderr, "kernel_launch: unexpected shapes (n_in %d, in0 %d, out %d, ws %zu)\n", n_in, n_in > 0 ? in_sizes[0] : -1, out_size, ws_size); grid = -1; return; }
        int dev = 0, cus = 0, per_cu = 0;
        if (hipGetDevice(&dev) != hipSuccess || hipDeviceGetAttribute(&cus, hipDeviceAttributeMultiprocessorCount, dev) != hipSuccess) { fprintf(stderr, "kernel_launch: device query failed\n"); grid = -1; return; }
        if (hipFuncSetAttribute((const void*)fwd_megakernel, hipFuncAttributeMaxDynamicSharedMemorySize, LDS_BYTES) != hipSuccess) { fprintf(stderr, "kernel_launch: hipFuncSetAttribute failed\n"); grid = -1; return; }
        if (hipOccupancyMaxActiveBlocksPerMultiprocessor(&per_cu, (const void*)fwd_megakernel, NTHR, LDS_BYTES) != hipSuccess || per_cu < 1)
            fprintf(stderr, "kernel_launch: note: occupancy query reports %d workgroups per CU\n", per_cu);
        (void)hipGetLastError();
        grid = cus;
        if (grid > 256) grid = 256;
    }
    if (grid < 0) return;
    if (hipMemsetAsync((char*)d_ws + WS_CTL, 0, CTL_ZERO_BYTES, stream) != hipSuccess) { fprintf(stderr, "kernel_launch: memset failed\n"); return; }
    Args a{};
    a.x = (const float*)d_in[0]; a.p = (const float*)d_in[1]; a.norm_a = (const float*)d_in[2]; a.w_in_a = (const float*)d_in[3]; a.conv_a = (const float*)d_in[4];
    a.b_gate_a = (const float*)d_in[5]; a.hnorm_a = (const float*)d_in[6]; a.w_out_a = (const float*)d_in[7]; a.norm_kv = (const float*)d_in[8]; a.w_kv = (const float*)d_in[9];
    a.knorm = (const float*)d_in[10]; a.norm_b = (const float*)d_in[11]; a.w_in_b = (const float*)d_in[12]; a.qnorm_b = (const float*)d_in[13]; a.w_out_b = (const float*)d_in[14];
    a.ple_norm = (const float*)d_in[15]; a.w_ple_gate = (const float*)d_in[16]; a.w_ple = (const float*)d_in[17];
    a.out = (float*)d_out; a.ws = (unsigned char*)d_ws;
    hipLaunchKernelGGL(fwd_megakernel, dim3(grid), dim3(NTHR), LDS_BYTES, stream, a);
    const hipError_t le = hipPeekAtLastError();
    if (le != hipSuccess) fprintf(stderr, "kernel_launch: launch failed: %s\n", hipGetErrorName(le));
}
```

```cpp
#include <hip/hip_runtime.h>
#include <cstdio>
#include <cstdint>

#define LAS __attribute__((address_space(3)))
#define GAS __attribute__((address_space(1)))
typedef unsigned short bf16_t;
typedef short bf16x8 __attribute__((ext_vector_type(8)));
typedef float f32x4 __attribute__((ext_vector_type(4)));
typedef unsigned u32x4 __attribute__((ext_vector_type(4)));
typedef unsigned u32x2 __attribute__((ext_vector_type(2)));

constexpr int BATCH = 8, SEQ = 4096, T = BATCH * SEQ, D = 1024, DEPTH = 4, PLE = 256;
constexpr int A_COLS = 4104;
constexpr float EPS = 1e-6f;

typedef __bf16 bf16x2_t __attribute__((ext_vector_type(2)));
typedef float f32x2_t __attribute__((ext_vector_type(2)));
__device__ __forceinline__ unsigned cvt_pk_bf16(float lo, float hi) { const f32x2_t v = {lo, hi}; return __builtin_bit_cast(unsigned, __builtin_convertvector(v, bf16x2_t)); }
__device__ __forceinline__ float bf_lo(unsigned w) { return __uint_as_float(w << 16); }
__device__ __forceinline__ float bf_hi(unsigned w) { return __uint_as_float(w & 0xffff0000u); }
__device__ __forceinline__ float bf2f(bf16_t b) { return __uint_as_float(((unsigned)b) << 16); }
__device__ __forceinline__ bf16_t f2bf(float f) { return (bf16_t)(cvt_pk_bf16(f, 0.f) & 0xffffu); }
__device__ __forceinline__ float sigmoidf_(float x) { return 1.f / (1.f + __expf(-x)); }
__device__ __forceinline__ float ssq16_rstd(const float* ssq, int row) {
    const f32x4* p = (const f32x4*)(ssq + (size_t)row * 16);
    const f32x4 a = p[0], b = p[1], c = p[2], d = p[3];
    const float s = ((a.x + a.y) + (a.z + a.w)) + ((b.x + b.y) + (b.z + b.w)) + ((c.x + c.y) + (c.z + c.w)) + ((d.x + d.y) + (d.z + d.w));
    return rsqrtf(s * (1.f / 1024.f) + EPS);
}

constexpr size_t WS_S0_ = (size_t)208 << 20, WS_S1_ = (size_t)272 << 20, WS_S2_ = (size_t)336 << 20, WS_S3_ = (size_t)400 << 20;
namespace pg8 {
#define PG8_LAS __attribute__((address_space(3)))
constexpr int BM = 256, BK = 64, HALF = 128, HTB = HALF * BK * 2, STAGE_BYTES = 8 * HTB, NXCD = 8, WGM = 8;
__host__ __device__ __forceinline__ int lds_byte(int r, int c) { const int st = (r >> 4) * 2 + (c >> 5), rr = r & 15, cc = c & 31, ob = rr * 64 + cc * 2; return st * 1024 + (ob ^ (((ob >> 9) & 1) << 5)); }
__host__ __device__ __forceinline__ void stage_rc(int b, int& R, int& C) { const int st = b / 1024, sb = b % 1024, swz = sb ^ (((sb >> 9) & 1) << 5); R = (st >> 1) * 16 + swz / 64; C = (st & 1) * 32 + (swz % 64) / 2; }
__host__ __device__ __forceinline__ int perm32(int rho) { const int n = rho >> 4, i = rho & 15; return 8 * (i >> 2) + 4 * n + (i & 3); }

struct Unit { int pm, pn; };
struct Gemm { const bf16_t* A; const bf16_t* Bt; int M, N, K; };
struct StaticOrder {
    int nM, nN, nwg, G, c;
    __host__ __device__ void init(int M, int N, int G_, int c_) { nM = M / BM; nN = N / BM; nwg = nM * nN; G = G_; c = c_; }
    __host__ __device__ bool next(int i, Unit& u) const {
        const long L = (long)i * G + c; if (L >= nwg) return false;
        int wgid = (int)L; { const int q = nwg / NXCD, r = nwg % NXCD, xcd = wgid % NXCD, off = wgid / NXCD; wgid = (xcd < r ? xcd * (q + 1) : r * (q + 1) + (xcd - r) * q) + off; }
        const int nig = WGM * nN, gid = wgid / nig, fm = gid * WGM, gsz = (nM - fm) < WGM ? (nM - fm) : WGM;
        u.pm = fm + ((wgid % nig) % gsz); u.pn = (wgid % nig) / gsz; return true;
    }
    __device__ __forceinline__ void a_ready(const Unit&) const {}
    __device__ __forceinline__ void done(const Unit&) const {}
};


struct EpiP {
    static constexpr bool PERM = true, AFTER_DRAIN = false;
    int mode; const float* ssq; unsigned char* ws; const float* qg; const float* kg; PG8_LAS unsigned char* lds;
    __device__ __forceinline__ void operator()(const f32x4 (&acc)[2][2][4][2], const Unit& u, int wr, int wc, int fr, int fq) const {
        const int row0 = u.pm * BM + wr * 64 + fr;
        size_t boff; int ldc, colt, act = 0;
        if (mode == 0) { const int ten = u.pn >> 2; boff = WS_S0_ + (size_t)ten * (64u << 20); ldc = 1024; colt = (u.pn & 3) * 256; act = ten == 2 ? 1 : ten == 3 ? 2 : 0; }
        else if (mode == 1) {
            if (u.pn < 6) { boff = WS_S1_; ldc = 1536; colt = u.pn * 256; act = 3; }
            else if (u.pn < 8) { boff = WS_S3_; ldc = 512; colt = (u.pn - 6) * 256; act = 2; }
            else if (u.pn < 10) { boff = WS_S0_; ldc = 512; colt = (u.pn - 8) * 256; act = 3; }
            else { boff = WS_S0_ + (32u << 20); ldc = 512; colt = (u.pn - 10) * 256; }
        } else { boff = WS_S1_; ldc = 1024; colt = u.pn * 256; }
        bf16_t* base = (bf16_t*)(ws + boff);
        if (act == 3) {
            PG8_LAS float* X = (PG8_LAS float*)(lds + 131072);
            const float* gn = (u.pn < 6) ? qg : kg;
            const float* COS = (const float*)(ws + ((size_t)2 << 20)); const float* SIN = (const float*)(ws + ((size_t)3 << 20));
#pragma unroll
            for (int ai = 0; ai < 2; ++ai)
#pragma unroll
                for (int m = 0; m < 4; ++m) {
                    const int rl = ai * HALF + wr * 64 + m * 16 + fr;
                    const float rs = ssq16_rstd(ssq, u.pm * BM + rl);
#pragma unroll
                    for (int bj = 0; bj < 2; ++bj) {
                        const f32x4 v0 = acc[ai][bj][m][0] * rs, v1 = acc[ai][bj][m][1] * rs;
                        float sq = (v0[0] * v0[0] + v0[1] * v0[1]) + (v0[2] * v0[2] + v0[3] * v0[3]) + (v1[0] * v1[0] + v1[1] * v1[1]) + (v1[2] * v1[2] + v1[3] * v1[3]);
                        sq += __shfl_xor(sq, 16); sq += __shfl_xor(sq, 32);
                        if (fq == 0) X[(rl * 2 + bj) * 4 + wc] = sq;
                    }
                }
            asm volatile("s_waitcnt lgkmcnt(0)" ::: "memory"); __builtin_amdgcn_s_barrier(); asm volatile("" ::: "memory");
            const int d0 = 16 * wc + 4 * fq;
            const f32x4 g1 = *(const f32x4*)(gn + d0), g2 = *(const f32x4*)(gn + 64 + d0);
#pragma unroll
            for (int ai = 0; ai < 2; ++ai)
#pragma unroll
                for (int m = 0; m < 4; ++m) {
                    const int rl = ai * HALF + wr * 64 + m * 16 + fr, row = u.pm * BM + rl, pos = row & (SEQ - 1);
                    const float rs = ssq16_rstd(ssq, row);
                    const f32x4 cs = *(const f32x4*)(COS + pos * 64 + d0), sn = *(const f32x4*)(SIN + pos * 64 + d0);
#pragma unroll
                    for (int bj = 0; bj < 2; ++bj) {
                        const f32x4 xs = *(const PG8_LAS f32x4*)(X + (rl * 2 + bj) * 4);
                        const float rh = rs * rsqrtf(((xs[0] + xs[1]) + (xs[2] + xs[3])) * (1.f / 128.f) + EPS);
                        const f32x4 x1 = acc[ai][bj][m][0] * rh * g1, x2 = acc[ai][bj][m][1] * rh * g2;
                        const f32x4 o1 = x1 * cs - x2 * sn, o2 = x2 * cs + x1 * sn;
                        bf16_t* p = base + (size_t)row * ldc + colt + bj * HALF + d0;
                        u32x2 w1, w2; w1.x = cvt_pk_bf16(o1[0], o1[1]); w1.y = cvt_pk_bf16(o1[2], o1[3]); w2.x = cvt_pk_bf16(o2[0], o2[1]); w2.y = cvt_pk_bf16(o2[2], o2[3]);
                        *(u32x2*)p = w1; *(u32x2*)(p + 64) = w2;
                    }
                    asm volatile("" ::: "memory");
                }
            return;
        }
        const int col0 = colt + wc * 32 + 8 * fq;
#pragma unroll
        for (int ai = 0; ai < 2; ++ai)
#pragma unroll
            for (int m = 0; m < 4; ++m) {
                const int row = row0 + ai * HALF + m * 16;
                const float rs = (mode == 2) ? 1.f : ssq16_rstd(ssq, row);
                bf16_t* rowp = base + (size_t)row * ldc + col0;
#pragma unroll
                for (int bj = 0; bj < 2; ++bj) {
                    f32x4 v0 = acc[ai][bj][m][0] * rs, v1 = acc[ai][bj][m][1] * rs;
                    if (act == 1) {
#pragma unroll
                        for (int j = 0; j < 4; ++j) { v0[j] = sigmoidf_(v0[j]); v1[j] = sigmoidf_(v1[j]); }
                    } else if (act == 2) {
#pragma unroll
                        for (int j = 0; j < 4; ++j) { v0[j] = v0[j] * sigmoidf_(v0[j]); v1[j] = v1[j] * sigmoidf_(v1[j]); }
                    }
                    u32x4 w; w.x = cvt_pk_bf16(v0[0], v0[1]); w.y = cvt_pk_bf16(v0[2], v0[3]); w.z = cvt_pk_bf16(v1[0], v1[1]); w.w = cvt_pk_bf16(v1[2], v1[3]);
                    *(u32x4*)(rowp + bj * HALF) = w;
                }
                asm volatile("" ::: "memory");
            }
    }
};
struct EpiF {
    static constexpr bool PERM = false, AFTER_DRAIN = false;
    int mode; const bf16_t* hres; bf16_t* hb; float* ssq_out; const float* ssq_in; const bf16_t* pp; float* fout;
    __device__ __forceinline__ void operator()(const f32x4 (&acc)[2][2][4][2], const Unit& u, int wr, int wc, int fr, int fq) const {
        const int row0 = u.pm * BM + wr * 64 + fr, col0 = u.pn * BM + wc * 32 + 4 * fq;
#pragma unroll
        for (int ai = 0; ai < 2; ++ai)
#pragma unroll
            for (int m = 0; m < 4; ++m) {
                const int row = row0 + ai * HALF + m * 16;
                const size_t off = (size_t)row * 1024 + col0;
                float rs = 1.f; if (mode == 1) rs = ssq16_rstd(ssq_in, row);
                float sq = 0.f;
#pragma unroll
                for (int bj = 0; bj < 2; ++bj)
#pragma unroll
                    for (int n = 0; n < 2; ++n) {
                        const size_t o = off + bj * HALF + n * 16;
                        const u32x2 hw = *(const u32x2*)(hres + o);
                        f32x4 v = acc[ai][bj][m][n];
                        if (mode == 1) {
                            const u32x2 pw = *(const u32x2*)(pp + o);
                            v[0] = bf_lo(pw.x) * sigmoidf_(v[0] * rs); v[1] = bf_hi(pw.x) * sigmoidf_(v[1] * rs);
                            v[2] = bf_lo(pw.y) * sigmoidf_(v[2] * rs); v[3] = bf_hi(pw.y) * sigmoidf_(v[3] * rs);
                        }
                        f32x4 hn; hn[0] = bf_lo(hw.x) + v[0]; hn[1] = bf_hi(hw.x) + v[1]; hn[2] = bf_lo(hw.y) + v[2]; hn[3] = bf_hi(hw.y) + v[3];
                        if (fout) *(f32x4*)(fout + o) = hn;
                        else { u32x2 w; w.x = cvt_pk_bf16(hn[0], hn[1]); w.y = cvt_pk_bf16(hn[2], hn[3]); *(u32x2*)(hb + o) = w; }
                        sq += (hn[0] * hn[0] + hn[1] * hn[1]) + (hn[2] * hn[2] + hn[3] * hn[3]);
                    }
                sq += __shfl_xor(sq, 16); sq += __shfl_xor(sq, 32);
                if (fq == 0 && !fout) ssq_out[(size_t)row * 16 + u.pn * 4 + wc] = sq;
                asm volatile("" ::: "memory");
            }
    }
};

template <class Epi, class Sched, bool ALIGN_EPI = false, bool SP2 = false>
__device__ __forceinline__ void gemm_phase(PG8_LAS unsigned char* lds, const Gemm g, const Sched& S, const Epi& E) {
    int tid = threadIdx.x; asm volatile("" : "+v"(tid));
    const int wid = __builtin_amdgcn_readfirstlane(tid >> 6), lane = tid & 63, wr = wid >> 2, wc = wid & 3, fr = lane & 15, fq = lane >> 4;
    const int K = g.K, nt = K / BK;
    unsigned voffA[2], voffB[2];
#pragma unroll
    for (int i = 0; i < 2; ++i) { int R, C; stage_rc(tid * 16 + i * 8192, R, C); const int Rb = Epi::PERM ? ((R & ~31) + perm32(R & 31)) : R;
        voffA[i] = (unsigned)(R * K + C) * 2u; voffB[i] = (unsigned)(Rb * K + C) * 2u; }
    const size_t kstep = (size_t)(BK * 2);
    const size_t hstep = (size_t)HALF * K * 2;
    const size_t tstep = 2 * hstep;
    const unsigned ldsw = (unsigned)wid * 1024u;
    const int aoff = lds_byte(wr * 64 + fr, fq * 8), boff = lds_byte(wc * 32 + fr, fq * 8);
#define PG8_SA(b, h) (((b) * 2 + (h)) * HTB)
#define PG8_SB(b, h) ((4 + (b) * 2 + (h)) * HTB)
#define PG8_STAGE(bufoff, gbase, voff) do { _Pragma("unroll") for (int _i = 0; _i < 2; ++_i) \
        __builtin_amdgcn_global_load_lds((const unsigned*)((const char*)(gbase) + (voff)[_i]), (PG8_LAS unsigned*)(lds + (bufoff) + ldsw + _i * 8192), 16, 0, 0); } while (0)
#define PG8_LDA(dst, b, h) do { _Pragma("unroll") for (int m = 0; m < 4; ++m) _Pragma("unroll") for (int k = 0; k < 2; ++k) dst[m][k] = *(const PG8_LAS bf16x8*)(lds + PG8_SA(b, h) + aoff + m * 2048 + k * 1024); } while (0)
#define PG8_LDB(dst, b, h) do { _Pragma("unroll") for (int n = 0; n < 2; ++n) _Pragma("unroll") for (int k = 0; k < 2; ++k) dst[n][k] = *(const PG8_LAS bf16x8*)(lds + PG8_SB(b, h) + boff + n * 2048 + k * 1024); } while (0)
#define PG8_MMA(ai, bj, At, Bt) do { __builtin_amdgcn_s_setprio(1); _Pragma("unroll") for (int m = 0; m < 4; ++m) _Pragma("unroll") for (int n = 0; n < 2; ++n) _Pragma("unroll") for (int k = 0; k < 2; ++k) \
        acc[ai][bj][m][n] = __builtin_amdgcn_mfma_f32_16x16x32_bf16(Bt[n][k], At[m][k], acc[ai][bj][m][n], 0, 0, 0); __builtin_amdgcn_s_setprio(0); } while (0)
#define PG8_WAIT_V(n) asm volatile("s_waitcnt vmcnt(" #n ")" ::: "memory")
#define PG8_WAIT_L(n) asm volatile("s_waitcnt lgkmcnt(" #n ")" ::: "memory")
#define PG8_BAR __builtin_amdgcn_s_barrier()
#define PG8_SCHED __builtin_amdgcn_sched_barrier(0)
    Unit cur, nxt; int ui = 0;
    if (!S.next(0, cur)) return;
    f32x4 acc[2][2][4][2];
#pragma unroll
    for (int a = 0; a < 2; ++a)
#pragma unroll
        for (int b = 0; b < 2; ++b)
#pragma unroll
            for (int m = 0; m < 4; ++m)
#pragma unroll
                for (int n = 0; n < 2; ++n) acc[a][b][m][n] = (f32x4){0.f, 0.f, 0.f, 0.f};
    bf16x8 At[4][2], B0[2][2], B1[2][2];
    const char* cA = (const char*)g.A + (size_t)cur.pm * tstep; const char* cB = (const char*)g.Bt + (size_t)cur.pn * tstep;
    S.a_ready(cur);
    if constexpr (SP2) {
        PG8_STAGE(PG8_SB(0, 0), cB, voffB); PG8_STAGE(PG8_SB(0, 1), cB + hstep, voffB); PG8_STAGE(PG8_SA(0, 0), cA, voffA); PG8_STAGE(PG8_SA(0, 1), cA + hstep, voffA);
        if (wr == 1) PG8_BAR;
        PG8_WAIT_V(2); PG8_BAR;
        PG8_STAGE(PG8_SB(1, 0), cB + kstep, voffB); PG8_STAGE(PG8_SA(1, 0), cA + kstep, voffA); PG8_STAGE(PG8_SB(1, 1), cB + hstep + kstep, voffB);
        PG8_WAIT_V(6); PG8_BAR;
    } else {
        PG8_STAGE(PG8_SB(0, 0), cB, voffB); PG8_STAGE(PG8_SA(0, 0), cA, voffA); PG8_STAGE(PG8_SB(0, 1), cB + hstep, voffB); PG8_STAGE(PG8_SA(0, 1), cA + hstep, voffA);
        if (wr == 1) PG8_BAR;
        PG8_WAIT_V(4); PG8_BAR;
        PG8_STAGE(PG8_SB(1, 0), cB + kstep, voffB); PG8_STAGE(PG8_SA(1, 0), cA + kstep, voffA); PG8_STAGE(PG8_SB(1, 1), cB + hstep + kstep, voffB);
        PG8_WAIT_V(6); PG8_BAR;
    }
    for (;;) {
        const bool has_next = S.next(ui + 1, nxt);
        const char* nA = has_next ? (const char*)g.A + (size_t)nxt.pm * tstep : cA; const char* nB = has_next ? (const char*)g.Bt + (size_t)nxt.pn * tstep : cB;
        for (int t = 0; t < nt; t += 2) {
            const bool last = (t == nt - 2);
            const char* a1 = cA + (size_t)(t + 1) * kstep;
            const char* a2 = last ? nA : cA + (size_t)(t + 2) * kstep; const char* b2 = last ? nB : cB + (size_t)(t + 2) * kstep;
            const char* a3 = a2 + kstep; const char* b3 = b2 + kstep;
            if (last && has_next) S.a_ready(nxt);
            if constexpr (SP2) {
            PG8_LDB(B0, 0, 0); PG8_LDB(B1, 0, 1); PG8_SCHED; PG8_LDA(At, 0, 0); PG8_STAGE(PG8_SA(1, 1), a1 + hstep, voffA);
            PG8_WAIT_V(8); PG8_WAIT_L(0); PG8_BAR; PG8_MMA(0, 0, At, B0); PG8_MMA(0, 1, At, B1); PG8_BAR; PG8_SCHED;
            PG8_LDA(At, 0, 1); PG8_STAGE(PG8_SB(0, 0), b2, voffB); PG8_STAGE(PG8_SB(0, 1), b2 + hstep, voffB); PG8_STAGE(PG8_SA(0, 0), a2, voffA);
            PG8_WAIT_V(8); PG8_WAIT_L(0); PG8_BAR; PG8_MMA(1, 0, At, B0); PG8_MMA(1, 1, At, B1); PG8_BAR; PG8_SCHED;
            PG8_LDB(B0, 1, 0); PG8_LDB(B1, 1, 1); PG8_SCHED; PG8_LDA(At, 1, 0); PG8_STAGE(PG8_SA(0, 1), a2 + hstep, voffA);
            PG8_WAIT_V(8); PG8_WAIT_L(0); PG8_BAR; PG8_MMA(0, 0, At, B0); PG8_MMA(0, 1, At, B1); PG8_BAR; PG8_SCHED;
            PG8_LDA(At, 1, 1); PG8_STAGE(PG8_SB(1, 0), b3, voffB); PG8_STAGE(PG8_SB(1, 1), b3 + hstep, voffB); PG8_STAGE(PG8_SA(1, 0), a3, voffA);
            PG8_WAIT_V(8); PG8_WAIT_L(0); PG8_BAR; PG8_MMA(1, 0, At, B0); PG8_MMA(1, 1, At, B1); PG8_BAR; PG8_SCHED;
            } else {
            PG8_LDB(B0, 0, 0); PG8_SCHED; PG8_LDA(At, 0, 0); PG8_STAGE(PG8_SA(1, 1), a1 + hstep, voffA);
            PG8_WAIT_L(8); PG8_BAR; PG8_WAIT_L(0); PG8_MMA(0, 0, At, B0); PG8_BAR; PG8_SCHED;
            PG8_LDB(B1, 0, 1); PG8_STAGE(PG8_SB(0, 0), b2, voffB);
            PG8_BAR; PG8_WAIT_L(0); PG8_MMA(0, 1, At, B1); PG8_BAR;
            PG8_LDA(At, 0, 1); PG8_STAGE(PG8_SA(0, 0), a2, voffA);
            PG8_BAR; PG8_WAIT_L(0); PG8_MMA(1, 0, At, B0); PG8_BAR; PG8_SCHED;
            PG8_STAGE(PG8_SB(0, 1), b2 + hstep, voffB);
            PG8_WAIT_V(6); PG8_BAR; PG8_MMA(1, 1, At, B1); PG8_BAR;
            PG8_LDB(B0, 1, 0); PG8_SCHED; PG8_LDA(At, 1, 0); PG8_STAGE(PG8_SA(0, 1), a2 + hstep, voffA);
            PG8_WAIT_L(8); PG8_BAR; PG8_WAIT_L(0); PG8_MMA(0, 0, At, B0); PG8_BAR; PG8_SCHED;
            PG8_LDB(B1, 1, 1); PG8_STAGE(PG8_SB(1, 0), b3, voffB);
            PG8_BAR; PG8_WAIT_L(0); PG8_MMA(0, 1, At, B1); PG8_BAR;
            PG8_LDA(At, 1, 1); PG8_STAGE(PG8_SA(1, 0), a3, voffA);
            PG8_BAR; PG8_WAIT_L(0); PG8_MMA(1, 0, At, B0); PG8_BAR; PG8_SCHED;
            PG8_STAGE(PG8_SB(1, 1), b3 + hstep, voffB);
            PG8_WAIT_V(6); PG8_BAR; PG8_MMA(1, 1, At, B1); PG8_BAR;
            }
        }
        if constexpr (ALIGN_EPI) { if (wr == 0) PG8_BAR; }
        if constexpr (!Epi::AFTER_DRAIN) { E(acc, cur, wr, wc, fr, fq); S.done(cur); }
        if (!has_next) break;
#pragma unroll
        for (int a = 0; a < 2; ++a)
#pragma unroll
            for (int b = 0; b < 2; ++b)
#pragma unroll
                for (int m = 0; m < 4; ++m)
#pragma unroll
                    for (int n = 0; n < 2; ++n) acc[a][b][m][n] = (f32x4){0.f, 0.f, 0.f, 0.f};
        cur = nxt; cA = nA; cB = nB; ++ui;
        if constexpr (ALIGN_EPI) { if (wr == 1) PG8_BAR; }
    }
    PG8_WAIT_V(0);
    if constexpr (!ALIGN_EPI) { if (wr == 0) PG8_BAR; }
    PG8_BAR;
#undef PG8_SA
#undef PG8_SB
#undef PG8_STAGE
#undef PG8_LDA
#undef PG8_LDB
#undef PG8_MMA
#undef PG8_WAIT_V
#undef PG8_WAIT_L
#undef PG8_BAR
#undef PG8_SCHED
}
}

constexpr size_t MiB = 1u << 20;
constexpr size_t WS_CTL = 0, CTL_ZERO_BYTES = 1 * MiB;
constexpr size_t WS_COS = 2 * MiB, WS_SIN = 3 * MiB;
constexpr size_t WS_WG8 = 4 * MiB;
constexpr size_t WS_GATES = 5 * MiB;
constexpr size_t WS_LSE = 6 * MiB;
constexpr size_t WS_SSQ0 = 8 * MiB, WS_SSQ1 = 10 * MiB;
constexpr size_t WS_SSQH = 12 * MiB;
constexpr size_t WS_WINA = 16 * MiB;
constexpr size_t WS_WOUTA = 32 * MiB;
constexpr size_t WS_WINB0 = 36 * MiB;
constexpr size_t WS_WINB1 = 42 * MiB;
constexpr size_t WS_WOUTB = 46 * MiB;
constexpr size_t WS_WGATE = 48 * MiB;
constexpr size_t WS_WPLE = 56 * MiB;
constexpr size_t WS_HB0 = 64 * MiB, WS_HB1 = 128 * MiB;
constexpr size_t WS_PB = 192 * MiB;
constexpr size_t WS_S0 = WS_S0_, WS_S1 = WS_S1_, WS_S2 = WS_S2_, WS_S3 = WS_S3_, WS_END = 464 * MiB;
constexpr int CW_BAR = 4096;

#define XB_TMO      128
#define XB_XCNT(j)  (256  + 64 * (j))
#define XB_XSUB(j)  (1280 + 64 * (j))
#define XB_XGEN(j)  (2304 + 64 * (j))
#define XB_TOP      3328
#define XB_TOPGEN   3392
#define XCD_BAR_WORDS 3456
#define XB_SPIN_CAP (1u << 18)
__device__ __forceinline__ unsigned xb_ld(unsigned* p)              { return __hip_atomic_load(p, __ATOMIC_RELAXED, __HIP_MEMORY_SCOPE_AGENT); }
__device__ __forceinline__ unsigned xb_add(unsigned* p, unsigned v) { return __hip_atomic_fetch_add(p, v, __ATOMIC_RELAXED, __HIP_MEMORY_SCOPE_AGENT); }
__device__ __forceinline__ unsigned xb_xcc_id() { return (unsigned)__builtin_amdgcn_s_getreg((3 << 11) | 20) & 0xFu; }
#define XB_SPIN(cond, bar) do { unsigned _sp = 0; while (cond) { __builtin_amdgcn_s_sleep(1); \
    if ((++_sp & 255u) == 0u) { if (xb_ld(&(bar)[XB_TMO])) break; if (_sp > XB_SPIN_CAP) { atomicAdd(&(bar)[XB_TMO], 1u); break; } } } } while (0)
struct XcdBarrier { unsigned* bar; unsigned x; volatile LAS unsigned* st; };
__device__ __forceinline__ XcdBarrier xcd_barrier_post(unsigned* bar, volatile LAS unsigned* st) {
    XcdBarrier b; b.bar = bar; b.x = xb_xcc_id(); b.st = st;
    if (threadIdx.x == 0) (void)xb_add(&bar[XB_XCNT(b.x)], 1u);
    return b;
}
__device__ __forceinline__ void xcd_barrier_complete(unsigned* bar, unsigned x, unsigned& nloc, unsigned& nx) {
    const unsigned G = gridDim.x * gridDim.y * gridDim.z;
    unsigned sum, cnt, mine, sp = 0u;
    for (;;) {
        sum = 0u; cnt = 0u; mine = 0u;
#pragma unroll
        for (unsigned j = 0; j < 16; ++j) { const unsigned c = xb_ld(&bar[XB_XCNT(j)]); sum += c; cnt += (c > 0u) ? 1u : 0u; mine = (j == x) ? c : mine; }
        if (sum == G) break;
        __builtin_amdgcn_s_sleep(1);
        if ((++sp & 255u) == 0u) { if (xb_ld(&bar[XB_TMO])) break; if (sp > XB_SPIN_CAP) { atomicAdd(&bar[XB_TMO], 1u); break; } }
    }
    nloc = mine > 0u ? mine : 1u; nx = cnt > 0u ? cnt : 1u;
}
__device__ __forceinline__ void xcd_barrier(const XcdBarrier& b) {
    asm volatile("s_waitcnt vmcnt(0)" ::: "memory");
    __syncthreads();
    if (threadIdx.x == 0) {
        unsigned* bar = b.bar;
        __builtin_amdgcn_s_waitcnt(0);
        unsigned nloc = b.st[0], nx = b.st[1];
        if (nloc == 0u) { xcd_barrier_complete(bar, b.x, nloc, nx); b.st[0] = nloc; b.st[1] = nx; }
        const unsigned old = xb_add(&bar[XB_XSUB(b.x)], 1u);
        const unsigned gen = old / nloc;
        if (old + 1u == (gen + 1u) * nloc) {
            __builtin_amdgcn_fence(__ATOMIC_RELEASE, "agent");
            asm volatile("s_waitcnt vmcnt(0)" ::: "memory");
            const unsigned og = xb_add(&bar[XB_TOP], 1u);
            const unsigned tg = og / nx;
            if (og + 1u == (tg + 1u) * nx) xb_add(&bar[XB_TOPGEN], 1u);
            else XB_SPIN(xb_ld(&bar[XB_TOPGEN]) == tg, bar);
            __builtin_amdgcn_fence(__ATOMIC_ACQUIRE, "agent");
            xb_add(&bar[XB_XGEN(b.x)], 1u);
            asm volatile("s_waitcnt vmcnt(0)" ::: "memory");
        } else {
            XB_SPIN(xb_ld(&bar[XB_XGEN(b.x)]) == gen, bar);
            __builtin_amdgcn_fence(__ATOMIC_ACQUIRE, "agent");
            asm volatile("s_waitcnt vmcnt(0)" ::: "memory");
        }
    }
    __syncthreads();
}

struct Args {
    const float* x; const float* p; const float* norm_a; const float* w_in_a; const float* conv_a; const float* b_gate_a; const float* hnorm_a; const float* w_out_a;
    const float* norm_kv; const float* w_kv; const float* knorm; const float* norm_b; const float* w_in_b; const float* qnorm_b; const float* w_out_b;
    const float* ple_norm; const float* w_ple_gate; const float* w_ple;
    float* out; unsigned char* ws;
};

constexpr int NWAVES = 8, NTHR = 512;
constexpr int RING_OFF = 0;
constexpr int MISC_OFF = 160 * 1024 - 256;
constexpr int LDS_BYTES = 160 * 1024;

#define LDS_WAIT() asm volatile("s_waitcnt lgkmcnt(0)" ::: "memory")
#define LDS_BARRIER() do { asm volatile("s_waitcnt lgkmcnt(0)" ::: "memory"); __builtin_amdgcn_s_barrier(); asm volatile("" ::: "memory"); } while (0)

__device__ __forceinline__ void transpose_item(const float* W, int K, int ldw, int ncol0, int nblk, const float* gain, bf16_t* WT, int row_off, int nperm, LAS float* scr, int item, int lane) {
    const int kb = item / nblk, nb = item % nblk, k0 = 64 * kb, n0 = 32 * nb;
#pragma unroll 8
    for (int i = 0; i < 32; ++i) { const int kk = 2 * i + (lane >> 5); const float gv = gain ? gain[k0 + kk] : 1.f; scr[kk * 33 + (lane & 31)] = W[(size_t)(k0 + kk) * ldw + ncol0 + n0 + (lane & 31)] * gv; }
    LDS_WAIT(); asm volatile("" ::: "memory");
    const int c = lane & 7;
#pragma unroll
    for (int j = 0; j < 4; ++j) { const int n = (lane >> 3) + 8 * j; const LAS float* s = scr + (8 * c) * 33 + n;
        u32x4 o; o.x = cvt_pk_bf16(s[0 * 33], s[1 * 33]); o.y = cvt_pk_bf16(s[2 * 33], s[3 * 33]); o.z = cvt_pk_bf16(s[4 * 33], s[5 * 33]); o.w = cvt_pk_bf16(s[6 * 33], s[7 * 33]);
        int col = n0 + n; if (col < nperm) { const int d = col & 127; col = (col & ~127) + 32 * ((d & 63) >> 4) + 8 * ((d >> 2) & 3) + 4 * (d >> 6) + (d & 3); }
        *(u32x4*)(WT + (size_t)(row_off + col) * K + k0 + 8 * c) = o; }
    LDS_WAIT(); asm volatile("" ::: "memory");
}

__device__ __forceinline__ void prologue(const Args& a, LAS unsigned char* lds, int gw, int NGW, int lane, int wave) {
    unsigned char* ws = a.ws;
    LAS float* scr = (LAS float*)(lds + wave * 16384);
    struct TJ { const float* W; int K, ldw, ncol0, ncols; const float* gain; bf16_t* dst; int row_off, nperm; };
    int it = gw;
    for (int job = 0; job < 17; ++job) {
        TJ j;
        if (job < 2)       j = TJ{a.w_in_a + (size_t)job * 1024 * A_COLS, 1024, A_COLS, 0, 4096, a.norm_a + job * 1024, (bf16_t*)(ws + WS_WINA) + (size_t)job * 4096 * 1024, 0, 0};
        else if (job < 4)  j = TJ{a.w_out_a + (size_t)(job - 2) * 1024 * 1024, 1024, 1024, 0, 1024, a.hnorm_a + (job - 2) * 1024, (bf16_t*)(ws + WS_WOUTA) + (size_t)(job - 2) * 1024 * 1024, 0, 0};
        else if (job == 4) j = TJ{a.w_in_b, 1024, 2048, 0, 2048, a.norm_b, (bf16_t*)(ws + WS_WINB0), 0, 1536};
        else if (job == 5) j = TJ{a.w_in_b + (size_t)1024 * 2048, 1024, 2048, 0, 2048, a.norm_b + 1024, (bf16_t*)(ws + WS_WINB1), 0, 1536};
        else if (job == 6) j = TJ{a.w_kv, 1024, 1024, 0, 1024, a.norm_kv, (bf16_t*)(ws + WS_WINB0), 2048, 512};
        else if (job < 9)  j = TJ{a.w_out_b + (size_t)(job - 7) * 512 * 1024, 512, 1024, 0, 1024, nullptr, (bf16_t*)(ws + WS_WOUTB) + (size_t)(job - 7) * 1024 * 512, 0, 0};
        else if (job < 13) j = TJ{a.w_ple_gate + (size_t)(job - 9) * 1024 * 1024, 1024, 1024, 0, 1024, a.ple_norm + (job - 9) * 1024, (bf16_t*)(ws + WS_WGATE) + (size_t)(job - 9) * 1024 * 1024, 0, 0};
        else               j = TJ{a.w_ple + (size_t)(job - 13) * 256 * 1024, 256, 1024, 0, 1024, nullptr, (bf16_t*)(ws + WS_WPLE) + (size_t)(job - 13) * 1024 * 256, 0, 0};
        const int nblk = j.ncols / 32, nitems = (j.K / 64) * nblk;
        for (; it < nitems; it += NGW) transpose_item(j.W, j.K, j.ldw, j.ncol0, nblk, j.gain, j.dst, j.row_off, j.nperm, scr, it, lane);
        it -= nitems;
    }
    {
        bf16_t* HB = (bf16_t*)(ws + WS_HB0); float* SSQ = (float*)(ws + WS_SSQ0);
        for (int m = gw; m < T; m += NGW) {
            const f32x4* xr = (const f32x4*)(a.x + (size_t)m * D) + lane;
            f32x4 v[4]; float s = 0.f;
#pragma unroll
            for (int jj = 0; jj < 4; ++jj) { v[jj] = xr[64 * jj]; s += (v[jj].x * v[jj].x + v[jj].y * v[jj].y) + (v[jj].z * v[jj].z + v[jj].w * v[jj].w); }
#pragma unroll
            for (int o = 1; o < 64; o <<= 1) s += __shfl_xor(s, o);
            u32x2* o8 = (u32x2*)(HB + (size_t)m * D) + lane;
#pragma unroll
            for (int jj = 0; jj < 4; ++jj) { u32x2 w; w.x = cvt_pk_bf16(v[jj].x, v[jj].y); w.y = cvt_pk_bf16(v[jj].z, v[jj].w); o8[64 * jj] = w; }
            if (lane < 16) SSQ[(size_t)m * 16 + lane] = lane == 0 ? s : 0.f;
        }
    }
    {
        float* COS = (float*)(ws + WS_COS); float* SIN = (float*)(ws + WS_SIN);
        for (int i = gw * 64 + lane; i < SEQ * 64; i += NGW * 64) {
            const int pos = i >> 6, fi = i & 63;
            const float crev = exp2f(-(float)fi * (13.287712379549449f / 64.0f)) * 0.15915494309189535f;
            float tr = (float)pos * crev; tr -= rintf(tr);
            COS[i] = __builtin_amdgcn_cosf(tr); SIN[i] = __builtin_amdgcn_sinf(tr);
        }
    }
    {
        bf16_t* WG = (bf16_t*)(ws + WS_WG8);
        for (int i = gw * 64 + lane; i < 2 * 16 * 1024; i += NGW * 64) {
            const int l = i >> 14, jj = (i >> 10) & 15, k = i & 1023;
            WG[i] = (jj < 8) ? f2bf(a.w_in_a[(size_t)l * 1024 * A_COLS + (size_t)k * A_COLS + 4096 + jj] * a.norm_a[l * 1024 + k]) : (bf16_t)0;
        }
    }
}

__device__ __forceinline__ void convert_p(const Args& a, int layer, int gtid, int NGT) {
    const f32x4* src = (const f32x4*)(a.p + (size_t)layer * T * PLE);
    u32x4* dst = (u32x4*)(a.ws + WS_PB);
    for (int i = gtid; i < T * PLE / 8; i += NGT) {
        const f32x4 v0 = src[2 * i], v1 = src[2 * i + 1];
        u32x4 w; w.x = cvt_pk_bf16(v0.x, v0.y); w.y = cvt_pk_bf16(v0.z, v0.w); w.z = cvt_pk_bf16(v1.x, v1.y); w.w = cvt_pk_bf16(v1.z, v1.w);
        dst[i] = w;
    }
}

__device__ __forceinline__ void gates_job(const Args& a, int layer, const bf16_t* HB, const float* SSQ, int gw, int NGW, int lane) {
    const bf16_t* WG = (const bf16_t*)(a.ws + WS_WG8) + (size_t)layer * 16 * 1024;
    float* GATES = (float*)(a.ws + WS_GATES);
    const int ql = lane & 15, grp = lane >> 4;
#pragma nounroll
    for (int t0 = gw * 16; t0 < T; t0 += NGW * 16) {
        const bf16_t* arow = HB + (size_t)(t0 + ql) * D + 8 * grp;
        const bf16_t* brow = WG + ql * 1024 + 8 * grp;
        f32x4 acc = (f32x4){0.f, 0.f, 0.f, 0.f};
#pragma unroll 8
        for (int ks = 0; ks < 32; ++ks) acc = __builtin_amdgcn_mfma_f32_16x16x32_bf16(*(const bf16x8*)(arow + 32 * ks), *(const bf16x8*)(brow + 32 * ks), acc, 0, 0, 0);
        if (ql < 8) {
            const float bias = a.b_gate_a[layer * 8 + ql];
#pragma unroll
            for (int ii = 0; ii < 4; ++ii) { const int t = t0 + 4 * grp + ii; GATES[(size_t)t * 8 + ql] = acc[ii] * ssq16_rstd(SSQ, t) + bias; }
        }
    }
}

__device__ __forceinline__ void conv_phase(const Args& a, int layer, int gtid, int NGT) {
    const bf16_t* QKb = (const bf16_t*)(a.ws + WS_S0); bf16_t* QC = (bf16_t*)(a.ws + WS_HB1);
#pragma nounroll
    for (int task = gtid; task < (T / 16) * 128; task += NGT) {
        const int cgp = task & 127, run = task >> 7, t0 = run * 16, ch0 = cgp * 8;
        float cw[4][8];
#pragma unroll
        for (int jj = 0; jj < 4; ++jj) { const f32x4 c0 = *(const f32x4*)(a.conv_a + (size_t)layer * 4096 + jj * 1024 + ch0), c1 = *(const f32x4*)(a.conv_a + (size_t)layer * 4096 + jj * 1024 + ch0 + 4);
            cw[jj][0] = c0.x; cw[jj][1] = c0.y; cw[jj][2] = c0.z; cw[jj][3] = c0.w; cw[jj][4] = c1.x; cw[jj][5] = c1.y; cw[jj][6] = c1.z; cw[jj][7] = c1.w; }
        const float scl = (ch0 >= 512) ? 0.08838834764831845f : 1.f;
        const bool first = (t0 & (SEQ - 1)) == 0;
        const bf16_t* src = QKb + (size_t)t0 * 1024 + ch0; bf16_t* dst = QC + (size_t)t0 * 1024 + ch0;
        u32x4 r0 = (u32x4){0u, 0u, 0u, 0u}, r1 = r0, r2 = r0;
        if (!first) { r0 = *(const u32x4*)(src - 3 * 1024); r1 = *(const u32x4*)(src - 2 * 1024); r2 = *(const u32x4*)(src - 1 * 1024); }
#pragma unroll 4
        for (int q = 0; q < 16; ++q) {
            const u32x4 r3 = *(const u32x4*)(src + (size_t)q * 1024);
            const unsigned w0[4] = {r0.x, r0.y, r0.z, r0.w}, w1[4] = {r1.x, r1.y, r1.z, r1.w}, w2[4] = {r2.x, r2.y, r2.z, r2.w}, w3[4] = {r3.x, r3.y, r3.z, r3.w};
            unsigned ow[4];
#pragma unroll
            for (int e = 0; e < 4; ++e) {
                float u0 = cw[0][2 * e] * bf_lo(w0[e]) + cw[1][2 * e] * bf_lo(w1[e]) + cw[2][2 * e] * bf_lo(w2[e]) + cw[3][2 * e] * bf_lo(w3[e]);
                float u1 = cw[0][2 * e + 1] * bf_hi(w0[e]) + cw[1][2 * e + 1] * bf_hi(w1[e]) + cw[2][2 * e + 1] * bf_hi(w2[e]) + cw[3][2 * e + 1] * bf_hi(w3[e]);
                u0 = u0 * sigmoidf_(u0) * scl; u1 = u1 * sigmoidf_(u1) * scl;
                ow[e] = cvt_pk_bf16(u0, u1);
            }
            *(u32x4*)(dst + (size_t)q * 1024) = (u32x4){ow[0], ow[1], ow[2], ow[3]};
            r0 = r1; r1 = r2; r2 = r3;
        }
    }
}

namespace scan {
constexpr int QS = 0, KS = 17408, VT = 34816, WS_ = 41728, CS = 50944, HS = 77056, GA = 85504, TA = 86784, TPM = TA + 16384, TB = TPM + 16384;
constexpr int QSTR = 272, TSTR = 144, CBUF = 48 * 272;
constexpr int O_GW = 0;

__device__ __forceinline__ void flush_out(LAS unsigned char* lds, bf16_t* OGb, float* SSQH, size_t row, int vcol, int tokv, int c4, int h, int s, u32x4 ograw, u32x4 szraw) {
    const LAS float* hs = (const LAS float*)(lds + HS) + tokv * 33 + 8 * c4;
    const unsigned ow[4] = {ograw.x, ograw.y, ograw.z, ograw.w}, zw[4] = {szraw.x, szraw.y, szraw.z, szraw.w};
    float sq = 0.f; unsigned outw[4];
#pragma unroll
    for (int e = 0; e < 4; ++e) {
        const float g0 = bf_lo(ow[e]) * hs[2 * e], g1 = bf_hi(ow[e]) * hs[2 * e + 1];
        sq += g0 * g0 + g1 * g1;
        outw[e] = cvt_pk_bf16(g0 * bf_lo(zw[e]), g1 * bf_hi(zw[e]));
    }
    sq += __shfl_xor(sq, 1); sq += __shfl_xor(sq, 2);
    *(u32x4*)(OGb + row * 1024 + vcol) = (u32x4){outw[0], outw[1], outw[2], outw[3]};
    if (c4 == 0) SSQH[row * 32 + h * 8 + s] = sq;
}

__device__ __forceinline__ void phase(const Args& a, LAS unsigned char* lds, int layer, int G) {
    int tid = threadIdx.x; asm volatile("" : "+v"(tid));
    unsigned char* ws = a.ws;
    const bf16_t* QCb = (const bf16_t*)(ws + WS_HB1); const bf16_t* Vb = (const bf16_t*)(ws + WS_S1);
    bf16_t* OGb = (bf16_t*)(ws + WS_S2); const bf16_t* SZb = (const bf16_t*)(ws + WS_S3);
    const float* GATES = (const float*)(ws + WS_GATES); float* SSQH = (float*)(ws + WS_SSQH);
    for (int item = blockIdx.x; item < 256; item += G) {
        const int xx = item & 7, kk = item >> 3, bh = xx * 4 + (kk >> 3), s = kk & 7, b = bh >> 2, h = bh & 3;
        const size_t rowbase = (size_t)b * SEQ;
        {
            for (int i = tid; i < 2 * CBUF / 4; i += NTHR) ((LAS unsigned*)(lds + CS))[i] = 0u;
            for (int i = tid; i < 16 * TSTR / 4; i += NTHR) ((LAS unsigned*)(lds + VT + 32 * TSTR))[i] = (i < 32) ? 0x3f803f80u : 0u;
        }
        f32x4 Cacc[3] = {(f32x4){0.f, 0.f, 0.f, 0.f}, (f32x4){0.f, 0.f, 0.f, 0.f}, (f32x4){0.f, 0.f, 0.f, 0.f}};
        float mprev = 0.f;
        u32x4 qk[4]; u32x4 vraw = (u32x4){0u, 0u, 0u, 0u}, ograw = vraw, szraw = vraw;
        {
#pragma unroll
            for (int i = 0; i < 4; ++i) { const int p = (tid + 512 * i) & 1023, row = p >> 4, c16 = p & 15;
                qk[i] = *(const u32x4*)(QCb + (rowbase + row) * 1024 + (i >= 2 ? 512 : 0) + h * 128 + c16 * 8); }
            if (tid < 256) vraw = *(const u32x4*)(Vb + (rowbase + ((tid >> 2) & 63)) * 1024 + h * 256 + s * 32 + 8 * (tid & 3));
        }
        {
            const int lane = tid & 63, w0 = __builtin_amdgcn_readfirstlane(tid >> 6);
#pragma nounroll
            for (int cc = w0; cc < 64; cc += 8) {
                const int t = cc * 64 + lane;
                const float gi = GATES[(rowbase + t) * 8 + h], gf = GATES[(rowbase + t) * 8 + 4 + h];
                const float lf = fminf(gf, 0.f) - log1pf(expf(-fabsf(gf)));
                float bc = lf;
#pragma unroll
                for (int o = 1; o < 64; o <<= 1) { const float tt = __shfl_up(bc, o); if (lane >= o) bc += tt; }
                const float av = gi - bc;
                float pm = av;
#pragma unroll
                for (int o = 1; o < 64; o <<= 1) { const float tt = __shfl_up(pm, o); if (lane >= o) pm = fmaxf(pm, tt); }
                ((LAS float*)(lds + TA))[t] = av; ((LAS float*)(lds + TPM))[t] = pm; ((LAS float*)(lds + TB))[t] = bc;
            }
        }
        __syncthreads();
#pragma nounroll
        for (int c = 0; c < 64; ++c) {
            int tl = tid; asm volatile("" : "+v"(tl));
            const int w = __builtin_amdgcn_readfirstlane(tl >> 6), lane = tl & 63, grp = lane >> 4, ql = lane & 15;
            const int tokv = (tl >> 2) & 63, c4 = tl & 3;
            const int vcol = h * 256 + s * 32 + 8 * c4;
            LAS float* ga = (LAS float*)(lds + GA);
            const int t0 = c * 64, cur = c & 1, nxt = cur ^ 1;
            {
                const int p0 = tl, p1 = tl + 512;
                *(LAS u32x4*)(lds + QS + (p0 >> 4) * QSTR + (p0 & 15) * 16) = qk[0];
                *(LAS u32x4*)(lds + QS + (p1 >> 4) * QSTR + (p1 & 15) * 16) = qk[1];
                *(LAS u32x4*)(lds + KS + (p0 >> 4) * QSTR + (p0 & 15) * 16) = qk[2];
                *(LAS u32x4*)(lds + KS + (p1 >> 4) * QSTR + (p1 & 15) * 16) = qk[3];
                if (tl < 256) {
                    const unsigned vw[4] = {vraw.x, vraw.y, vraw.z, vraw.w};
#pragma unroll
                    for (int e = 0; e < 4; ++e) {
                        *(LAS bf16_t*)(lds + VT + (8 * c4 + 2 * e) * TSTR + tokv * 2) = (bf16_t)(vw[e] & 0xffffu);
                        *(LAS bf16_t*)(lds + VT + (8 * c4 + 2 * e + 1) * TSTR + tokv * 2) = (bf16_t)(vw[e] >> 16);
                    }
                }
            }
            const LAS float* tA = (const LAS float*)(lds + TA) + c * 64; const LAS float* tPM = (const LAS float*)(lds + TPM) + c * 64; const LAS float* tB = (const LAS float*)(lds + TB) + c * 64;
            const float mcur = mprev;
            const float Mlast = fmaxf(mcur, tPM[63]);
            const float decay = __expf(mcur - Mlast);
            mprev = tB[63] + Mlast;
            if (w == 0) ga[O_GW + lane] = __expf(tA[lane] - Mlast);
            if (c > 0 && tl < 256) flush_out(lds, OGb, SSQH, rowbase + (t0 - 64) + tokv, vcol, tokv, c4, h, s, ograw, szraw);
            if (tl < 256) { const size_t row = rowbase + t0 + tokv; ograw = *(const u32x4*)(OGb + row * 1024 + vcol); szraw = *(const u32x4*)(SZb + row * 1024 + vcol); }
            if (c < 63) {
#pragma unroll
                for (int i = 0; i < 4; ++i) { const int p = (tl + 512 * i) & 1023, row = p >> 4, c16 = p & 15;
                    qk[i] = *(const u32x4*)(QCb + (rowbase + t0 + 64 + row) * 1024 + (i >= 2 ? 512 : 0) + h * 128 + c16 * 8); }
                if (tl < 256) vraw = *(const u32x4*)(Vb + (rowbase + t0 + 64 + tokv) * 1024 + vcol);
            }
            LDS_BARRIER();
            const int ti = w >> 1;
            bf16x8 Aq[4];
            {
                const LAS unsigned char* qb = lds + QS + (16 * ti + ql) * QSTR + grp * 16;
#pragma unroll
                for (int ks = 0; ks < 4; ++ks) Aq[ks] = *(const LAS bf16x8*)(qb + ks * 64);
            }
            {
                f32x4 gMi = *(const LAS f32x4*)(tPM + 16 * ti + 4 * grp);
                gMi[0] = fmaxf(gMi[0], mcur); gMi[1] = fmaxf(gMi[1], mcur); gMi[2] = fmaxf(gMi[2], mcur); gMi[3] = fmaxf(gMi[3], mcur);
                const LAS unsigned char* kb = lds + KS + (32 * (w & 1) + ql) * QSTR + grp * 16;
                LAS unsigned char* wb = lds + WS_ + (16 * ti + 4 * grp) * TSTR + (32 * (w & 1) + ql) * 2;
#pragma unroll
                for (int tjj = 0; tjj < 2; ++tjj) {
                    f32x4 sacc = (f32x4){0.f, 0.f, 0.f, 0.f};
#pragma unroll
                    for (int ks = 0; ks < 4; ++ks) sacc = __builtin_amdgcn_mfma_f32_16x16x32_bf16(Aq[ks], *(const LAS bf16x8*)(kb + tjj * 16 * QSTR + ks * 64), sacc, 0, 0, 0);
                    const int j = 32 * (w & 1) + 16 * tjj + ql; const float gaj = tA[j];
#pragma unroll
                    for (int ii = 0; ii < 4; ++ii) {
                        const int i = 16 * ti + 4 * grp + ii;
                        const float wv = (j <= i) ? __expf(gaj - gMi[ii]) * sacc[ii] : 0.f;
                        *(LAS bf16_t*)(wb + ii * TSTR + tjj * 32) = f2bf(wv);
                    }
                }
            }
            LDS_BARRIER();
            {
                const int tn = w & 1;
                f32x4 acc1 = (f32x4){0.f, 0.f, 0.f, 0.f}, acc2 = acc1, acc1a = acc1, acc2a = acc1;
                const LAS unsigned char* wb = lds + WS_ + (16 * ti + ql) * TSTR + grp * 16;
                const LAS unsigned char* vb = lds + VT + (16 * tn + ql) * TSTR + grp * 16;
                const LAS unsigned char* va = lds + VT + (32 + ql) * TSTR + grp * 16;
                const LAS unsigned char* cb = lds + CS + cur * CBUF + (16 * tn + ql) * QSTR + grp * 16;
                const LAS unsigned char* ca = lds + CS + cur * CBUF + (32 + ql) * QSTR + grp * 16;
#pragma unroll
                for (int ks = 0; ks < 2; ++ks) { const bf16x8 Aw = *(const LAS bf16x8*)(wb + ks * 64);
                    acc1 = __builtin_amdgcn_mfma_f32_16x16x32_bf16(Aw, *(const LAS bf16x8*)(vb + ks * 64), acc1, 0, 0, 0);
                    acc1a = __builtin_amdgcn_mfma_f32_16x16x32_bf16(Aw, *(const LAS bf16x8*)(va + ks * 64), acc1a, 0, 0, 0); }
#pragma unroll
                for (int ks = 0; ks < 4; ++ks) {
                    acc2 = __builtin_amdgcn_mfma_f32_16x16x32_bf16(Aq[ks], *(const LAS bf16x8*)(cb + ks * 64), acc2, 0, 0, 0);
                    acc2a = __builtin_amdgcn_mfma_f32_16x16x32_bf16(Aq[ks], *(const LAS bf16x8*)(ca + ks * 64), acc2a, 0, 0, 0); }
                const int i0 = 16 * ti + 4 * grp;
                const f32x4 pmi = *(const LAS f32x4*)(tPM + i0), bi = *(const LAS f32x4*)(tB + i0);
                f32x4 inter, flr;
#pragma unroll
                for (int ii = 0; ii < 4; ++ii) { const float Mi = fmaxf(mcur, pmi[ii]); inter[ii] = __expf(mcur - Mi); flr[ii] = __expf(-(bi[ii] + Mi)); }
                LAS float* hsw = (LAS float*)(lds + HS) + i0 * 33 + 16 * tn + ql;
#pragma unroll
                for (int ii = 0; ii < 4; ++ii) {
                    const float num = acc1[ii] + inter[ii] * acc2[ii];
                    const float den = __shfl(acc1a[ii] + inter[ii] * acc2a[ii], lane & 48);
                    hsw[ii * 33] = num / fmaxf(fabsf(den), flr[ii]);
                }
            }
            {
                Cacc[0] = Cacc[0] * decay; Cacc[1] = Cacc[1] * decay; Cacc[2] = Cacc[2] * decay;
                const LAS unsigned char* kcol = lds + KS + (8 * grp) * QSTR + (16 * w + ql) * 2;
                const LAS unsigned char* vb = lds + VT + ql * TSTR + grp * 16;
#pragma unroll
                for (int ks = 0; ks < 2; ++ks) {
                    unsigned kw[4];
#pragma unroll
                    for (int e = 0; e < 4; ++e) { const unsigned lo = *(const LAS bf16_t*)(kcol + (32 * ks + 2 * e) * QSTR), hi = *(const LAS bf16_t*)(kcol + (32 * ks + 2 * e + 1) * QSTR); kw[e] = lo | (hi << 16); }
                    const bf16x8 Bk = __builtin_bit_cast(bf16x8, (u32x4){kw[0], kw[1], kw[2], kw[3]});
                    const f32x4 g0 = *(const LAS f32x4*)(ga + O_GW + 32 * ks + 8 * grp), g1 = *(const LAS f32x4*)(ga + O_GW + 32 * ks + 8 * grp + 4);
#pragma unroll
                    for (int vt = 0; vt < 3; ++vt) {
                        const u32x4 vv = *(const LAS u32x4*)(vb + vt * 16 * TSTR + ks * 64);
                        u32x4 aw; aw.x = cvt_pk_bf16(bf_lo(vv.x) * g0.x, bf_hi(vv.x) * g0.y); aw.y = cvt_pk_bf16(bf_lo(vv.y) * g0.z, bf_hi(vv.y) * g0.w);
                        aw.z = cvt_pk_bf16(bf_lo(vv.z) * g1.x, bf_hi(vv.z) * g1.y); aw.w = cvt_pk_bf16(bf_lo(vv.w) * g1.z, bf_hi(vv.w) * g1.w);
                        Cacc[vt] = __builtin_amdgcn_mfma_f32_16x16x32_bf16(__builtin_bit_cast(bf16x8, aw), Bk, Cacc[vt], 0, 0, 0);
                    }
                }
                LAS unsigned char* cw_ = lds + CS + nxt * CBUF + (4 * grp) * QSTR + (16 * w + ql) * 2;
#pragma unroll
                for (int vt = 0; vt < 2; ++vt)
#pragma unroll
                    for (int ii = 0; ii < 4; ++ii) *(LAS bf16_t*)(cw_ + (16 * vt + ii) * QSTR) = f2bf(Cacc[vt][ii]);
                if (grp == 0) *(LAS bf16_t*)(cw_ + 32 * QSTR) = f2bf(Cacc[2][0]);
            }
            LDS_BARRIER();
        }
        if (tid < 256) flush_out(lds, OGb, SSQH, rowbase + 63 * 64 + ((tid >> 2) & 63), h * 256 + s * 32 + 8 * (tid & 3), (tid >> 2) & 63, tid & 3, h, s, ograw, szraw);
        __syncthreads();
    }
}
}

__device__ __forceinline__ void mlstm_norm_phase(const Args& a, int gtid, int NGT) {
    const u32x4* A = (const u32x4*)(a.ws + WS_S2); u32x4* Y = (u32x4*)(a.ws + WS_S0); const float* SSQH = (const float*)(a.ws + WS_SSQH);
    for (int i = gtid; i < T * 128; i += NGT) {
        const int t = i >> 7, c8 = i & 127, h = c8 >> 5;
        const f32x4 s0 = *(const f32x4*)(SSQH + (size_t)t * 32 + h * 8), s1 = *(const f32x4*)(SSQH + (size_t)t * 32 + h * 8 + 4);
        const float rs = rsqrtf((((s0.x + s0.y) + (s0.z + s0.w)) + ((s1.x + s1.y) + (s1.z + s1.w))) * (1.f / 256.f) + EPS);
        const u32x4 v = A[i]; u32x4 o;
        o.x = cvt_pk_bf16(bf_lo(v.x) * rs, bf_hi(v.x) * rs); o.y = cvt_pk_bf16(bf_lo(v.y) * rs, bf_hi(v.y) * rs);
        o.z = cvt_pk_bf16(bf_lo(v.z) * rs, bf_hi(v.z) * rs); o.w = cvt_pk_bf16(bf_lo(v.w) * rs, bf_hi(v.w) * rs);
        Y[i] = o;
    }
}

namespace attn {
constexpr int KS = 0, VS = 69632;
constexpr int KSTR = 272, VSTR = 288;
typedef short s16x4 __attribute__((ext_vector_type(4)));
struct Item { int b, head, g, res, blk, r; };
__device__ __forceinline__ Item decode(int item) {
    Item it; const int bhh = item / 96, gi = item % 96; it.b = bhh >> 2; it.head = bhh & 3;
    if (gi < 32) { it.g = 0; it.res = 0; it.blk = gi; it.r = 1; } else if (gi < 64) { it.g = 1; it.res = (gi - 32) >> 3; it.blk = (gi - 32) & 7; it.r = 4; } else { it.g = 2; it.res = (gi - 64) >> 1; it.blk = (gi - 64) & 1; it.r = 16; }
    return it;
}
__device__ __forceinline__ void phase(const Args& a, LAS unsigned char* lds, int jl, int G) {
    int tid = threadIdx.x; asm volatile("" : "+v"(tid));
    unsigned char* ws = a.ws; (void)jl;
    const bf16_t* Kb = (const bf16_t*)(ws + WS_S0); const bf16_t* Vb = (const bf16_t*)(ws + WS_S0 + 32 * MiB);
    bf16_t* Qb = (bf16_t*)(ws + WS_S1);
    float* LSE = (float*)(ws + WS_LSE);
    { unsigned z0 = 0u; asm volatile("" : "+v"(z0)); if (tid < 16 * 18) *(LAS u32x4*)(lds + VS + 256 * VSTR + tid * 16) = (u32x4){z0, z0, z0, z0}; }
    u32x4 kreg[8], vreg[8]; bf16x8 qreg[4];
#define ATTN_LOAD(itm) do { const Item it_ = decode(itm); const int kj_ = tid >> 1, half_ = tid & 1, u_ = (it_.blk - 1) * 128 + kj_, pos_ = u_ >= 0 ? u_ * it_.r + it_.res : 0; \
        const size_t rb_ = (size_t)it_.b * SEQ; \
        const bf16_t* ks_ = Kb + (rb_ + pos_) * 512 + it_.head * 128 + 64 * half_; const bf16_t* vs_ = Vb + (rb_ + pos_) * 512 + it_.head * 128 + 64 * half_; \
        _Pragma("unroll") for (int c_ = 0; c_ < 8; ++c_) { kreg[c_] = *(const u32x4*)(ks_ + c_ * 8); vreg[c_] = *(const u32x4*)(vs_ + c_ * 8); } \
        const int lane_ = tid & 63, w_ = tid >> 6, posq_ = (128 * it_.blk + 16 * w_ + (lane_ & 15)) * it_.r + it_.res; \
        const bf16_t* qs_ = Qb + (rb_ + posq_) * 1536 + (it_.g * 4 + it_.head) * 128 + 8 * (lane_ >> 4); \
        _Pragma("unroll") for (int ks2_ = 0; ks2_ < 4; ++ks2_) qreg[ks2_] = *(const bf16x8*)(qs_ + 32 * ks2_); } while (0)
    int bx0 = blockIdx.x; asm volatile("" : "+s"(bx0));
    if (bx0 < 3072) ATTN_LOAD(bx0);
#pragma nounroll
    for (int item = bx0; item < 3072; item += G) {
        int tl = tid; asm volatile("" : "+v"(tl));
        const int w = __builtin_amdgcn_readfirstlane(tl >> 6), lane = tl & 63, grp = lane >> 4, ql = lane & 15;
        const Item it = decode(item);
        const int blk = it.blk;
        const size_t rowbase = (size_t)it.b * SEQ;
        {
            const int kj = tl >> 1, half = tl & 1;
            const bool oob = (blk - 1) * 128 + kj < 0;
            LAS unsigned char* krow = lds + KS + kj * KSTR + half * 128; LAS unsigned char* vrow = lds + VS + kj * VSTR + half * 128;
#pragma unroll
            for (int c = 0; c < 8; ++c) { u32x4 kv = kreg[c], vv = vreg[c]; if (oob) { kv = (u32x4){0u, 0u, 0u, 0u}; vv = kv; } *(LAS u32x4*)(krow + c * 16) = kv; *(LAS u32x4*)(vrow + c * 16) = vv; }
        }
        bf16x8 Qf[4];
#pragma unroll
        for (int ks = 0; ks < 4; ++ks) Qf[ks] = qreg[ks];
        const int qi = 16 * w + ql;
        const int posq = (128 * blk + qi) * it.r + it.res;
        bf16_t* orow = Qb + (rowbase + posq) * 1536 + (it.g * 4 + it.head) * 128 + 4 * grp;
        LDS_BARRIER();
        if (item + G < 3072) ATTN_LOAD(item + G);
        f32x4 sc[9];
        float mx = -__builtin_inff();
        const int dbase = 128 + ql - 4 * grp; const unsigned dmax = (blk > 0) ? 128u : (unsigned)qi;
        const LAS unsigned char* kbase = lds + KS + (16 * w + ql) * KSTR + grp * 16;
#pragma unroll
        for (int tt = 0; tt < 9; ++tt) {
            f32x4 acc = (f32x4){0.f, 0.f, 0.f, 0.f};
#pragma unroll
            for (int ks = 0; ks < 4; ++ks) acc = __builtin_amdgcn_mfma_f32_16x16x32_bf16(*(const LAS bf16x8*)(kbase + tt * 16 * KSTR + ks * 64), Qf[ks], acc, 0, 0, 0);
#pragma unroll
            for (int ii = 0; ii < 4; ++ii) {
                const int dist = dbase - 16 * tt - ii;
                const float v = ((unsigned)dist <= dmax) ? acc[ii] * 0.08838834764831845f : -__builtin_inff();
                sc[tt][ii] = v; mx = fmaxf(mx, v);
            }
        }
        mx = fmaxf(mx, __shfl_xor(mx, 16)); mx = fmaxf(mx, __shfl_xor(mx, 32));
        float den = 0.f;
#pragma unroll
        for (int tt = 0; tt < 9; ++tt)
#pragma unroll
            for (int ii = 0; ii < 4; ++ii) { const float e = __expf(sc[tt][ii] - mx); sc[tt][ii] = e; den += e; }
        den += __shfl_xor(den, 16); den += __shfl_xor(den, 32);
        f32x4 oacc[8];
#pragma unroll
        for (int dt = 0; dt < 8; ++dt) oacc[dt] = (f32x4){0.f, 0.f, 0.f, 0.f};
        const LAS unsigned char* vbase = lds + VS + (16 * w + 4 * grp + (ql >> 2)) * VSTR + (ql & 3) * 8;
#pragma unroll
        for (int pp = 0; pp < 5; ++pp) {
            u32x4 pw;
            pw.x = cvt_pk_bf16(sc[2 * pp][0], sc[2 * pp][1]); pw.y = cvt_pk_bf16(sc[2 * pp][2], sc[2 * pp][3]);
            if (pp < 4) { pw.z = cvt_pk_bf16(sc[2 * pp + 1][0], sc[2 * pp + 1][1]); pw.w = cvt_pk_bf16(sc[2 * pp + 1][2], sc[2 * pp + 1][3]); } else { pw.z = 0u; pw.w = 0u; }
            const bf16x8 Pf = __builtin_bit_cast(bf16x8, pw);
#pragma unroll
            for (int dt = 0; dt < 8; ++dt) {
                const s16x4 lo = __builtin_amdgcn_ds_read_tr16_b64_v4i16((LAS s16x4*)(vbase + pp * 32 * VSTR + dt * 32));
                const s16x4 hi = __builtin_amdgcn_ds_read_tr16_b64_v4i16((LAS s16x4*)(vbase + pp * 32 * VSTR + 16 * VSTR + dt * 32));
                const bf16x8 av = (bf16x8){lo[0], lo[1], lo[2], lo[3], hi[0], hi[1], hi[2], hi[3]};
                oacc[dt] = __builtin_amdgcn_mfma_f32_16x16x32_bf16(av, Pf, oacc[dt], 0, 0, 0);
            }
        }
        const float inv = 1.f / den;
#pragma unroll
        for (int dt = 0; dt < 8; ++dt) { u32x2 o; o.x = cvt_pk_bf16(oacc[dt][0] * inv, oacc[dt][1] * inv); o.y = cvt_pk_bf16(oacc[dt][2] * inv, oacc[dt][3] * inv);
            *(u32x2*)(orow + 16 * dt) = o; }
        if (grp == 0) LSE[((size_t)it.g * T + rowbase + posq) * 4 + it.head] = mx + __logf(den);
        LDS_BARRIER();
    }
#undef ATTN_LOAD
}
}

__device__ __forceinline__ void attn_combine_phase(const Args& a, int gtid, int NGT) {
    const bf16_t* O = (const bf16_t*)(a.ws + WS_S1); const u32x4* SZ = (const u32x4*)(a.ws + WS_S3); u32x4* Y = (u32x4*)(a.ws + WS_S3 + 32 * MiB);
    const float* LSE = (const float*)(a.ws + WS_LSE);
    for (int i = gtid; i < T * 64; i += NGT) {
        const int t = i >> 6, c8 = i & 63, h = c8 >> 4;
        const float l0 = LSE[((size_t)0 * T + t) * 4 + h], l1 = LSE[((size_t)1 * T + t) * 4 + h], l2 = LSE[((size_t)2 * T + t) * 4 + h];
        const float m = fmaxf(l0, fmaxf(l1, l2));
        float w0 = __expf(l0 - m), w1 = __expf(l1 - m), w2 = __expf(l2 - m);
        const float inv = 1.f / (w0 + w1 + w2); w0 *= inv; w1 *= inv; w2 *= inv;
        const u32x4 o0 = *(const u32x4*)(O + (size_t)t * 1536 + c8 * 8), o1 = *(const u32x4*)(O + (size_t)t * 1536 + 512 + c8 * 8), o2 = *(const u32x4*)(O + (size_t)t * 1536 + 1024 + c8 * 8);
        const u32x4 z = SZ[i];
        const unsigned a0[4] = {o0.x, o0.y, o0.z, o0.w}, a1[4] = {o1.x, o1.y, o1.z, o1.w}, a2[4] = {o2.x, o2.y, o2.z, o2.w}, zz[4] = {z.x, z.y, z.z, z.w};
        unsigned ow[4];
#pragma unroll
        for (int e = 0; e < 4; ++e) {
            const float lo = (w0 * bf_lo(a0[e]) + w1 * bf_lo(a1[e]) + w2 * bf_lo(a2[e])) * bf_lo(zz[e]);
            const float hi = (w0 * bf_hi(a0[e]) + w1 * bf_hi(a1[e]) + w2 * bf_hi(a2[e])) * bf_hi(zz[e]);
            ow[e] = cvt_pk_bf16(lo, hi);
        }
        Y[i] = (u32x4){ow[0], ow[1], ow[2], ow[3]};
    }
}

typedef const __attribute__((address_space(4))) Args* KArgs;
#define LOADARGS(name) Args name; { KArgs _k = kp; asm volatile("" : "+s"(_k)); name = *_k; }

__global__ void __launch_bounds__(NTHR, 2) fwd_megakernel(Args args_unused) {
#if defined(__HIP_DEVICE_COMPILE__)
    extern __shared__ __attribute__((aligned(16))) unsigned char lds_raw[];
    LAS unsigned char* lds = (LAS unsigned char*)lds_raw;
    KArgs kp = (KArgs)__builtin_amdgcn_kernarg_segment_ptr();
    const int G = gridDim.x, bx = blockIdx.x;
    {
        const int tid = threadIdx.x;
        volatile LAS unsigned* MISC0 = (volatile LAS unsigned*)(lds + MISC_OFF);
        if (tid < 64) MISC0[tid] = 0u;
        __syncthreads();
    }
    { LOADARGS(a); (void)xcd_barrier_post((unsigned*)(a.ws + WS_CTL) + CW_BAR, (volatile LAS unsigned*)(lds + MISC_OFF) + 8); }
#define GRID_BAR() do { LOADARGS(a_); XcdBarrier b_; b_.bar = (unsigned*)(a_.ws + WS_CTL) + CW_BAR; b_.x = xb_xcc_id(); b_.st = (volatile LAS unsigned*)(lds + MISC_OFF) + 8; xcd_barrier(b_); } while (0)
#define THREAD_IDS() int tid = threadIdx.x; asm volatile("" : "+v"(tid)); const int lane = tid & 63, wave = __builtin_amdgcn_readfirstlane(tid >> 6); \
    const int vcu = (G % 8 == 0) ? (bx % 8) * (G / 8) + bx / 8 : bx; const int gw = vcu * NWAVES + wave, NGW = G * NWAVES, gtid = vcu * NTHR + tid, NGT = G * NTHR; (void)lane; (void)gw; (void)NGW; (void)gtid; (void)NGT;

#define PH_PROLOGUE() { LOADARGS(a); THREAD_IDS(); prologue(a, lds, gw, NGW, lane, wave); }
#define PH_P1A(layer) { \
            { LOADARGS(a); unsigned char* ws = a.ws; \
              pg8::Gemm g{(const bf16_t*)(ws + WS_HB0), (const bf16_t*)(ws + WS_WINA) + (size_t)(layer) * 4096 * 1024, T, 4096, 1024}; \
              pg8::StaticOrder S; S.init(T, 4096, G, bx); \
              pg8::EpiP E{0, (const float*)(ws + WS_SSQ0), ws, nullptr, nullptr, lds}; \
              pg8::gemm_phase<pg8::EpiP, pg8::StaticOrder, true, true>(lds + RING_OFF, g, S, E); } \
            { LOADARGS(a); THREAD_IDS(); gates_job(a, (layer), (const bf16_t*)(a.ws + WS_HB0), (const float*)(a.ws + WS_SSQ0), gw, NGW, lane); } \
            { LOADARGS(a); THREAD_IDS(); convert_p(a, (layer), gtid, NGT); } }
#define PH_CONV(layer) { LOADARGS(a); THREAD_IDS(); conv_phase(a, (layer), gtid, NGT); }
#define PH_SCAN(layer) { LOADARGS(a); scan::phase(a, lds, (layer), G); }
#define PH_NORM() { LOADARGS(a); THREAD_IDS(); mlstm_norm_phase(a, gtid, NGT); }
#define PH_P3A(layer) { \
              LOADARGS(a); unsigned char* ws = a.ws; \
              pg8::Gemm g{(const bf16_t*)(ws + WS_S0), (const bf16_t*)(ws + WS_WOUTA) + (size_t)(layer) * 1024 * 1024, T, 1024, 1024}; \
              pg8::StaticOrder S; S.init(T, 1024, G, bx); \
              pg8::EpiF E{0, (const bf16_t*)(ws + WS_HB0), (bf16_t*)(ws + WS_HB1), (float*)(ws + WS_SSQ1), nullptr, nullptr, nullptr}; \
              pg8::gemm_phase<pg8::EpiF, pg8::StaticOrder, true, true>(lds + RING_OFF, g, S, E); }
#define PH_P1B(jl, layer) { \
            { LOADARGS(a); unsigned char* ws = a.ws; \
              const int N = ((jl) == 0) ? 3072 : 2048; \
              pg8::Gemm g{(const bf16_t*)(ws + WS_HB0), (const bf16_t*)(ws + ((jl) == 0 ? WS_WINB0 : WS_WINB1)), T, N, 1024}; \
              pg8::StaticOrder S; S.init(T, N, G, bx); \
              pg8::EpiP E{1, (const float*)(ws + WS_SSQ0), ws, a.qnorm_b + (jl) * 128, a.knorm, lds}; \
              pg8::gemm_phase<pg8::EpiP, pg8::StaticOrder, true, true>(lds + RING_OFF, g, S, E); } \
            { LOADARGS(a); THREAD_IDS(); convert_p(a, (layer), gtid, NGT); } }
#define PH_ATTN(jl) { LOADARGS(a); attn::phase(a, lds, (jl), G); }
#define PH_COMBINE() { LOADARGS(a); THREAD_IDS(); attn_combine_phase(a, gtid, NGT); }
#define PH_P3B(jl) { \
              LOADARGS(a); unsigned char* ws = a.ws; \
              pg8::Gemm g{(const bf16_t*)(ws + WS_S3 + 32 * MiB), (const bf16_t*)(ws + WS_WOUTB) + (size_t)(jl) * 1024 * 512, T, 1024, 512}; \
              pg8::StaticOrder S; S.init(T, 1024, G, bx); \
              pg8::EpiF E{0, (const bf16_t*)(ws + WS_HB0), (bf16_t*)(ws + WS_HB1), (float*)(ws + WS_SSQ1), nullptr, nullptr, nullptr}; \
              pg8::gemm_phase<pg8::EpiF, pg8::StaticOrder, true, true>(lds + RING_OFF, g, S, E); }
#define PH_PP(layer) { \
            LOADARGS(a); unsigned char* ws = a.ws; \
            pg8::Gemm g2{(const bf16_t*)(ws + WS_PB), (const bf16_t*)(ws + WS_WPLE) + (size_t)(layer) * 1024 * 256, T, 1024, 256}; \
            pg8::StaticOrder S; S.init(T, 1024, G, bx); \
            pg8::EpiP E2{2, nullptr, ws, nullptr, nullptr, lds}; \
            pg8::gemm_phase<pg8::EpiP, pg8::StaticOrder, true, true>(lds + RING_OFF, g2, S, E2); }
#define PH_P4(layer) { \
            LOADARGS(a); unsigned char* ws = a.ws; \
            pg8::Gemm g{(const bf16_t*)(ws + WS_HB1), (const bf16_t*)(ws + WS_WGATE) + (size_t)(layer) * 1024 * 1024, T, 1024, 1024}; \
            pg8::StaticOrder S; S.init(T, 1024, G, bx); \
            pg8::EpiF E{1, (const bf16_t*)(ws + WS_HB1), (bf16_t*)(ws + WS_HB0), (float*)(ws + WS_SSQ0), (const float*)(ws + WS_SSQ1), (const bf16_t*)(ws + WS_S1), ((layer) == DEPTH - 1) ? a.out : nullptr}; \
            pg8::gemm_phase<pg8::EpiF, pg8::StaticOrder, true, true>(lds + RING_OFF, g, S, E); }

#if defined(PROBE_KIND)
#define REP(kind) _Pragma("nounroll") for (int r_ = 0; r_ < ((PROBE_KIND == (kind) && pass == 0) ? PROBE_REPS : 1); ++r_)
#define LASTBAR() GRID_BAR()
#pragma nounroll
    for (int pass = 0; pass < 2; ++pass) {
#else
#define REP(kind)
#define LASTBAR() if (layer < DEPTH - 1) GRID_BAR()
    {
#endif
    REP(1) { PH_PROLOGUE(); GRID_BAR(); }
#pragma nounroll
    for (int layer = 0; layer < DEPTH; ++layer) {
        if (layer < 2) {
            REP(4) { PH_P1A(layer); GRID_BAR(); }
            REP(12) { PH_CONV(layer); GRID_BAR(); }
            REP(2) { PH_SCAN(layer); GRID_BAR(); }
            REP(6) { PH_NORM(); GRID_BAR(); }
            REP(9) { PH_P3A(layer); }
        } else {
            const int jl = layer - 2;
            REP(11) { PH_P1B(jl, layer); GRID_BAR(); }
            REP(3) { PH_ATTN(jl); GRID_BAR(); }
            REP(7) { PH_COMBINE(); GRID_BAR(); }
            REP(10) { PH_P3B(jl); }
        }
        REP(8) { PH_PP(layer); }
        GRID_BAR();
        REP(5) { PH_P4(layer); LASTBAR(); }
    }
    }
#endif
}

extern "C" void kernel_launch(void* const* d_in, const int* in_sizes, int n_in, void* d_out, int out_size, void* d_ws, size_t ws_size, hipStream_t stream) {
    static int grid = 0;
    if (grid == 0) {
        if (n_in != 18 || in_sizes[0] != T * D || out_size != T * D || ws_size < WS_END) { fprintf(stderr, "kernel_launch: unexpected shapes (n_in %d, in0 %d, out %d, ws %zu)\n", n_in, n_in > 0 ? in_sizes[0] : -1, out_size, ws_size); grid = -1; return; }
        int dev = 0, cus = 0, per_cu = 0;
        if (hipGetDevice(&dev) != hipSuccess || hipDeviceGetAttribute(&cus, hipDeviceAttributeMultiprocessorCount, dev) != hipSuccess) { fprintf(stderr, "kernel_launch: device query failed\n"); grid = -1; return; }
        if (hipFuncSetAttribute((const void*)fwd_megakernel, hipFuncAttributeMaxDynamicSharedMemorySize, LDS_BYTES) != hipSuccess) { fprintf(stderr, "kernel_launch: hipFuncSetAttribute failed\n"); grid = -1; return; }
        if (hipOccupancyMaxActiveBlocksPerMultiprocessor(&per_cu, (const void*)fwd_megakernel, NTHR, LDS_BYTES) != hipSuccess || per_cu < 1)
            fprintf(stderr, "kernel_launch: note: occupancy query reports %d workgroups per CU\n", per_cu);
        (void)hipGetLastError();
        grid = cus;
        if (grid > 256) grid = 256;
    }
    if (grid < 0) return;
    if (hipMemsetAsync((char*)d_ws + WS_CTL, 0, CTL_ZERO_BYTES, stream) != hipSuccess) { fprintf(stderr, "kernel_launch: memset failed\n"); return; }
    Args a{};
    a.x = (const float*)d_in[0]; a.p = (const float*)d_in[1]; a.norm_a = (const float*)d_in[2]; a.w_in_a = (const float*)d_in[3]; a.conv_a = (const float*)d_in[4];
    a.b_gate_a = (const float*)d_in[5]; a.hnorm_a = (const float*)d_in[6]; a.w_out_a = (const float*)d_in[7]; a.norm_kv = (const float*)d_in[8]; a.w_kv = (const float*)d_in[9];
    a.knorm = (const float*)d_in[10]; a.norm_b = (const float*)d_in[11]; a.w_in_b = (const float*)d_in[12]; a.qnorm_b = (const float*)d_in[13]; a.w_out_b = (const float*)d_in[14];
    a.ple_norm = (const float*)d_in[15]; a.w_ple_gate = (const float*)d_in[16]; a.w_ple = (const float*)d_in[17];
    a.out = (float*)d_out; a.ws = (unsigned char*)d_ws;
    hipLaunchKernelGGL(fwd_megakernel, dim3(grid), dim3(NTHR), LDS_BYTES, stream, a);
    const hipError_t le = hipPeekAtLastError();
    if (le != hipSuccess) fprintf(stderr, "kernel_launch: launch failed: %s\n", hipGetErrorName(le));
}
```

```cpp
#include <hip/hip_runtime.h>
#include <cstdio>
#include <cstdint>

#define LAS __attribute__((address_space(3)))
#define GAS __attribute__((address_space(1)))
typedef unsigned short bf16_t;
typedef short bf16x8 __attribute__((ext_vector_type(8)));
typedef float f32x4 __attribute__((ext_vector_type(4)));
typedef unsigned u32x4 __attribute__((ext_vector_type(4)));
typedef unsigned u32x2 __attribute__((ext_vector_type(2)));

constexpr int BATCH = 8, SEQ = 4096, T = BATCH * SEQ, D = 1024, DEPTH = 4, PLE = 256;
constexpr int A_COLS = 4104;
constexpr float EPS = 1e-6f;

typedef __bf16 bf16x2_t __attribute__((ext_vector_type(2)));
typedef float f32x2_t __attribute__((ext_vector_type(2)));
__device__ __forceinline__ unsigned cvt_pk_bf16(float lo, float hi) { const f32x2_t v = {lo, hi}; return __builtin_bit_cast(unsigned, __builtin_convertvector(v, bf16x2_t)); }
__device__ __forceinline__ float bf_lo(unsigned w) { return __uint_as_float(w << 16); }
__device__ __forceinline__ float bf_hi(unsigned w) { return __uint_as_float(w & 0xffff0000u); }
__device__ __forceinline__ float bf2f(bf16_t b) { return __uint_as_float(((unsigned)b) << 16); }
__device__ __forceinline__ bf16_t f2bf(float f) { return (bf16_t)(cvt_pk_bf16(f, 0.f) & 0xffffu); }
__device__ __forceinline__ float sigmoidf_(float x) { return 1.f / (1.f + __expf(-x)); }
__device__ __forceinline__ float ssq16_rstd(const float* ssq, int row) {
    const f32x4* p = (const f32x4*)(ssq + (size_t)row * 16);
    const f32x4 a = p[0], b = p[1], c = p[2], d = p[3];
    const float s = ((a.x + a.y) + (a.z + a.w)) + ((b.x + b.y) + (b.z + b.w)) + ((c.x + c.y) + (c.z + c.w)) + ((d.x + d.y) + (d.z + d.w));
    return rsqrtf(s * (1.f / 1024.f) + EPS);
}

constexpr size_t WS_S0_ = (size_t)208 << 20, WS_S1_ = (size_t)272 << 20, WS_S2_ = (size_t)336 << 20, WS_S3_ = (size_t)400 << 20;
namespace pg8 {
#define PG8_LAS __attribute__((address_space(3)))
constexpr int BM = 256, BK = 64, HALF = 128, HTB = HALF * BK * 2, STAGE_BYTES = 8 * HTB, NXCD = 8, WGM = 8;
__host__ __device__ __forceinline__ int lds_byte(int r, int c) { const int st = (r >> 4) * 2 + (c >> 5), rr = r & 15, cc = c & 31, ob = rr * 64 + cc * 2; return st * 1024 + (ob ^ (((ob >> 9) & 1) << 5)); }
__host__ __device__ __forceinline__ void stage_rc(int b, int& R, int& C) { const int st = b / 1024, sb = b % 1024, swz = sb ^ (((sb >> 9) & 1) << 5); R = (st >> 1) * 16 + swz / 64; C = (st & 1) * 32 + (swz % 64) / 2; }
__host__ __device__ __forceinline__ int perm32(int rho) { const int n = rho >> 4, i = rho & 15; return 8 * (i >> 2) + 4 * n + (i & 3); }

struct Unit { int pm, pn; };
struct Gemm { const bf16_t* A; const bf16_t* Bt; int M, N, K; };
struct StaticOrder {
    int nM, nN, nwg, G, c;
    __host__ __device__ void init(int M, int N, int G_, int c_) { nM = M / BM; nN = N / BM; nwg = nM * nN; G = G_; c = c_; }
    __host__ __device__ bool next(int i, Unit& u) const {
        const long L = (long)i * G + c; if (L >= nwg) return false;
        int wgid = (int)L; { const int q = nwg / NXCD, r = nwg % NXCD, xcd = wgid % NXCD, off = wgid / NXCD; wgid = (xcd < r ? xcd * (q + 1) : r * (q + 1) + (xcd - r) * q) + off; }
        const int nig = WGM * nN, gid = wgid / nig, fm = gid * WGM, gsz = (nM - fm) < WGM ? (nM - fm) : WGM;
        u.pm = fm + ((wgid % nig) % gsz); u.pn = (wgid % nig) / gsz; return true;
    }
    __device__ __forceinline__ void a_ready(const Unit&) const {}
    __device__ __forceinline__ void done(const Unit&) const {}
};


struct EpiP {
    static constexpr bool PERM = true, AFTER_DRAIN = false;
    int mode; const float* ssq; unsigned char* ws; const float* qg; const float* kg; PG8_LAS unsigned char* lds;
    __device__ __forceinline__ void operator()(const f32x4 (&acc)[2][2][4][2], const Unit& u, int wr, int wc, int fr, int fq) const {
        const int row0 = u.pm * BM + wr * 64 + fr;
        size_t boff; int ldc, colt, act = 0;
        if (mode == 0) { const int ten = u.pn >> 2; boff = WS_S0_ + (size_t)ten * (64u << 20); ldc = 1024; colt = (u.pn & 3) * 256; act = ten == 2 ? 1 : ten == 3 ? 2 : 0; }
        else if (mode == 1) {
            if (u.pn < 6) { boff = WS_S1_; ldc = 1536; colt = u.pn * 256; act = 3; }
            else if (u.pn < 8) { boff = WS_S3_; ldc = 512; colt = (u.pn - 6) * 256; act = 2; }
            else if (u.pn < 10) { boff = WS_S0_; ldc = 512; colt = (u.pn - 8) * 256; act = 3; }
            else { boff = WS_S0_ + (32u << 20); ldc = 512; colt = (u.pn - 10) * 256; }
        } else { boff = WS_S1_; ldc = 1024; colt = u.pn * 256; }
        bf16_t* base = (bf16_t*)(ws + boff);
        if (act == 3) {
            PG8_LAS float* X = (PG8_LAS float*)(lds + 131072);
            const float* gn = (u.pn < 6) ? qg : kg;
            const float* COS = (const float*)(ws + ((size_t)2 << 20)); const float* SIN = (const float*)(ws + ((size_t)3 << 20));
#pragma unroll
            for (int ai = 0; ai < 2; ++ai)
#pragma unroll
                for (int m = 0; m < 4; ++m) {
                    const int rl = ai * HALF + wr * 64 + m * 16 + fr;
                    const float rs = ssq16_rstd(ssq, u.pm * BM + rl);
#pragma unroll
                    for (int bj = 0; bj < 2; ++bj) {
                        const f32x4 v0 = acc[ai][bj][m][0] * rs, v1 = acc[ai][bj][m][1] * rs;
                        float sq = (v0[0] * v0[0] + v0[1] * v0[1]) + (v0[2] * v0[2] + v0[3] * v0[3]) + (v1[0] * v1[0] + v1[1] * v1[1]) + (v1[2] * v1[2] + v1[3] * v1[3]);
                        sq += __shfl_xor(sq, 16); sq += __shfl_xor(sq, 32);
                        if (fq == 0) X[(rl * 2 + bj) * 4 + wc] = sq;
                    }
                }
            asm volatile("s_waitcnt lgkmcnt(0)" ::: "memory"); __builtin_amdgcn_s_barrier(); asm volatile("" ::: "memory");
            const int d0 = 16 * wc + 4 * fq;
            const f32x4 g1 = *(const f32x4*)(gn + d0), g2 = *(const f32x4*)(gn + 64 + d0);
#pragma unroll
            for (int ai = 0; ai < 2; ++ai)
#pragma unroll
                for (int m = 0; m < 4; ++m) {
                    const int rl = ai * HALF + wr * 64 + m * 16 + fr, row = u.pm * BM + rl, pos = row & (SEQ - 1);
                    const float rs = ssq16_rstd(ssq, row);
                    const f32x4 cs = *(const f32x4*)(COS + pos * 64 + d0), sn = *(const f32x4*)(SIN + pos * 64 + d0);
#pragma unroll
                    for (int bj = 0; bj < 2; ++bj) {
                        const f32x4 xs = *(const PG8_LAS f32x4*)(X + (rl * 2 + bj) * 4);
                        const float rh = rs * rsqrtf(((xs[0] + xs[1]) + (xs[2] + xs[3])) * (1.f / 128.f) + EPS);
                        const f32x4 x1 = acc[ai][bj][m][0] * rh * g1, x2 = acc[ai][bj][m][1] * rh * g2;
                        const f32x4 o1 = x1 * cs - x2 * sn, o2 = x2 * cs + x1 * sn;
                        bf16_t* p = base + (size_t)row * ldc + colt + bj * HALF + d0;
                        u32x2 w1, w2; w1.x = cvt_pk_bf16(o1[0], o1[1]); w1.y = cvt_pk_bf16(o1[2], o1[3]); w2.x = cvt_pk_bf16(o2[0], o2[1]); w2.y = cvt_pk_bf16(o2[2], o2[3]);
                        *(u32x2*)p = w1; *(u32x2*)(p + 64) = w2;
                    }
                    asm volatile("" ::: "memory");
                }
            return;
        }
        const int col0 = colt + wc * 32 + 8 * fq;
#pragma unroll
        for (int ai = 0; ai < 2; ++ai)
#pragma unroll
            for (int m = 0; m < 4; ++m) {
                const int row = row0 + ai * HALF + m * 16;
                const float rs = (mode == 2) ? 1.f : ssq16_rstd(ssq, row);
                bf16_t* rowp = base + (size_t)row * ldc + col0;
#pragma unroll
                for (int bj = 0; bj < 2; ++bj) {
                    f32x4 v0 = acc[ai][bj][m][0] * rs, v1 = acc[ai][bj][m][1] * rs;
                    if (act == 1) {
#pragma unroll
                        for (int j = 0; j < 4; ++j) { v0[j] = sigmoidf_(v0[j]); v1[j] = sigmoidf_(v1[j]); }
                    } else if (act == 2) {
#pragma unroll
                        for (int j = 0; j < 4; ++j) { v0[j] = v0[j] * sigmoidf_(v0[j]); v1[j] = v1[j] * sigmoidf_(v1[j]); }
                    }
                    u32x4 w; w.x = cvt_pk_bf16(v0[0], v0[1]); w.y = cvt_pk_bf16(v0[2], v0[3]); w.z = cvt_pk_bf16(v1[0], v1[1]); w.w = cvt_pk_bf16(v1[2], v1[3]);
                    *(u32x4*)(rowp + bj * HALF) = w;
                }
                asm volatile("" ::: "memory");
            }
    }
};
struct EpiF {
    static constexpr bool PERM = true, AFTER_DRAIN = false;
    int mode; const bf16_t* hres; bf16_t* hb; float* ssq_out; const float* ssq_in; const bf16_t* pp; float* fout;
    __device__ __forceinline__ void operator()(const f32x4 (&acc)[2][2][4][2], const Unit& u, int wr, int wc, int fr, int fq) const {
        const int row0 = u.pm * BM + wr * 64 + fr, col0 = u.pn * BM + wc * 32 + 8 * fq;
#pragma unroll
        for (int ai = 0; ai < 2; ++ai)
#pragma unroll
            for (int m = 0; m < 4; ++m) {
                const int row = row0 + ai * HALF + m * 16;
                const size_t off = (size_t)row * 1024 + col0;
                float rs = 1.f; if (mode == 1) rs = ssq16_rstd(ssq_in, row);
                float sq = 0.f;
#pragma unroll
                for (int bj = 0; bj < 2; ++bj) {
                    const size_t o = off + bj * HALF;
                    const u32x4 hw = *(const u32x4*)(hres + o);
                    f32x4 v0 = acc[ai][bj][m][0], v1 = acc[ai][bj][m][1];
                    if (mode == 1) {
                        const u32x4 pw = *(const u32x4*)(pp + o);
                        v0[0] = bf_lo(pw.x) * sigmoidf_(v0[0] * rs); v0[1] = bf_hi(pw.x) * sigmoidf_(v0[1] * rs); v0[2] = bf_lo(pw.y) * sigmoidf_(v0[2] * rs); v0[3] = bf_hi(pw.y) * sigmoidf_(v0[3] * rs);
                        v1[0] = bf_lo(pw.z) * sigmoidf_(v1[0] * rs); v1[1] = bf_hi(pw.z) * sigmoidf_(v1[1] * rs); v1[2] = bf_lo(pw.w) * sigmoidf_(v1[2] * rs); v1[3] = bf_hi(pw.w) * sigmoidf_(v1[3] * rs);
                    }
                    f32x4 h0, h1;
                    h0[0] = bf_lo(hw.x) + v0[0]; h0[1] = bf_hi(hw.x) + v0[1]; h0[2] = bf_lo(hw.y) + v0[2]; h0[3] = bf_hi(hw.y) + v0[3];
                    h1[0] = bf_lo(hw.z) + v1[0]; h1[1] = bf_hi(hw.z) + v1[1]; h1[2] = bf_lo(hw.w) + v1[2]; h1[3] = bf_hi(hw.w) + v1[3];
                    if (fout) { *(f32x4*)(fout + o) = h0; *(f32x4*)(fout + o + 4) = h1; }
                    else { u32x4 w; w.x = cvt_pk_bf16(h0[0], h0[1]); w.y = cvt_pk_bf16(h0[2], h0[3]); w.z = cvt_pk_bf16(h1[0], h1[1]); w.w = cvt_pk_bf16(h1[2], h1[3]); *(u32x4*)(hb + o) = w; }
                    sq += ((h0[0] * h0[0] + h0[1] * h0[1]) + (h0[2] * h0[2] + h0[3] * h0[3])) + ((h1[0] * h1[0] + h1[1] * h1[1]) + (h1[2] * h1[2] + h1[3] * h1[3]));
                }
                sq += __shfl_xor(sq, 16); sq += __shfl_xor(sq, 32);
                if (fq == 0 && !fout) ssq_out[(size_t)row * 16 + u.pn * 4 + wc] = sq;
                asm volatile("" ::: "memory");
            }
    }
};

template <class Epi, class Sched, bool ALIGN_EPI = false, bool SP2 = false>
__device__ __forceinline__ void gemm_phase(PG8_LAS unsigned char* lds, const Gemm g, const Sched& S, const Epi& E) {
    int tid = threadIdx.x; asm volatile("" : "+v"(tid));
    const int wid = __builtin_amdgcn_readfirstlane(tid >> 6), lane = tid & 63, wr = wid >> 2, wc = wid & 3, fr = lane & 15, fq = lane >> 4;
    const int K = g.K, nt = K / BK;
    unsigned voffA[2], voffB[2];
#pragma unroll
    for (int i = 0; i < 2; ++i) { int R, C; stage_rc(tid * 16 + i * 8192, R, C); const int Rb = Epi::PERM ? ((R & ~31) + perm32(R & 31)) : R;
        voffA[i] = (unsigned)(R * K + C) * 2u; voffB[i] = (unsigned)(Rb * K + C) * 2u; }
    const size_t kstep = (size_t)(BK * 2);
    const size_t hstep = (size_t)HALF * K * 2;
    const size_t tstep = 2 * hstep;
    const unsigned ldsw = (unsigned)wid * 1024u;
    const int aoff = lds_byte(wr * 64 + fr, fq * 8), boff = lds_byte(wc * 32 + fr, fq * 8);
#define PG8_SA(b, h) (((b) * 2 + (h)) * HTB)
#define PG8_SB(b, h) ((4 + (b) * 2 + (h)) * HTB)
#define PG8_STAGE(bufoff, gbase, voff) do { _Pragma("unroll") for (int _i = 0; _i < 2; ++_i) \
        __builtin_amdgcn_global_load_lds((const unsigned*)((const char*)(gbase) + (voff)[_i]), (PG8_LAS unsigned*)(lds + (bufoff) + ldsw + _i * 8192), 16, 0, 0); } while (0)
#define PG8_LDA(dst, b, h) do { _Pragma("unroll") for (int m = 0; m < 4; ++m) _Pragma("unroll") for (int k = 0; k < 2; ++k) dst[m][k] = *(const PG8_LAS bf16x8*)(lds + PG8_SA(b, h) + aoff + m * 2048 + k * 1024); } while (0)
#define PG8_LDB(dst, b, h) do { _Pragma("unroll") for (int n = 0; n < 2; ++n) _Pragma("unroll") for (int k = 0; k < 2; ++k) dst[n][k] = *(const PG8_LAS bf16x8*)(lds + PG8_SB(b, h) + boff + n * 2048 + k * 1024); } while (0)
#define PG8_MMA(ai, bj, At, Bt) do { __builtin_amdgcn_s_setprio(1); _Pragma("unroll") for (int m = 0; m < 4; ++m) _Pragma("unroll") for (int n = 0; n < 2; ++n) _Pragma("unroll") for (int k = 0; k < 2; ++k) \
        acc[ai][bj][m][n] = __builtin_amdgcn_mfma_f32_16x16x32_bf16(Bt[n][k], At[m][k], acc[ai][bj][m][n], 0, 0, 0); __builtin_amdgcn_s_setprio(0); } while (0)
#define PG8_WAIT_V(n) asm volatile("s_waitcnt vmcnt(" #n ")" ::: "memory")
#define PG8_WAIT_L(n) asm volatile("s_waitcnt lgkmcnt(" #n ")" ::: "memory")
#define PG8_BAR __builtin_amdgcn_s_barrier()
#define PG8_SCHED __builtin_amdgcn_sched_barrier(0)
    Unit cur, nxt; int ui = 0;
    if (!S.next(0, cur)) return;
    f32x4 acc[2][2][4][2];
#pragma unroll
    for (int a = 0; a < 2; ++a)
#pragma unroll
        for (int b = 0; b < 2; ++b)
#pragma unroll
            for (int m = 0; m < 4; ++m)
#pragma unroll
                for (int n = 0; n < 2; ++n) acc[a][b][m][n] = (f32x4){0.f, 0.f, 0.f, 0.f};
    bf16x8 At[4][2], B0[2][2], B1[2][2];
    const char* cA = (const char*)g.A + (size_t)cur.pm * tstep; const char* cB = (const char*)g.Bt + (size_t)cur.pn * tstep;
    S.a_ready(cur);
    if constexpr (SP2) {
        PG8_STAGE(PG8_SB(0, 0), cB, voffB); PG8_STAGE(PG8_SB(0, 1), cB + hstep, voffB); PG8_STAGE(PG8_SA(0, 0), cA, voffA); PG8_STAGE(PG8_SA(0, 1), cA + hstep, voffA);
        if (wr == 1) PG8_BAR;
        PG8_WAIT_V(2); PG8_BAR;
        PG8_STAGE(PG8_SB(1, 0), cB + kstep, voffB); PG8_STAGE(PG8_SA(1, 0), cA + kstep, voffA); PG8_STAGE(PG8_SB(1, 1), cB + hstep + kstep, voffB);
        PG8_WAIT_V(6); PG8_BAR;
    } else {
        PG8_STAGE(PG8_SB(0, 0), cB, voffB); PG8_STAGE(PG8_SA(0, 0), cA, voffA); PG8_STAGE(PG8_SB(0, 1), cB + hstep, voffB); PG8_STAGE(PG8_SA(0, 1), cA + hstep, voffA);
        if (wr == 1) PG8_BAR;
        PG8_WAIT_V(4); PG8_BAR;
        PG8_STAGE(PG8_SB(1, 0), cB + kstep, voffB); PG8_STAGE(PG8_SA(1, 0), cA + kstep, voffA); PG8_STAGE(PG8_SB(1, 1), cB + hstep + kstep, voffB);
        PG8_WAIT_V(6); PG8_BAR;
    }
    for (;;) {
        const bool has_next = S.next(ui + 1, nxt);
        const char* nA = has_next ? (const char*)g.A + (size_t)nxt.pm * tstep : cA; const char* nB = has_next ? (const char*)g.Bt + (size_t)nxt.pn * tstep : cB;
        for (int t = 0; t < nt; t += 2) {
            const bool last = (t == nt - 2);
            const char* a1 = cA + (size_t)(t + 1) * kstep;
            const char* a2 = last ? nA : cA + (size_t)(t + 2) * kstep; const char* b2 = last ? nB : cB + (size_t)(t + 2) * kstep;
            const char* a3 = a2 + kstep; const char* b3 = b2 + kstep;
            if (last && has_next) S.a_ready(nxt);
            if constexpr (SP2) {
            PG8_LDB(B0, 0, 0); PG8_LDB(B1, 0, 1); PG8_SCHED; PG8_LDA(At, 0, 0); PG8_STAGE(PG8_SA(1, 1), a1 + hstep, voffA);
            PG8_WAIT_V(8); PG8_WAIT_L(0); PG8_BAR; PG8_MMA(0, 0, At, B0); PG8_MMA(0, 1, At, B1); PG8_BAR; PG8_SCHED;
            PG8_LDA(At, 0, 1); PG8_STAGE(PG8_SB(0, 0), b2, voffB); PG8_STAGE(PG8_SB(0, 1), b2 + hstep, voffB); PG8_STAGE(PG8_SA(0, 0), a2, voffA);
            PG8_WAIT_V(8); PG8_WAIT_L(0); PG8_BAR; PG8_MMA(1, 0, At, B0); PG8_MMA(1, 1, At, B1); PG8_BAR; PG8_SCHED;
            PG8_LDB(B0, 1, 0); PG8_LDB(B1, 1, 1); PG8_SCHED; PG8_LDA(At, 1, 0); PG8_STAGE(PG8_SA(0, 1), a2 + hstep, voffA);
            PG8_WAIT_V(8); PG8_WAIT_L(0); PG8_BAR; PG8_MMA(0, 0, At, B0); PG8_MMA(0, 1, At, B1); PG8_BAR; PG8_SCHED;
            PG8_LDA(At, 1, 1); PG8_STAGE(PG8_SB(1, 0), b3, voffB); PG8_STAGE(PG8_SB(1, 1), b3 + hstep, voffB); PG8_STAGE(PG8_SA(1, 0), a3, voffA);
            PG8_WAIT_V(8); PG8_WAIT_L(0); PG8_BAR; PG8_MMA(1, 0, At, B0); PG8_MMA(1, 1, At, B1); PG8_BAR; PG8_SCHED;
            } else {
            PG8_LDB(B0, 0, 0); PG8_SCHED; PG8_LDA(At, 0, 0); PG8_STAGE(PG8_SA(1, 1), a1 + hstep, voffA);
            PG8_WAIT_L(8); PG8_BAR; PG8_WAIT_L(0); PG8_MMA(0, 0, At, B0); PG8_BAR; PG8_SCHED;
            PG8_LDB(B1, 0, 1); PG8_STAGE(PG8_SB(0, 0), b2, voffB);
            PG8_BAR; PG8_WAIT_L(0); PG8_MMA(0, 1, At, B1); PG8_BAR;
            PG8_LDA(At, 0, 1); PG8_STAGE(PG8_SA(0, 0), a2, voffA);
            PG8_BAR; PG8_WAIT_L(0); PG8_MMA(1, 0, At, B0); PG8_BAR; PG8_SCHED;
            PG8_STAGE(PG8_SB(0, 1), b2 + hstep, voffB);
            PG8_WAIT_V(6); PG8_BAR; PG8_MMA(1, 1, At, B1); PG8_BAR;
            PG8_LDB(B0, 1, 0); PG8_SCHED; PG8_LDA(At, 1, 0); PG8_STAGE(PG8_SA(0, 1), a2 + hstep, voffA);
            PG8_WAIT_L(8); PG8_BAR; PG8_WAIT_L(0); PG8_MMA(0, 0, At, B0); PG8_BAR; PG8_SCHED;
            PG8_LDB(B1, 1, 1); PG8_STAGE(PG8_SB(1, 0), b3, voffB);
            PG8_BAR; PG8_WAIT_L(0); PG8_MMA(0, 1, At, B1); PG8_BAR;
            PG8_LDA(At, 1, 1); PG8_STAGE(PG8_SA(1, 0), a3, voffA);
            PG8_BAR; PG8_WAIT_L(0); PG8_MMA(1, 0, At, B0); PG8_BAR; PG8_SCHED;
            PG8_STAGE(PG8_SB(1, 1), b3 + hstep, voffB);
            PG8_WAIT_V(6); PG8_BAR; PG8_MMA(1, 1, At, B1); PG8_BAR;
            }
        }
        if constexpr (ALIGN_EPI) { if (wr == 0) PG8_BAR; }
        if constexpr (!Epi::AFTER_DRAIN) { E(acc, cur, wr, wc, fr, fq); S.done(cur); }
        if (!has_next) break;
#pragma unroll
        for (int a = 0; a < 2; ++a)
#pragma unroll
            for (int b = 0; b < 2; ++b)
#pragma unroll
                for (int m = 0; m < 4; ++m)
#pragma unroll
                    for (int n = 0; n < 2; ++n) acc[a][b][m][n] = (f32x4){0.f, 0.f, 0.f, 0.f};
        cur = nxt; cA = nA; cB = nB; ++ui;
        if constexpr (ALIGN_EPI) { if (wr == 1) PG8_BAR; }
    }
    PG8_WAIT_V(0);
    if constexpr (!ALIGN_EPI) { if (wr == 0) PG8_BAR; }
    PG8_BAR;
#undef PG8_SA
#undef PG8_SB
#undef PG8_STAGE
#undef PG8_LDA
#undef PG8_LDB
#undef PG8_MMA
#undef PG8_WAIT_V
#undef PG8_WAIT_L
#undef PG8_BAR
#undef PG8_SCHED
}
}

constexpr size_t MiB = 1u << 20;
constexpr size_t WS_CTL = 0, CTL_ZERO_BYTES = 1 * MiB;
constexpr size_t WS_COS = 2 * MiB, WS_SIN = 3 * MiB;
constexpr size_t WS_WG8 = 4 * MiB;
constexpr size_t WS_GATES = 5 * MiB;
constexpr size_t WS_LSE = 6 * MiB;
constexpr size_t WS_SSQ0 = 8 * MiB, WS_SSQ1 = 10 * MiB;
constexpr size_t WS_SSQH = 12 * MiB;
constexpr size_t WS_WINA = 16 * MiB;
constexpr size_t WS_WOUTA = 32 * MiB;
constexpr size_t WS_WINB0 = 36 * MiB;
constexpr size_t WS_WINB1 = 42 * MiB;
constexpr size_t WS_WOUTB = 46 * MiB;
constexpr size_t WS_WGATE = 48 * MiB;
constexpr size_t WS_WPLE = 56 * MiB;
constexpr size_t WS_HB0 = 64 * MiB, WS_HB1 = 128 * MiB;
constexpr size_t WS_PB = 192 * MiB;
constexpr size_t WS_S0 = WS_S0_, WS_S1 = WS_S1_, WS_S2 = WS_S2_, WS_S3 = WS_S3_, WS_END = 464 * MiB;
constexpr int CW_BAR = 4096;

#define XB_TMO      128
#define XB_XCNT(j)  (256  + 64 * (j))
#define XB_XSUB(j)  (1280 + 64 * (j))
#define XB_XGEN(j)  (2304 + 64 * (j))
#define XB_TOP      3328
#define XB_TOPGEN   3392
#define XCD_BAR_WORDS 3456
#define XB_SPIN_CAP (1u << 18)
__device__ __forceinline__ unsigned xb_ld(unsigned* p)              { return __hip_atomic_load(p, __ATOMIC_RELAXED, __HIP_MEMORY_SCOPE_AGENT); }
__device__ __forceinline__ unsigned xb_add(unsigned* p, unsigned v) { return __hip_atomic_fetch_add(p, v, __ATOMIC_RELAXED, __HIP_MEMORY_SCOPE_AGENT); }
__device__ __forceinline__ unsigned xb_xcc_id() { return (unsigned)__builtin_amdgcn_s_getreg((3 << 11) | 20) & 0xFu; }
#define XB_SPIN(cond, bar) do { unsigned _sp = 0; while (cond) { __builtin_amdgcn_s_sleep(1); \
    if ((++_sp & 255u) == 0u) { if (xb_ld(&(bar)[XB_TMO])) break; if (_sp > XB_SPIN_CAP) { atomicAdd(&(bar)[XB_TMO], 1u); break; } } } } while (0)
struct XcdBarrier { unsigned* bar; unsigned x; volatile LAS unsigned* st; };
__device__ __forceinline__ XcdBarrier xcd_barrier_post(unsigned* bar, volatile LAS unsigned* st) {
    XcdBarrier b; b.bar = bar; b.x = xb_xcc_id(); b.st = st;
    if (threadIdx.x == 0) (void)xb_add(&bar[XB_XCNT(b.x)], 1u);
    return b;
}
__device__ __forceinline__ void xcd_barrier_complete(unsigned* bar, unsigned x, unsigned& nloc, unsigned& nx) {
    const unsigned G = gridDim.x * gridDim.y * gridDim.z;
    unsigned sum, cnt, mine, sp = 0u;
    for (;;) {
        sum = 0u; cnt = 0u; mine = 0u;
#pragma unroll
        for (unsigned j = 0; j < 16; ++j) { const unsigned c = xb_ld(&bar[XB_XCNT(j)]); sum += c; cnt += (c > 0u) ? 1u : 0u; mine = (j == x) ? c : mine; }
        if (sum == G) break;
        __builtin_amdgcn_s_sleep(1);
        if ((++sp & 255u) == 0u) { if (xb_ld(&bar[XB_TMO])) break; if (sp > XB_SPIN_CAP) { atomicAdd(&bar[XB_TMO], 1u); break; } }
    }
    nloc = mine > 0u ? mine : 1u; nx = cnt > 0u ? cnt : 1u;
}
__device__ __forceinline__ void xcd_barrier(const XcdBarrier& b) {
    asm volatile("s_waitcnt vmcnt(0)" ::: "memory");
    __syncthreads();
    if (threadIdx.x == 0) {
        unsigned* bar = b.bar;
        __builtin_amdgcn_s_waitcnt(0);
        unsigned nloc = b.st[0], nx = b.st[1];
        if (nloc == 0u) { xcd_barrier_complete(bar, b.x, nloc, nx); b.st[0] = nloc; b.st[1] = nx; }
        const unsigned old = xb_add(&bar[XB_XSUB(b.x)], 1u);
        const unsigned gen = old / nloc;
        if (old + 1u == (gen + 1u) * nloc) {
            __builtin_amdgcn_fence(__ATOMIC_RELEASE, "agent");
            asm volatile("s_waitcnt vmcnt(0)" ::: "memory");
            const unsigned og = xb_add(&bar[XB_TOP], 1u);
            const unsigned tg = og / nx;
            if (og + 1u == (tg + 1u) * nx) xb_add(&bar[XB_TOPGEN], 1u);
            else XB_SPIN(xb_ld(&bar[XB_TOPGEN]) == tg, bar);
            __builtin_amdgcn_fence(__ATOMIC_ACQUIRE, "agent");
            xb_add(&bar[XB_XGEN(b.x)], 1u);
            asm volatile("s_waitcnt vmcnt(0)" ::: "memory");
        } else {
            XB_SPIN(xb_ld(&bar[XB_XGEN(b.x)]) == gen, bar);
            __builtin_amdgcn_fence(__ATOMIC_ACQUIRE, "agent");
            asm volatile("s_waitcnt vmcnt(0)" ::: "memory");
        }
    }
    __syncthreads();
}

struct Args {
    const float* x; const float* p; const float* norm_a; const float* w_in_a; const float* conv_a; const float* b_gate_a; const float* hnorm_a; const float* w_out_a;
    const float* norm_kv; const float* w_kv; const float* knorm; const float* norm_b; const float* w_in_b; const float* qnorm_b; const float* w_out_b;
    const float* ple_norm; const float* w_ple_gate; const float* w_ple;
    float* out; unsigned char* ws;
};

constexpr int NWAVES = 8, NTHR = 512;
constexpr int RING_OFF = 0;
constexpr int MISC_OFF = 160 * 1024 - 256;
constexpr int LDS_BYTES = 160 * 1024;

#define LDS_WAIT() asm volatile("s_waitcnt lgkmcnt(0)" ::: "memory")
#define LDS_BARRIER() do { asm volatile("s_waitcnt lgkmcnt(0)" ::: "memory"); __builtin_amdgcn_s_barrier(); asm volatile("" ::: "memory"); } while (0)

__device__ __forceinline__ void transpose_item(const float* W, int K, int ldw, int ncol0, int nblk, const float* gain, bf16_t* WT, int row_off, int nperm, LAS float* scr, int item, int lane) {
    const int kb = item / nblk, nb = item % nblk, k0 = 64 * kb, n0 = 32 * nb;
#pragma unroll 8
    for (int i = 0; i < 32; ++i) { const int kk = 2 * i + (lane >> 5); const float gv = gain ? gain[k0 + kk] : 1.f; scr[kk * 33 + (lane & 31)] = W[(size_t)(k0 + kk) * ldw + ncol0 + n0 + (lane & 31)] * gv; }
    LDS_WAIT(); asm volatile("" ::: "memory");
    const int c = lane & 7;
#pragma unroll
    for (int j = 0; j < 4; ++j) { const int n = (lane >> 3) + 8 * j; const LAS float* s = scr + (8 * c) * 33 + n;
        u32x4 o; o.x = cvt_pk_bf16(s[0 * 33], s[1 * 33]); o.y = cvt_pk_bf16(s[2 * 33], s[3 * 33]); o.z = cvt_pk_bf16(s[4 * 33], s[5 * 33]); o.w = cvt_pk_bf16(s[6 * 33], s[7 * 33]);
        int col = n0 + n; if (col < nperm) { const int d = col & 127; col = (col & ~127) + 32 * ((d & 63) >> 4) + 8 * ((d >> 2) & 3) + 4 * (d >> 6) + (d & 3); }
        *(u32x4*)(WT + (size_t)(row_off + col) * K + k0 + 8 * c) = o; }
    LDS_WAIT(); asm volatile("" ::: "memory");
}

__device__ __forceinline__ void prologue(const Args& a, LAS unsigned char* lds, int gw, int NGW, int lane, int wave) {
    unsigned char* ws = a.ws;
    LAS float* scr = (LAS float*)(lds + wave * 16384);
    struct TJ { const float* W; int K, ldw, ncol0, ncols; const float* gain; bf16_t* dst; int row_off, nperm; };
    int it = gw;
    for (int job = 0; job < 17; ++job) {
        TJ j;
        if (job < 2)       j = TJ{a.w_in_a + (size_t)job * 1024 * A_COLS, 1024, A_COLS, 0, 4096, a.norm_a + job * 1024, (bf16_t*)(ws + WS_WINA) + (size_t)job * 4096 * 1024, 0, 0};
        else if (job < 4)  j = TJ{a.w_out_a + (size_t)(job - 2) * 1024 * 1024, 1024, 1024, 0, 1024, a.hnorm_a + (job - 2) * 1024, (bf16_t*)(ws + WS_WOUTA) + (size_t)(job - 2) * 1024 * 1024, 0, 0};
        else if (job == 4) j = TJ{a.w_in_b, 1024, 2048, 0, 2048, a.norm_b, (bf16_t*)(ws + WS_WINB0), 0, 1536};
        else if (job == 5) j = TJ{a.w_in_b + (size_t)1024 * 2048, 1024, 2048, 0, 2048, a.norm_b + 1024, (bf16_t*)(ws + WS_WINB1), 0, 1536};
        else if (job == 6) j = TJ{a.w_kv, 1024, 1024, 0, 1024, a.norm_kv, (bf16_t*)(ws + WS_WINB0), 2048, 512};
        else if (job < 9)  j = TJ{a.w_out_b + (size_t)(job - 7) * 512 * 1024, 512, 1024, 0, 1024, nullptr, (bf16_t*)(ws + WS_WOUTB) + (size_t)(job - 7) * 1024 * 512, 0, 0};
        else if (job < 13) j = TJ{a.w_ple_gate + (size_t)(job - 9) * 1024 * 1024, 1024, 1024, 0, 1024, a.ple_norm + (job - 9) * 1024, (bf16_t*)(ws + WS_WGATE) + (size_t)(job - 9) * 1024 * 1024, 0, 0};
        else               j = TJ{a.w_ple + (size_t)(job - 13) * 256 * 1024, 256, 1024, 0, 1024, nullptr, (bf16_t*)(ws + WS_WPLE) + (size_t)(job - 13) * 1024 * 256, 0, 0};
        const int nblk = j.ncols / 32, nitems = (j.K / 64) * nblk;
        for (; it < nitems; it += NGW) transpose_item(j.W, j.K, j.ldw, j.ncol0, nblk, j.gain, j.dst, j.row_off, j.nperm, scr, it, lane);
        it -= nitems;
    }
    {
        bf16_t* HB = (bf16_t*)(ws + WS_HB0); float* SSQ = (float*)(ws + WS_SSQ0);
        for (int m = gw; m < T; m += NGW) {
            const f32x4* xr = (const f32x4*)(a.x + (size_t)m * D) + lane;
            f32x4 v[4]; float s = 0.f;
#pragma unroll
            for (int jj = 0; jj < 4; ++jj) { v[jj] = xr[64 * jj]; s += (v[jj].x * v[jj].x + v[jj].y * v[jj].y) + (v[jj].z * v[jj].z + v[jj].w * v[jj].w); }
#pragma unroll
            for (int o = 1; o < 64; o <<= 1) s += __shfl_xor(s, o);
            u32x2* o8 = (u32x2*)(HB + (size_t)m * D) + lane;
#pragma unroll
            for (int jj = 0; jj < 4; ++jj) { u32x2 w; w.x = cvt_pk_bf16(v[jj].x, v[jj].y); w.y = cvt_pk_bf16(v[jj].z, v[jj].w); o8[64 * jj] = w; }
            if (lane < 16) SSQ[(size_t)m * 16 + lane] = lane == 0 ? s : 0.f;
        }
    }
    {
        float* COS = (float*)(ws + WS_COS); float* SIN = (float*)(ws + WS_SIN);
        for (int i = gw * 64 + lane; i < SEQ * 64; i += NGW * 64) {
            const int pos = i >> 6, fi = i & 63;
            const float crev = exp2f(-(float)fi * (13.287712379549449f / 64.0f)) * 0.15915494309189535f;
            float tr = (float)pos * crev; tr -= rintf(tr);
            COS[i] = __builtin_amdgcn_cosf(tr); SIN[i] = __builtin_amdgcn_sinf(tr);
        }
    }
    {
        bf16_t* WG = (bf16_t*)(ws + WS_WG8);
        for (int i = gw * 64 + lane; i < 2 * 16 * 1024; i += NGW * 64) {
            const int l = i >> 14, jj = (i >> 10) & 15, k = i & 1023;
            WG[i] = (jj < 8) ? f2bf(a.w_in_a[(size_t)l * 1024 * A_COLS + (size_t)k * A_COLS + 4096 + jj] * a.norm_a[l * 1024 + k]) : (bf16_t)0;
        }
    }
}

__device__ __forceinline__ void convert_p(const Args& a, int layer, int gtid, int NGT) {
    const f32x4* src = (const f32x4*)(a.p + (size_t)layer * T * PLE);
    u32x4* dst = (u32x4*)(a.ws + WS_PB);
    for (int i = gtid; i < T * PLE / 8; i += NGT) {
        const f32x4 v0 = src[2 * i], v1 = src[2 * i + 1];
        u32x4 w; w.x = cvt_pk_bf16(v0.x, v0.y); w.y = cvt_pk_bf16(v0.z, v0.w); w.z = cvt_pk_bf16(v1.x, v1.y); w.w = cvt_pk_bf16(v1.z, v1.w);
        dst[i] = w;
    }
}

__device__ __forceinline__ void gates_job(const Args& a, int layer, const bf16_t* HB, const float* SSQ, int gw, int NGW, int lane) {
    const bf16_t* WG = (const bf16_t*)(a.ws + WS_WG8) + (size_t)layer * 16 * 1024;
    float* GATES = (float*)(a.ws + WS_GATES);
    const int ql = lane & 15, grp = lane >> 4;
#pragma nounroll
    for (int t0 = gw * 16; t0 < T; t0 += NGW * 16) {
        const bf16_t* arow = HB + (size_t)(t0 + ql) * D + 8 * grp;
        const bf16_t* brow = WG + ql * 1024 + 8 * grp;
        f32x4 acc = (f32x4){0.f, 0.f, 0.f, 0.f};
#pragma unroll 8
        for (int ks = 0; ks < 32; ++ks) acc = __builtin_amdgcn_mfma_f32_16x16x32_bf16(*(const bf16x8*)(arow + 32 * ks), *(const bf16x8*)(brow + 32 * ks), acc, 0, 0, 0);
        if (ql < 8) {
            const float bias = a.b_gate_a[layer * 8 + ql];
#pragma unroll
            for (int ii = 0; ii < 4; ++ii) { const int t = t0 + 4 * grp + ii; GATES[(size_t)t * 8 + ql] = acc[ii] * ssq16_rstd(SSQ, t) + bias; }
        }
    }
}

__device__ __forceinline__ void conv_phase(const Args& a, int layer, int gtid, int NGT, int gw, int NGW, int lane) {
    const bf16_t* QKb = (const bf16_t*)(a.ws + WS_S0); bf16_t* QC = (bf16_t*)(a.ws + WS_HB1);
#pragma nounroll
    for (int task = gtid; task < (T / 16) * 128; task += NGT) {
        const int cgp = task & 127, run = task >> 7, t0 = run * 16, ch0 = cgp * 8;
        float cw[4][8];
#pragma unroll
        for (int jj = 0; jj < 4; ++jj) { const f32x4 c0 = *(const f32x4*)(a.conv_a + (size_t)layer * 4096 + jj * 1024 + ch0), c1 = *(const f32x4*)(a.conv_a + (size_t)layer * 4096 + jj * 1024 + ch0 + 4);
            cw[jj][0] = c0.x; cw[jj][1] = c0.y; cw[jj][2] = c0.z; cw[jj][3] = c0.w; cw[jj][4] = c1.x; cw[jj][5] = c1.y; cw[jj][6] = c1.z; cw[jj][7] = c1.w; }
        const float scl = (ch0 >= 512) ? 0.08838834764831845f : 1.f;
        const bool first = (t0 & (SEQ - 1)) == 0;
        const bf16_t* src = QKb + (size_t)t0 * 1024 + ch0; bf16_t* dst = QC + (size_t)t0 * 1024 + ch0;
        u32x4 r[19];
#pragma unroll
        for (int q = 0; q < 19; ++q) r[q] = (q < 3 && first) ? (u32x4){0u, 0u, 0u, 0u} : *(const u32x4*)(src + (q - 3) * 1024);
#pragma unroll
        for (int q = 0; q < 16; ++q) {
            const unsigned w0[4] = {r[q].x, r[q].y, r[q].z, r[q].w}, w1[4] = {r[q + 1].x, r[q + 1].y, r[q + 1].z, r[q + 1].w}, w2[4] = {r[q + 2].x, r[q + 2].y, r[q + 2].z, r[q + 2].w}, w3[4] = {r[q + 3].x, r[q + 3].y, r[q + 3].z, r[q + 3].w};
            unsigned ow[4];
#pragma unroll
            for (int e = 0; e < 4; ++e) {
                float u0 = cw[0][2 * e] * bf_lo(w0[e]) + cw[1][2 * e] * bf_lo(w1[e]) + cw[2][2 * e] * bf_lo(w2[e]) + cw[3][2 * e] * bf_lo(w3[e]);
                float u1 = cw[0][2 * e + 1] * bf_hi(w0[e]) + cw[1][2 * e + 1] * bf_hi(w1[e]) + cw[2][2 * e + 1] * bf_hi(w2[e]) + cw[3][2 * e + 1] * bf_hi(w3[e]);
                u0 = u0 * sigmoidf_(u0) * scl; u1 = u1 * sigmoidf_(u1) * scl;
                ow[e] = cvt_pk_bf16(u0, u1);
            }
            *(u32x4*)(dst + (size_t)q * 1024) = (u32x4){ow[0], ow[1], ow[2], ow[3]};
        }
    }
    const float* GATES = (const float*)(a.ws + WS_GATES); float* TAB = (float*)(a.ws + WS_LSE);
#pragma nounroll
    for (int task = gw; task < 32 * 64; task += NGW) {
        const int bh = task >> 6, cc = task & 63, b = bh >> 2, h = bh & 3, t = cc * 64 + lane;
        const float gi = GATES[((size_t)b * SEQ + t) * 8 + h], gf = GATES[((size_t)b * SEQ + t) * 8 + 4 + h];
        const float lf = fminf(gf, 0.f) - log1pf(expf(-fabsf(gf)));
        float bc = lf;
#pragma unroll
        for (int o = 1; o < 64; o <<= 1) { const float tt = __shfl_up(bc, o); if (lane >= o) bc += tt; }
        const float av = gi - bc;
        float pm = av;
#pragma unroll
        for (int o = 1; o < 64; o <<= 1) { const float tt = __shfl_up(pm, o); if (lane >= o) pm = fmaxf(pm, tt); }
        float* tb = TAB + (size_t)bh * 3 * SEQ + t;
        tb[0] = av; tb[SEQ] = pm; tb[2 * SEQ] = bc;
    }
}

namespace scan {
constexpr int QS = 0, KS = 18432, VS = 36864, CS = 41984, HS1 = 68096, HS2 = 76544, GA = 84992, TA = 86016, TPM = TA + 16384, TB = TPM + 16384;
constexpr int QSTR = 288, VSTR = 80, CSTR = 272, CBUF = 48 * 272;
constexpr int O_EA = 0, O_D1 = 64, O_D2 = 128, O_FL = 192;
typedef short s16x4 __attribute__((ext_vector_type(4)));

__device__ __forceinline__ void flush_out(LAS unsigned char* lds, bf16_t* OGb, float* SSQH, size_t row, int vcol, int tokv, int c4, int h, int s, u32x4 ograw, u32x4 szraw) {
    const LAS float* hs1 = (const LAS float*)(lds + HS1) + tokv * 33 + 8 * c4; const LAS float* hs2 = (const LAS float*)(lds + HS2) + tokv * 33 + 8 * c4;
    const LAS float* ga = (const LAS float*)(lds + GA);
    const float rden = 1.f / fmaxf(fabsf(ga[O_D1 + tokv] + ga[O_D2 + tokv]), ga[O_FL + tokv]);
    const unsigned ow[4] = {ograw.x, ograw.y, ograw.z, ograw.w}, zw[4] = {szraw.x, szraw.y, szraw.z, szraw.w};
    float sq = 0.f; unsigned outw[4];
#pragma unroll
    for (int e = 0; e < 4; ++e) {
        const float g0 = bf_lo(ow[e]) * ((hs1[2 * e] + hs2[2 * e]) * rden), g1 = bf_hi(ow[e]) * ((hs1[2 * e + 1] + hs2[2 * e + 1]) * rden);
        sq += g0 * g0 + g1 * g1;
        outw[e] = cvt_pk_bf16(g0 * bf_lo(zw[e]), g1 * bf_hi(zw[e]));
    }
    sq += __shfl_xor(sq, 1); sq += __shfl_xor(sq, 2);
    *(u32x4*)(OGb + row * 1024 + vcol) = (u32x4){outw[0], outw[1], outw[2], outw[3]};
    if (c4 == 0) SSQH[row * 32 + h * 8 + s] = sq;
}

template <int VAR>
__device__ __forceinline__ void phase(const Args& a, LAS unsigned char* lds, int layer, int G) {
    int tid = threadIdx.x; asm volatile("" : "+v"(tid));
    unsigned char* ws = a.ws; (void)layer;
    const bf16_t* QCb = (const bf16_t*)(ws + WS_HB1); const bf16_t* Vb = (const bf16_t*)(ws + WS_S1);
    bf16_t* OGb = (bf16_t*)(ws + WS_S2); const bf16_t* SZb = (const bf16_t*)(ws + WS_S3);
    float* SSQH = (float*)(ws + WS_SSQH);
    for (int item = blockIdx.x; item < 256; item += G) {
        const int xx = item & 7, kk = item >> 3, bh = xx * 4 + (kk >> 3), s = kk & 7, b = bh >> 2, h = bh & 3;
        const size_t rowbase = (size_t)b * SEQ;
        {
            unsigned z0 = 0u; asm volatile("" : "+v"(z0));
            for (int i = tid; i < 2 * CBUF / 4; i += NTHR) ((LAS unsigned*)(lds + CS))[i] = z0;
        }
        f32x4 Cacc[3][2];
#pragma unroll
        for (int vt = 0; vt < 3; ++vt) { Cacc[vt][0] = (f32x4){0.f, 0.f, 0.f, 0.f}; Cacc[vt][1] = (f32x4){0.f, 0.f, 0.f, 0.f}; }
        float mprev = 0.f;
        u32x4 qk[4]; u32x4 vraw = (u32x4){0u, 0u, 0u, 0u}, ograw = vraw, szraw = vraw;
        {
#pragma unroll
            for (int i = 0; i < 4; ++i) { const int p = (tid + 512 * i) & 1023, row = p >> 4, c16 = p & 15;
                qk[i] = *(const u32x4*)(QCb + (rowbase + row) * 1024 + (i >= 2 ? 512 : 0) + h * 128 + c16 * 8); }
            if (tid < 256) vraw = *(const u32x4*)(Vb + (rowbase + ((tid >> 2) & 63)) * 1024 + h * 256 + s * 32 + 8 * (tid & 3));
        }
        {
            const u32x4* src = (const u32x4*)((const float*)(ws + WS_LSE) + (size_t)bh * 3 * SEQ);
            u32x4 tv[6];
#pragma unroll
            for (int q = 0; q < 6; ++q) tv[q] = src[tid + 512 * q];
#pragma unroll
            for (int q = 0; q < 6; ++q) *(LAS u32x4*)(lds + TA + (tid + 512 * q) * 16) = tv[q];
        }
        __syncthreads();
#pragma nounroll
        for (int c = 0; c < (VAR == 6 ? 0 : 64); ++c) {
            int tl = tid; asm volatile("" : "+v"(tl));
            const int w = __builtin_amdgcn_readfirstlane(tl >> 6), lane = tl & 63, grp = lane >> 4, ql = lane & 15;
            const int tokv = (tl >> 2) & 63, c4 = tl & 3;
            const int vcol = h * 256 + s * 32 + 8 * c4;
            LAS float* ga = (LAS float*)(lds + GA);
            const int t0 = c * 64, cur = c & 1, nxt = cur ^ 1;
            const LAS float* tA = (const LAS float*)(lds + TA) + c * 64; const LAS float* tPM = (const LAS float*)(lds + TPM) + c * 64; const LAS float* tB = (const LAS float*)(lds + TB) + c * 64;
            const float mcur = mprev;
            const float cmax = tPM[63];
            const float Mlast = fmaxf(mcur, cmax);
            const float decay = __expf(mcur - Mlast), sB = __expf(cmax - Mlast);
            mprev = tB[63] + Mlast;
            if (VAR != 5 && c > 0 && tl < 256) flush_out(lds, OGb, SSQH, rowbase + (t0 - 64) + tokv, vcol, tokv, c4, h, s, ograw, szraw);
            if (VAR != 5) {
                const int p0 = tl, p1 = tl + 512;
                *(LAS u32x4*)(lds + QS + (p0 >> 4) * QSTR + (p0 & 15) * 16) = qk[0];
                *(LAS u32x4*)(lds + QS + (p1 >> 4) * QSTR + (p1 & 15) * 16) = qk[1];
                *(LAS u32x4*)(lds + KS + (p0 >> 4) * QSTR + (p0 & 15) * 16) = qk[2];
                *(LAS u32x4*)(lds + KS + (p1 >> 4) * QSTR + (p1 & 15) * 16) = qk[3];
                if (tl < 256) {
                    const float ea = __expf(tA[tokv] - cmax);
                    u32x4 vs; vs.x = cvt_pk_bf16(bf_lo(vraw.x) * ea, bf_hi(vraw.x) * ea); vs.y = cvt_pk_bf16(bf_lo(vraw.y) * ea, bf_hi(vraw.y) * ea);
                    vs.z = cvt_pk_bf16(bf_lo(vraw.z) * ea, bf_hi(vraw.z) * ea); vs.w = cvt_pk_bf16(bf_lo(vraw.w) * ea, bf_hi(vraw.w) * ea);
                    *(LAS u32x4*)(lds + VS + tokv * VSTR + c4 * 16) = vs;
                }
            }
            LDS_WAIT();
            if (w == 7) ga[O_EA + lane] = __expf(tA[lane] - cmax);
            if (VAR != 1 && VAR != 4 && VAR != 5) { if (tl < 256) { const size_t row = rowbase + t0 + tokv; ograw = *(const u32x4*)(OGb + row * 1024 + vcol); szraw = *(const u32x4*)(SZb + row * 1024 + vcol); } }
            if (VAR == 1 || VAR == 4 || VAR == 5) { asm volatile("" : "+v"(qk[0]), "+v"(qk[1]), "+v"(qk[2]), "+v"(qk[3]), "+v"(vraw), "+v"(ograw), "+v"(szraw)); }
            if (VAR != 1 && VAR != 4 && VAR != 5 && c < 63) {
#pragma unroll
                for (int i = 0; i < 4; ++i) { const int p = (tl + 512 * i) & 1023, row = p >> 4, c16 = p & 15;
                    qk[i] = *(const u32x4*)(QCb + (rowbase + t0 + 64 + row) * 1024 + (i >= 2 ? 512 : 0) + h * 128 + c16 * 8); }
                if (tl < 256) vraw = *(const u32x4*)(Vb + (rowbase + t0 + 64 + tokv) * 1024 + vcol);
            }
            LDS_BARRIER();
            const LAS unsigned char* vbase = lds + VS + (4 * grp + (ql >> 2)) * VSTR + (ql & 3) * 8;
            if (VAR == 2 || VAR == 4 || VAR == 5) { } else if (w < 4) {
                const int ti = w, i = 16 * ti + ql;
                bf16x8 Qf[4];
                {
                    const LAS unsigned char* qb = lds + QS + i * QSTR + grp * 16;
#pragma unroll
                    for (int ks = 0; ks < 4; ++ks) Qf[ks] = *(const LAS bf16x8*)(qb + ks * 64);
                }
                const float Mi = fmaxf(mcur, tPM[i]), eb = __expf(cmax - Mi), flr = __expf(-(tB[i] + Mi));
                f32x4 wt[4];
                const LAS unsigned char* kb = lds + KS + ql * QSTR + grp * 16;
#pragma unroll
                for (int tj = 0; tj < 4; ++tj) {
                    f32x4 sacc = (f32x4){0.f, 0.f, 0.f, 0.f};
                    if (tj <= ti) {
#pragma unroll
                        for (int ks = 0; ks < 4; ++ks) sacc = __builtin_amdgcn_mfma_f32_16x16x32_bf16(*(const LAS bf16x8*)(kb + tj * 16 * QSTR + ks * 64), Qf[ks], sacc, 0, 0, 0);
                    }
                    if (tj == ti) {
#pragma unroll
                        for (int ii = 0; ii < 4; ++ii) sacc[ii] = (4 * grp + ii <= ql) ? sacc[ii] : 0.f;
                    }
                    wt[tj] = sacc;
                }
                f32x4 acc1[3];
#pragma unroll
                for (int vt = 0; vt < 3; ++vt) acc1[vt] = (f32x4){0.f, 0.f, 0.f, 0.f};
#pragma unroll
                for (int p = 0; p < 2; ++p) {
                    u32x4 pw; pw.x = cvt_pk_bf16(wt[2 * p][0], wt[2 * p][1]); pw.y = cvt_pk_bf16(wt[2 * p][2], wt[2 * p][3]); pw.z = cvt_pk_bf16(wt[2 * p + 1][0], wt[2 * p + 1][1]); pw.w = cvt_pk_bf16(wt[2 * p + 1][2], wt[2 * p + 1][3]);
                    const bf16x8 Pf = __builtin_bit_cast(bf16x8, pw);
#pragma unroll
                    for (int vt = 0; vt < 2; ++vt) {
                        const s16x4 lo = __builtin_amdgcn_ds_read_tr16_b64_v4i16((LAS s16x4*)(vbase + (32 * p) * VSTR + vt * 32));
                        const s16x4 hi = __builtin_amdgcn_ds_read_tr16_b64_v4i16((LAS s16x4*)(vbase + (32 * p + 16) * VSTR + vt * 32));
                        acc1[vt] = __builtin_amdgcn_mfma_f32_16x16x32_bf16((bf16x8){lo[0], lo[1], lo[2], lo[3], hi[0], hi[1], hi[2], hi[3]}, Pf, acc1[vt], 0, 0, 0);
                    }
                    const f32x4 e0 = *(const LAS f32x4*)(ga + O_EA + 32 * p + 4 * grp), e1 = *(const LAS f32x4*)(ga + O_EA + 32 * p + 16 + 4 * grp);
                    u32x4 aw; aw.x = cvt_pk_bf16(e0[0], e0[1]); aw.y = cvt_pk_bf16(e0[2], e0[3]); aw.z = cvt_pk_bf16(e1[0], e1[1]); aw.w = cvt_pk_bf16(e1[2], e1[3]);
                    if (ql != 0) aw = (u32x4){0u, 0u, 0u, 0u};
                    acc1[2] = __builtin_amdgcn_mfma_f32_16x16x32_bf16(__builtin_bit_cast(bf16x8, aw), Pf, acc1[2], 0, 0, 0);
                }
                LAS float* hsw = (LAS float*)(lds + HS1) + i * 33 + 4 * grp;
#pragma unroll
                for (int vt = 0; vt < 2; ++vt)
#pragma unroll
                    for (int ii = 0; ii < 4; ++ii) hsw[16 * vt + ii] = acc1[vt][ii] * eb;
                if (grp == 0) { ga[O_D1 + i] = acc1[2][0] * eb; ga[O_FL + i] = flr; }
            } else {
                const int wb = w - 4, i = 16 * wb + ql;
                {
                    bf16x8 Qf[4];
                    const LAS unsigned char* qb = lds + QS + i * QSTR + grp * 16;
#pragma unroll
                    for (int ks = 0; ks < 4; ++ks) Qf[ks] = *(const LAS bf16x8*)(qb + ks * 64);
                    f32x4 acc2[3];
#pragma unroll
                    for (int vt = 0; vt < 3; ++vt) acc2[vt] = (f32x4){0.f, 0.f, 0.f, 0.f};
                    const LAS unsigned char* cb = lds + CS + cur * CBUF + ql * CSTR + grp * 16;
#pragma unroll
                    for (int vt = 0; vt < 3; ++vt)
#pragma unroll
                        for (int ks = 0; ks < 4; ++ks) acc2[vt] = __builtin_amdgcn_mfma_f32_16x16x32_bf16(*(const LAS bf16x8*)(cb + vt * 16 * CSTR + ks * 64), Qf[ks], acc2[vt], 0, 0, 0);
                    const float inter = __expf(mcur - fmaxf(mcur, tPM[i]));
                    LAS float* hsw = (LAS float*)(lds + HS2) + i * 33 + 4 * grp;
#pragma unroll
                    for (int vt = 0; vt < 2; ++vt)
#pragma unroll
                        for (int ii = 0; ii < 4; ++ii) hsw[16 * vt + ii] = acc2[vt][ii] * inter;
                    if (grp == 0) ga[O_D2 + i] = acc2[2][0] * inter;
                }
                f32x4 U[3][2];
#pragma unroll
                for (int vt = 0; vt < 3; ++vt) { U[vt][0] = (f32x4){0.f, 0.f, 0.f, 0.f}; U[vt][1] = (f32x4){0.f, 0.f, 0.f, 0.f}; }
                const LAS unsigned char* kbase = lds + KS + (4 * grp + (ql >> 2)) * QSTR + (ql & 3) * 8 + wb * 64;
#pragma unroll
                for (int p = 0; p < 2; ++p) {
                    bf16x8 Af[3];
#pragma unroll
                    for (int vt = 0; vt < 2; ++vt) {
                        const s16x4 lo = __builtin_amdgcn_ds_read_tr16_b64_v4i16((LAS s16x4*)(vbase + (32 * p) * VSTR + vt * 32));
                        const s16x4 hi = __builtin_amdgcn_ds_read_tr16_b64_v4i16((LAS s16x4*)(vbase + (32 * p + 16) * VSTR + vt * 32));
                        Af[vt] = (bf16x8){lo[0], lo[1], lo[2], lo[3], hi[0], hi[1], hi[2], hi[3]};
                    }
                    { const f32x4 e0 = *(const LAS f32x4*)(ga + O_EA + 32 * p + 4 * grp), e1 = *(const LAS f32x4*)(ga + O_EA + 32 * p + 16 + 4 * grp);
                      u32x4 aw; aw.x = cvt_pk_bf16(e0[0], e0[1]); aw.y = cvt_pk_bf16(e0[2], e0[3]); aw.z = cvt_pk_bf16(e1[0], e1[1]); aw.w = cvt_pk_bf16(e1[2], e1[3]);
                      if (ql != 0) aw = (u32x4){0u, 0u, 0u, 0u};
                      Af[2] = __builtin_bit_cast(bf16x8, aw); }
#pragma unroll
                    for (int dl = 0; dl < 2; ++dl) {
                        const s16x4 lo = __builtin_amdgcn_ds_read_tr16_b64_v4i16((LAS s16x4*)(kbase + (32 * p) * QSTR + dl * 32));
                        const s16x4 hi = __builtin_amdgcn_ds_read_tr16_b64_v4i16((LAS s16x4*)(kbase + (32 * p + 16) * QSTR + dl * 32));
                        const bf16x8 Bk = (bf16x8){lo[0], lo[1], lo[2], lo[3], hi[0], hi[1], hi[2], hi[3]};
#pragma unroll
                        for (int vt = 0; vt < 3; ++vt) U[vt][dl] = __builtin_amdgcn_mfma_f32_16x16x32_bf16(Af[vt], Bk, U[vt][dl], 0, 0, 0);
                    }
                }
#pragma unroll
                for (int vt = 0; vt < 3; ++vt)
#pragma unroll
                    for (int dl = 0; dl < 2; ++dl) Cacc[vt][dl] = Cacc[vt][dl] * decay + U[vt][dl] * sB;
                LAS unsigned char* cw_ = lds + CS + nxt * CBUF + (4 * grp) * CSTR + (32 * wb + ql) * 2;
#pragma unroll
                for (int dl = 0; dl < 2; ++dl) {
#pragma unroll
                    for (int vt = 0; vt < 2; ++vt)
#pragma unroll
                        for (int ii = 0; ii < 4; ++ii) *(LAS bf16_t*)(cw_ + (16 * vt + ii) * CSTR + dl * 32) = f2bf(Cacc[vt][dl][ii]);
                    if (grp == 0) *(LAS bf16_t*)(cw_ + 32 * CSTR + dl * 32) = f2bf(Cacc[2][dl][0]);
                }
            }
            LDS_BARRIER();
        }
        if (tid < 256) flush_out(lds, OGb, SSQH, rowbase + 63 * 64 + ((tid >> 2) & 63), h * 256 + s * 32 + 8 * (tid & 3), (tid >> 2) & 63, tid & 3, h, s, ograw, szraw);
        __syncthreads();
    }
}
}

__device__ __forceinline__ void mlstm_norm_phase(const Args& a, int gtid, int NGT) {
    const u32x4* A = (const u32x4*)(a.ws + WS_S2); u32x4* Y = (u32x4*)(a.ws + WS_S0); const float* SSQH = (const float*)(a.ws + WS_SSQH);
    for (int i = gtid; i < T * 128; i += NGT) {
        const int t = i >> 7, c8 = i & 127, h = c8 >> 5;
        const f32x4 s0 = *(const f32x4*)(SSQH + (size_t)t * 32 + h * 8), s1 = *(const f32x4*)(SSQH + (size_t)t * 32 + h * 8 + 4);
        const float rs = rsqrtf((((s0.x + s0.y) + (s0.z + s0.w)) + ((s1.x + s1.y) + (s1.z + s1.w))) * (1.f / 256.f) + EPS);
        const u32x4 v = A[i]; u32x4 o;
        o.x = cvt_pk_bf16(bf_lo(v.x) * rs, bf_hi(v.x) * rs); o.y = cvt_pk_bf16(bf_lo(v.y) * rs, bf_hi(v.y) * rs);
        o.z = cvt_pk_bf16(bf_lo(v.z) * rs, bf_hi(v.z) * rs); o.w = cvt_pk_bf16(bf_lo(v.w) * rs, bf_hi(v.w) * rs);
        Y[i] = o;
    }
}

namespace attn {
constexpr int KS = 0, VS = 69632;
constexpr int KSTR = 272, VSTR = 288;
typedef short s16x4 __attribute__((ext_vector_type(4)));
struct Item { int b, head, g, res, blk, r; };
__device__ __forceinline__ Item decode(int item) {
    const int xcd = item & 7, q = item >> 3, bhh = xcd + 8 * (q / 96), gi = q % 96;
    Item it; it.b = bhh >> 2; it.head = bhh & 3;
    if (gi < 32) { it.g = 0; it.res = 0; it.blk = gi; it.r = 1; } else if (gi < 64) { it.g = 1; it.res = (gi - 32) >> 3; it.blk = (gi - 32) & 7; it.r = 4; } else { it.g = 2; it.res = (gi - 64) >> 1; it.blk = (gi - 64) & 1; it.r = 16; }
    return it;
}
template <int VAR>
__device__ __forceinline__ void phase(const Args& a, LAS unsigned char* lds, int jl, int G) {
    int tid = threadIdx.x; asm volatile("" : "+v"(tid));
    unsigned char* ws = a.ws; (void)jl;
    const bf16_t* Kb = (const bf16_t*)(ws + WS_S0); const bf16_t* Vb = (const bf16_t*)(ws + WS_S0 + 32 * MiB);
    bf16_t* Qb = (bf16_t*)(ws + WS_S1);
    float* LSE = (float*)(ws + WS_LSE);
    { unsigned z0 = 0u; asm volatile("" : "+v"(z0)); if (tid < 16 * 18) *(LAS u32x4*)(lds + VS + 256 * VSTR + tid * 16) = (u32x4){z0, z0, z0, z0}; }
    u32x4 kreg[8], vreg[8]; bf16x8 qreg[4];
#define ATTN_LOAD(itm) do { const Item it_ = decode(itm); const size_t rb_ = (size_t)it_.b * SEQ; \
        _Pragma("unroll") for (int c_ = 0; c_ < 8; ++c_) { const int p_ = tid + 512 * c_, kj_ = p_ >> 4, u_ = (it_.blk - 1) * 128 + kj_, pos_ = u_ >= 0 ? u_ * it_.r + it_.res : 0; \
            const size_t off_ = (rb_ + pos_) * 512 + it_.head * 128 + (p_ & 15) * 8; kreg[c_] = *(const u32x4*)(Kb + off_); vreg[c_] = *(const u32x4*)(Vb + off_); } \
        const int lane_ = tid & 63, w_ = tid >> 6, posq_ = (128 * it_.blk + 16 * w_ + (lane_ & 15)) * it_.r + it_.res; \
        const bf16_t* qs_ = Qb + (rb_ + posq_) * 1536 + (it_.g * 4 + it_.head) * 128 + 8 * (lane_ >> 4); \
        _Pragma("unroll") for (int ks2_ = 0; ks2_ < 4; ++ks2_) qreg[ks2_] = *(const bf16x8*)(qs_ + 32 * ks2_); } while (0)
    int bx0 = blockIdx.x; asm volatile("" : "+s"(bx0));
    if (bx0 < 3072) ATTN_LOAD(bx0);
    if (VAR == 1) { _Pragma("unroll") for (int c_ = 0; c_ < 8; ++c_) asm volatile("" : "+v"(kreg[c_]), "+v"(vreg[c_])); }
#pragma nounroll
    for (int item = bx0; item < 3072; item += G) {
        int tl = tid; asm volatile("" : "+v"(tl));
        const int w = __builtin_amdgcn_readfirstlane(tl >> 6), lane = tl & 63, grp = lane >> 4, ql = lane & 15;
        const Item it = decode(item);
        const int blk = it.blk;
        const size_t rowbase = (size_t)it.b * SEQ;
#pragma unroll
        for (int c = 0; c < 8; ++c) {
            const int p = tl + 512 * c, kj = p >> 4, ch = p & 15;
            u32x4 kv = kreg[c], vv = vreg[c];
            if (blk == 0 && kj < 128) { kv = (u32x4){0u, 0u, 0u, 0u}; vv = kv; }
            *(LAS u32x4*)(lds + KS + kj * KSTR + ch * 16) = kv; *(LAS u32x4*)(lds + VS + kj * VSTR + ch * 16) = vv;
        }
        bf16x8 Qf[4];
#pragma unroll
        for (int ks = 0; ks < 4; ++ks) Qf[ks] = qreg[ks];
        const int qi = 16 * w + ql;
        const int posq = (128 * blk + qi) * it.r + it.res;
        bf16_t* orow = Qb + (rowbase + posq) * 1536 + (it.g * 4 + it.head) * 128 + 4 * grp;
        LDS_BARRIER();
        float mx = -__builtin_inff(); float den = 0.f;
        f32x4 oacc[8];
#pragma unroll
        for (int dt = 0; dt < 8; ++dt) oacc[dt] = (f32x4){0.f, 0.f, 0.f, 0.f};
        if (VAR != 2) {
        f32x4 sc[9];
        const int dbase = 128 + ql - 4 * grp; const unsigned dmax = (blk > 0) ? 128u : (unsigned)qi;
        const LAS unsigned char* kbase = lds + KS + (16 * w + ql) * KSTR + grp * 16;
        bf16x8 kf[2][4];
#pragma unroll
        for (int ks = 0; ks < 4; ++ks) kf[0][ks] = *(const LAS bf16x8*)(kbase + ks * 64);
#pragma unroll
        for (int tt = 0; tt < 9; ++tt) {
            if (tt < 8) {
#pragma unroll
                for (int ks = 0; ks < 4; ++ks) kf[(tt + 1) & 1][ks] = *(const LAS bf16x8*)(kbase + (tt + 1) * 16 * KSTR + ks * 64);
            }
            f32x4 acc = (f32x4){0.f, 0.f, 0.f, 0.f};
#pragma unroll
            for (int ks = 0; ks < 4; ++ks) acc = __builtin_amdgcn_mfma_f32_16x16x32_bf16(kf[tt & 1][ks], Qf[ks], acc, 0, 0, 0);
#pragma unroll
            for (int ii = 0; ii < 4; ++ii) {
                const int dist = dbase - 16 * tt - ii;
                const float v = ((unsigned)dist <= dmax) ? acc[ii] * 0.08838834764831845f : -__builtin_inff();
                sc[tt][ii] = v; mx = fmaxf(mx, v);
            }
        }
        if (VAR != 1) { if (item + G < 3072) ATTN_LOAD(item + G); }
        mx = fmaxf(mx, __shfl_xor(mx, 16)); mx = fmaxf(mx, __shfl_xor(mx, 32));
#pragma unroll
        for (int tt = 0; tt < 9; ++tt)
#pragma unroll
            for (int ii = 0; ii < 4; ++ii) { const float e = __expf(sc[tt][ii] - mx); sc[tt][ii] = e; den += e; }
        den += __shfl_xor(den, 16); den += __shfl_xor(den, 32);
        const LAS unsigned char* vbase = lds + VS + (16 * w + 4 * grp + (ql >> 2)) * VSTR + (ql & 3) * 8;
#pragma unroll
        for (int pp = 0; pp < 5; ++pp) {
            u32x4 pw;
            pw.x = cvt_pk_bf16(sc[2 * pp][0], sc[2 * pp][1]); pw.y = cvt_pk_bf16(sc[2 * pp][2], sc[2 * pp][3]);
            if (pp < 4) { pw.z = cvt_pk_bf16(sc[2 * pp + 1][0], sc[2 * pp + 1][1]); pw.w = cvt_pk_bf16(sc[2 * pp + 1][2], sc[2 * pp + 1][3]); } else { pw.z = 0u; pw.w = 0u; }
            const bf16x8 Pf = __builtin_bit_cast(bf16x8, pw);
#pragma unroll
            for (int dh = 0; dh < 2; ++dh) {
                s16x4 lo[4], hi[4];
#pragma unroll
                for (int d4 = 0; d4 < 4; ++d4) {
                    lo[d4] = __builtin_amdgcn_ds_read_tr16_b64_v4i16((LAS s16x4*)(vbase + pp * 32 * VSTR + (4 * dh + d4) * 32));
                    hi[d4] = __builtin_amdgcn_ds_read_tr16_b64_v4i16((LAS s16x4*)(vbase + pp * 32 * VSTR + 16 * VSTR + (4 * dh + d4) * 32));
                }
#pragma unroll
                for (int d4 = 0; d4 < 4; ++d4) {
                    const bf16x8 av = (bf16x8){lo[d4][0], lo[d4][1], lo[d4][2], lo[d4][3], hi[d4][0], hi[d4][1], hi[d4][2], hi[d4][3]};
                    oacc[4 * dh + d4] = __builtin_amdgcn_mfma_f32_16x16x32_bf16(av, Pf, oacc[4 * dh + d4], 0, 0, 0);
                }
            }
        }
        } else { den = 1.f; mx = 0.f; if (item + G < 3072) ATTN_LOAD(item + G); }
        const float inv = 1.f / den;
#pragma unroll
        for (int dt = 0; dt < 8; ++dt) { u32x2 o; o.x = cvt_pk_bf16(oacc[dt][0] * inv, oacc[dt][1] * inv); o.y = cvt_pk_bf16(oacc[dt][2] * inv, oacc[dt][3] * inv);
            *(u32x2*)(orow + 16 * dt) = o; }
        if (grp == 0) LSE[((size_t)it.g * T + rowbase + posq) * 4 + it.head] = mx + __logf(den);
        LDS_BARRIER();
    }
#undef ATTN_LOAD
}
}

__device__ __forceinline__ void attn_combine_phase(const Args& a, int gtid, int NGT) {
    const bf16_t* O = (const bf16_t*)(a.ws + WS_S1); const u32x4* SZ = (const u32x4*)(a.ws + WS_S3); u32x4* Y = (u32x4*)(a.ws + WS_S3 + 32 * MiB);
    const float* LSE = (const float*)(a.ws + WS_LSE);
    for (int i = gtid; i < T * 64; i += NGT) {
        const int t = i >> 6, c8 = i & 63, h = c8 >> 4;
        const float l0 = LSE[((size_t)0 * T + t) * 4 + h], l1 = LSE[((size_t)1 * T + t) * 4 + h], l2 = LSE[((size_t)2 * T + t) * 4 + h];
        const float m = fmaxf(l0, fmaxf(l1, l2));
        float w0 = __expf(l0 - m), w1 = __expf(l1 - m), w2 = __expf(l2 - m);
        const float inv = 1.f / (w0 + w1 + w2); w0 *= inv; w1 *= inv; w2 *= inv;
        const u32x4 o0 = *(const u32x4*)(O + (size_t)t * 1536 + c8 * 8), o1 = *(const u32x4*)(O + (size_t)t * 1536 + 512 + c8 * 8), o2 = *(const u32x4*)(O + (size_t)t * 1536 + 1024 + c8 * 8);
        const u32x4 z = SZ[i];
        const unsigned a0[4] = {o0.x, o0.y, o0.z, o0.w}, a1[4] = {o1.x, o1.y, o1.z, o1.w}, a2[4] = {o2.x, o2.y, o2.z, o2.w}, zz[4] = {z.x, z.y, z.z, z.w};
        unsigned ow[4];
#pragma unroll
        for (int e = 0; e < 4; ++e) {
            const float lo = (w0 * bf_lo(a0[e]) + w1 * bf_lo(a1[e]) + w2 * bf_lo(a2[e])) * bf_lo(zz[e]);
            const float hi = (w0 * bf_hi(a0[e]) + w1 * bf_hi(a1[e]) + w2 * bf_hi(a2[e])) * bf_hi(zz[e]);
            ow[e] = cvt_pk_bf16(lo, hi);
        }
        Y[i] = (u32x4){ow[0], ow[1], ow[2], ow[3]};
    }
}

typedef const __attribute__((address_space(4))) Args* KArgs;
#define LOADARGS(name) Args name; { KArgs _k = kp; asm volatile("" : "+s"(_k)); name = *_k; }

__global__ void __launch_bounds__(NTHR, 2) fwd_megakernel(Args args_unused) {
#if defined(__HIP_DEVICE_COMPILE__)
    extern __shared__ __attribute__((aligned(16))) unsigned char lds_raw[];
    LAS unsigned char* lds = (LAS unsigned char*)lds_raw;
    KArgs kp = (KArgs)__builtin_amdgcn_kernarg_segment_ptr();
    const int G = gridDim.x, bx = blockIdx.x;
    {
        const int tid = threadIdx.x;
        volatile LAS unsigned* MISC0 = (volatile LAS unsigned*)(lds + MISC_OFF);
        if (tid < 64) MISC0[tid] = 0u;
        __syncthreads();
    }
    { LOADARGS(a); (void)xcd_barrier_post((unsigned*)(a.ws + WS_CTL) + CW_BAR, (volatile LAS unsigned*)(lds + MISC_OFF) + 8); }
#define GRID_BAR() do { LOADARGS(a_); XcdBarrier b_; b_.bar = (unsigned*)(a_.ws + WS_CTL) + CW_BAR; b_.x = xb_xcc_id(); b_.st = (volatile LAS unsigned*)(lds + MISC_OFF) + 8; xcd_barrier(b_); } while (0)
#define THREAD_IDS() int tid = threadIdx.x; asm volatile("" : "+v"(tid)); const int lane = tid & 63, wave = __builtin_amdgcn_readfirstlane(tid >> 6); \
    const int vcu = (G % 8 == 0) ? (bx % 8) * (G / 8) + bx / 8 : bx; const int gw = vcu * NWAVES + wave, NGW = G * NWAVES, gtid = vcu * NTHR + tid, NGT = G * NTHR; (void)lane; (void)gw; (void)NGW; (void)gtid; (void)NGT;

#define PH_PROLOGUE() { LOADARGS(a); THREAD_IDS(); prologue(a, lds, gw, NGW, lane, wave); }
#define PH_P1A(layer) { \
            { LOADARGS(a); unsigned char* ws = a.ws; \
              pg8::Gemm g{(const bf16_t*)(ws + WS_HB0), (const bf16_t*)(ws + WS_WINA) + (size_t)(layer) * 4096 * 1024, T, 4096, 1024}; \
              pg8::StaticOrder S; S.init(T, 4096, G, bx); \
              pg8::EpiP E{0, (const float*)(ws + WS_SSQ0), ws, nullptr, nullptr, lds}; \
              pg8::gemm_phase<pg8::EpiP, pg8::StaticOrder, true, true>(lds + RING_OFF, g, S, E); } \
            { LOADARGS(a); THREAD_IDS(); gates_job(a, (layer), (const bf16_t*)(a.ws + WS_HB0), (const float*)(a.ws + WS_SSQ0), gw, NGW, lane); } \
            { LOADARGS(a); THREAD_IDS(); convert_p(a, (layer), gtid, NGT); } }
#define PH_CONV(layer) { LOADARGS(a); THREAD_IDS(); conv_phase(a, (layer), gtid, NGT, gw, NGW, lane); }
#if defined(PROBE_VARIANT) && PROBE_KIND == 2
#define PH_SCAN(layer) { LOADARGS(a); if (pass == 0 && r_ > 0) scan::phase<PROBE_VARIANT>(a, lds, (layer), G); else scan::phase<0>(a, lds, (layer), G); }
#else
#define PH_SCAN(layer) { LOADARGS(a); scan::phase<0>(a, lds, (layer), G); }
#endif
#define PH_NORM() { LOADARGS(a); THREAD_IDS(); mlstm_norm_phase(a, gtid, NGT); }
#define PH_P3A(layer) { \
              LOADARGS(a); unsigned char* ws = a.ws; \
              pg8::Gemm g{(const bf16_t*)(ws + WS_S0), (const bf16_t*)(ws + WS_WOUTA) + (size_t)(layer) * 1024 * 1024, T, 1024, 1024}; \
              pg8::StaticOrder S; S.init(T, 1024, G, bx); \
              pg8::EpiF E{0, (const bf16_t*)(ws + WS_HB0), (bf16_t*)(ws + WS_HB1), (float*)(ws + WS_SSQ1), nullptr, nullptr, nullptr}; \
              pg8::gemm_phase<pg8::EpiF, pg8::StaticOrder, true, true>(lds + RING_OFF, g, S, E); }
#define PH_P1B(jl, layer) { \
            { LOADARGS(a); unsigned char* ws = a.ws; \
              const int N = ((jl) == 0) ? 3072 : 2048; \
              pg8::Gemm g{(const bf16_t*)(ws + WS_HB0), (const bf16_t*)(ws + ((jl) == 0 ? WS_WINB0 : WS_WINB1)), T, N, 1024}; \
              pg8::StaticOrder S; S.init(T, N, G, bx); \
              pg8::EpiP E{1, (const float*)(ws + WS_SSQ0), ws, a.qnorm_b + (jl) * 128, a.knorm, lds}; \
              pg8::gemm_phase<pg8::EpiP, pg8::StaticOrder, true, true>(lds + RING_OFF, g, S, E); } \
            { LOADARGS(a); THREAD_IDS(); convert_p(a, (layer), gtid, NGT); } }
#if defined(PROBE_VARIANT) && PROBE_KIND == 3
#define PH_ATTN(jl) { LOADARGS(a); if (pass == 0 && r_ > 0) attn::phase<PROBE_VARIANT>(a, lds, (jl), G); else attn::phase<0>(a, lds, (jl), G); }
#else
#define PH_ATTN(jl) { LOADARGS(a); attn::phase<0>(a, lds, (jl), G); }
#endif
#define PH_COMBINE() { LOADARGS(a); THREAD_IDS(); attn_combine_phase(a, gtid, NGT); }
#define PH_P3B(jl) { \
              LOADARGS(a); unsigned char* ws = a.ws; \
              pg8::Gemm g{(const bf16_t*)(ws + WS_S3 + 32 * MiB), (const bf16_t*)(ws + WS_WOUTB) + (size_t)(jl) * 1024 * 512, T, 1024, 512}; \
              pg8::StaticOrder S; S.init(T, 1024, G, bx); \
              pg8::EpiF E{0, (const bf16_t*)(ws + WS_HB0), (bf16_t*)(ws + WS_HB1), (float*)(ws + WS_SSQ1), nullptr, nullptr, nullptr}; \
              pg8::gemm_phase<pg8::EpiF, pg8::StaticOrder, true, true>(lds + RING_OFF, g, S, E); }
#define PH_PP(layer) { \
            LOADARGS(a); unsigned char* ws = a.ws; \
            pg8::Gemm g2{(const bf16_t*)(ws + WS_PB), (const bf16_t*)(ws + WS_WPLE) + (size_t)(layer) * 1024 * 256, T, 1024, 256}; \
            pg8::StaticOrder S; S.init(T, 1024, G, bx); \
            pg8::EpiP E2{2, nullptr, ws, nullptr, nullptr, lds}; \
            pg8::gemm_phase<pg8::EpiP, pg8::StaticOrder, true, true>(lds + RING_OFF, g2, S, E2); }
#define PH_P4(layer) { \
            LOADARGS(a); unsigned char* ws = a.ws; \
            pg8::Gemm g{(const bf16_t*)(ws + WS_HB1), (const bf16_t*)(ws + WS_WGATE) + (size_t)(layer) * 1024 * 1024, T, 1024, 1024}; \
            pg8::StaticOrder S; S.init(T, 1024, G, bx); \
            pg8::EpiF E{1, (const bf16_t*)(ws + WS_HB1), (bf16_t*)(ws + WS_HB0), (float*)(ws + WS_SSQ0), (const float*)(ws + WS_SSQ1), (const bf16_t*)(ws + WS_S1), ((layer) == DEPTH - 1) ? a.out : nullptr}; \
            pg8::gemm_phase<pg8::EpiF, pg8::StaticOrder, true, true>(lds + RING_OFF, g, S, E); }

#if defined(PROBE_KIND)
#define REP(kind) _Pragma("nounroll") for (int r_ = 0; r_ < ((PROBE_KIND == (kind) && pass == 0) ? PROBE_REPS : 1); ++r_)
#define LASTBAR() GRID_BAR()
#pragma nounroll
    for (int pass = 0; pass < 2; ++pass) {
#else
#define REP(kind)
#define LASTBAR() if (layer < DEPTH - 1) GRID_BAR()
    {
#endif
    REP(1) { PH_PROLOGUE(); GRID_BAR(); }
#pragma nounroll
    for (int layer = 0; layer < DEPTH; ++layer) {
        if (layer < 2) {
            REP(4) { PH_P1A(layer); GRID_BAR(); }
            REP(12) { PH_CONV(layer); GRID_BAR(); }
            REP(2) { PH_SCAN(layer); GRID_BAR(); }
            REP(6) { PH_NORM(); GRID_BAR(); }
            REP(9) { PH_P3A(layer); }
        } else {
            const int jl = layer - 2;
            REP(11) { PH_P1B(jl, layer); GRID_BAR(); }
            REP(3) { PH_ATTN(jl); GRID_BAR(); }
            REP(7) { PH_COMBINE(); GRID_BAR(); }
            REP(10) { PH_P3B(jl); }
        }
        REP(8) { PH_PP(layer); }
        GRID_BAR();
        REP(5) { PH_P4(layer); LASTBAR(); }
    }
    }
#endif
}

extern "C" void kernel_launch(void* const* d_in, const int* in_sizes, int n_in, void* d_out, int out_size, void* d_ws, size_t ws_size, hipStream_t stream) {
    static int grid = 0;
    if (grid == 0) {
        if (n_in != 18 || in_sizes[0] != T * D || out_size != T * D || ws_size < WS_END) { fprintf(stderr, "kernel_launch: unexpected shapes (n_in %d, in0 %d, out %d, ws %zu)\n", n_in, n_in > 0 ? in_sizes[0] : -1, out_size, ws_size); grid = -1; return; }
        int dev = 0, cus = 0, per_cu = 0;
        if (hipGetDevice(&dev) != hipSuccess || hipDeviceGetAttribute(&cus, hipDeviceAttributeMultiprocessorCount, dev) != hipSuccess) { fprintf(stderr, "kernel_launch: device query failed\n"); grid = -1; return; }
        if (hipFuncSetAttribute((const void*)fwd_megakernel, hipFuncAttributeMaxDynamicSharedMemorySize, LDS_BYTES) != hipSuccess) { fprintf(stderr, "kernel_launch: hipFuncSetAttribute failed\n"); grid = -1; return; }
        if (hipOccupancyMaxActiveBlocksPerMultiprocessor(&per_cu, (const void*)fwd_megakernel, NTHR, LDS_BYTES) != hipSuccess || per_cu < 1)
            fprintf(stderr, "kernel_launch: note: occupancy query reports %d workgroups per CU\n", per_cu);
        (void)hipGetLastError();
        grid = cus;
        if (grid > 256) grid = 256;
    }
    if (grid < 0) return;
    if (hipMemsetAsync((char*)d_ws + WS_CTL, 0, CTL_ZERO_BYTES, stream) != hipSuccess) { fprintf(stderr, "kernel_launch: memset failed\n"); return; }
    Args a{};
    a.x = (const float*)d_in[0]; a.p = (const float*)d_in[1]; a.norm_a = (const float*)d_in[2]; a.w_in_a = (const float*)d_in[3]; a.conv_a = (const float*)d_in[4];
    a.b_gate_a = (const float*)d_in[5]; a.hnorm_a = (const float*)d_in[6]; a.w_out_a = (const float*)d_in[7]; a.norm_kv = (const float*)d_in[8]; a.w_kv = (const float*)d_in[9];
    a.knorm = (const float*)d_in[10]; a.norm_b = (const float*)d_in[11]; a.w_in_b = (const float*)d_in[12]; a.qnorm_b = (const float*)d_in[13]; a.w_out_b = (const float*)d_in[14];
    a.ple_norm = (const float*)d_in[15]; a.w_ple_gate = (const float*)d_in[16]; a.w_ple = (const float*)d_in[17];
    a.out = (float*)d_out; a.ws = (unsigned char*)d_ws;
    hipLaunchKernelGGL(fwd_megakernel, dim3(grid), dim3(NTHR), LDS_BYTES, stream, a);
    const hipError_t le = hipPeekAtLastError();
    if (le != hipSuccess) fprintf(stderr, "kernel_launch: launch failed: %s\n", hipGetErrorName(le));
}
```

```cpp
#include <hip/hip_runtime.h>
#include <cstdio>
#include <cstdint>

#define LAS __attribute__((address_space(3)))
#define GAS __attribute__((address_space(1)))
typedef unsigned short bf16_t;
typedef short bf16x8 __attribute__((ext_vector_type(8)));
typedef float f32x4 __attribute__((ext_vector_type(4)));
typedef unsigned u32x4 __attribute__((ext_vector_type(4)));
typedef unsigned u32x2 __attribute__((ext_vector_type(2)));

constexpr int BATCH = 8, SEQ = 4096, T = BATCH * SEQ, D = 1024, DEPTH = 4, PLE = 256;
constexpr int A_COLS = 4104;
constexpr float EPS = 1e-6f;

typedef __bf16 bf16x2_t __attribute__((ext_vector_type(2)));
typedef float f32x2_t __attribute__((ext_vector_type(2)));
__device__ __forceinline__ unsigned cvt_pk_bf16(float lo, float hi) { const f32x2_t v = {lo, hi}; return __builtin_bit_cast(unsigned, __builtin_convertvector(v, bf16x2_t)); }
__device__ __forceinline__ float bf_lo(unsigned w) { return __uint_as_float(w << 16); }
__device__ __forceinline__ float bf_hi(unsigned w) { return __uint_as_float(w & 0xffff0000u); }
__device__ __forceinline__ float bf2f(bf16_t b) { return __uint_as_float(((unsigned)b) << 16); }
__device__ __forceinline__ bf16_t f2bf(float f) { return (bf16_t)(cvt_pk_bf16(f, 0.f) & 0xffffu); }
__device__ __forceinline__ float sigmoidf_(float x) { return 1.f / (1.f + __expf(-x)); }
__device__ __forceinline__ float ssq16_rstd(const float* ssq, int row) {
    const f32x4* p = (const f32x4*)(ssq + (size_t)row * 16);
    const f32x4 a = p[0], b = p[1], c = p[2], d = p[3];
    const float s = ((a.x + a.y) + (a.z + a.w)) + ((b.x + b.y) + (b.z + b.w)) + ((c.x + c.y) + (c.z + c.w)) + ((d.x + d.y) + (d.z + d.w));
    return rsqrtf(s * (1.f / 1024.f) + EPS);
}

constexpr size_t WS_S0_ = (size_t)208 << 20, WS_S1_ = (size_t)272 << 20, WS_S2_ = (size_t)336 << 20, WS_S3_ = (size_t)400 << 20;
namespace pg8 {
#define PG8_LAS __attribute__((address_space(3)))
constexpr int BM = 256, BK = 64, HALF = 128, HTB = HALF * BK * 2, STAGE_BYTES = 8 * HTB, NXCD = 8, WGM = 8;
__host__ __device__ __forceinline__ int lds_byte(int r, int c) { const int st = (r >> 4) * 2 + (c >> 5), rr = r & 15, cc = c & 31, ob = rr * 64 + cc * 2; return st * 1024 + (ob ^ (((ob >> 9) & 1) << 5)); }
__host__ __device__ __forceinline__ void stage_rc(int b, int& R, int& C) { const int st = b / 1024, sb = b % 1024, swz = sb ^ (((sb >> 9) & 1) << 5); R = (st >> 1) * 16 + swz / 64; C = (st & 1) * 32 + (swz % 64) / 2; }
__host__ __device__ __forceinline__ int perm32(int rho) { const int n = rho >> 4, i = rho & 15; return 8 * (i >> 2) + 4 * n + (i & 3); }

struct Unit { int pm, pn, idx; };
struct Gemm { const bf16_t* A; const bf16_t* Bt; int M, N, K; };
struct StaticOrder {
    int nM, nN, nwg, G, c;
    __host__ __device__ void init(int M, int N, int G_, int c_) { nM = M / BM; nN = N / BM; nwg = nM * nN; G = G_; c = c_; }
    __host__ __device__ __forceinline__ bool next(int i, Unit& u) const {
        const long L = (long)i * G + c; if (L >= nwg) return false;
        int wgid = (int)L; { const int q = nwg / NXCD, r = nwg % NXCD, xcd = wgid % NXCD, off = wgid / NXCD; wgid = (xcd < r ? xcd * (q + 1) : r * (q + 1) + (xcd - r) * q) + off; }
        const int nig = WGM * nN, gid = wgid / nig, fm = gid * WGM, gsz = (nM - fm) < WGM ? (nM - fm) : WGM;
        u.pm = fm + ((wgid % nig) % gsz); u.pn = (wgid % nig) / gsz; return true;
    }
    __device__ __forceinline__ void a_ready(const Unit&) const {}
    __device__ __forceinline__ void done(const Unit&) const {}
};


struct EpiP {
    static constexpr bool PERM = true, AFTER_DRAIN = false;
    int mode; const float* ssq; unsigned char* ws; const float* qg; const float* kg; PG8_LAS unsigned char* lds;
    __device__ __forceinline__ void operator()(const f32x4 (&acc)[2][2][4][2], const Unit& u, int wr, int wc, int fr, int fq) const {
        const int row0 = u.pm * BM + wr * 64 + fr;
        size_t boff; int ldc, colt, act = 0;
        if (mode == 0) { const int ten = u.pn >> 2; boff = WS_S0_ + (size_t)ten * (64u << 20); ldc = 1024; colt = (u.pn & 3) * 256; act = ten == 2 ? 1 : ten == 3 ? 2 : 0; }
        else if (mode == 1) {
            if (u.pn < 6) { boff = WS_S1_; ldc = 1536; colt = u.pn * 256; act = 3; }
            else if (u.pn < 8) { boff = WS_S3_; ldc = 512; colt = (u.pn - 6) * 256; act = 2; }
            else if (u.pn < 10) { boff = WS_S0_; ldc = 512; colt = (u.pn - 8) * 256; act = 3; }
            else { boff = WS_S0_ + (32u << 20); ldc = 512; colt = (u.pn - 10) * 256; }
        } else { boff = WS_S1_; ldc = 1024; colt = u.pn * 256; }
        bf16_t* base = (bf16_t*)(ws + boff);
        if (act == 3) {
            PG8_LAS float* X = (PG8_LAS float*)(lds + 131072);
            const float* gn = (u.pn < 6) ? qg : kg;
            const float* COS = (const float*)(ws + ((size_t)2 << 20)); const float* SIN = (const float*)(ws + ((size_t)3 << 20));
#pragma unroll
            for (int ai = 0; ai < 2; ++ai)
#pragma unroll
                for (int m = 0; m < 4; ++m) {
                    const int rl = ai * HALF + wr * 64 + m * 16 + fr;
                    const float rs = ssq16_rstd(ssq, u.pm * BM + rl);
#pragma unroll
                    for (int bj = 0; bj < 2; ++bj) {
                        const f32x4 v0 = acc[ai][bj][m][0] * rs, v1 = acc[ai][bj][m][1] * rs;
                        float sq = (v0[0] * v0[0] + v0[1] * v0[1]) + (v0[2] * v0[2] + v0[3] * v0[3]) + (v1[0] * v1[0] + v1[1] * v1[1]) + (v1[2] * v1[2] + v1[3] * v1[3]);
                        sq += __shfl_xor(sq, 16); sq += __shfl_xor(sq, 32);
                        if (fq == 0) X[(rl * 2 + bj) * 4 + wc] = sq;
                    }
                }
            asm volatile("s_waitcnt lgkmcnt(0)" ::: "memory"); __builtin_amdgcn_s_barrier(); asm volatile("" ::: "memory");
            const int d0 = 16 * wc + 4 * fq;
            const f32x4 g1 = *(const f32x4*)(gn + d0), g2 = *(const f32x4*)(gn + 64 + d0);
#pragma unroll
            for (int ai = 0; ai < 2; ++ai)
#pragma unroll
                for (int m = 0; m < 4; ++m) {
                    const int rl = ai * HALF + wr * 64 + m * 16 + fr, row = u.pm * BM + rl, pos = row & (SEQ - 1);
                    const float rs = ssq16_rstd(ssq, row);
                    const f32x4 cs = *(const f32x4*)(COS + pos * 64 + d0), sn = *(const f32x4*)(SIN + pos * 64 + d0);
#pragma unroll
                    for (int bj = 0; bj < 2; ++bj) {
                        const f32x4 xs = *(const PG8_LAS f32x4*)(X + (rl * 2 + bj) * 4);
                        const float rh = rs * rsqrtf(((xs[0] + xs[1]) + (xs[2] + xs[3])) * (1.f / 128.f) + EPS);
                        const f32x4 x1 = acc[ai][bj][m][0] * rh * g1, x2 = acc[ai][bj][m][1] * rh * g2;
                        const f32x4 o1 = x1 * cs - x2 * sn, o2 = x2 * cs + x1 * sn;
                        bf16_t* p = base + (size_t)row * ldc + colt + bj * HALF + d0;
                        u32x2 w1, w2; w1.x = cvt_pk_bf16(o1[0], o1[1]); w1.y = cvt_pk_bf16(o1[2], o1[3]); w2.x = cvt_pk_bf16(o2[0], o2[1]); w2.y = cvt_pk_bf16(o2[2], o2[3]);
                        *(u32x2*)p = w1; *(u32x2*)(p + 64) = w2;
                    }
                    asm volatile("" ::: "memory");
                }
            return;
        }
        const int col0 = colt + wc * 32 + 8 * fq;
#pragma unroll
        for (int ai = 0; ai < 2; ++ai)
#pragma unroll
            for (int m = 0; m < 4; ++m) {
                const int row = row0 + ai * HALF + m * 16;
                const float rs = (mode == 2) ? 1.f : ssq16_rstd(ssq, row);
                bf16_t* rowp = base + (size_t)row * ldc + col0;
#pragma unroll
                for (int bj = 0; bj < 2; ++bj) {
                    f32x4 v0 = acc[ai][bj][m][0] * rs, v1 = acc[ai][bj][m][1] * rs;
                    if (act == 1) {
#pragma unroll
                        for (int j = 0; j < 4; ++j) { v0[j] = sigmoidf_(v0[j]); v1[j] = sigmoidf_(v1[j]); }
                    } else if (act == 2) {
#pragma unroll
                        for (int j = 0; j < 4; ++j) { v0[j] = v0[j] * sigmoidf_(v0[j]); v1[j] = v1[j] * sigmoidf_(v1[j]); }
                    }
                    u32x4 w; w.x = cvt_pk_bf16(v0[0], v0[1]); w.y = cvt_pk_bf16(v0[2], v0[3]); w.z = cvt_pk_bf16(v1[0], v1[1]); w.w = cvt_pk_bf16(v1[2], v1[3]);
                    *(u32x4*)(rowp + bj * HALF) = w;
                }
                asm volatile("" ::: "memory");
            }
    }
};
struct EpiF {
    static constexpr bool PERM = true, AFTER_DRAIN = false;
    int mode; const bf16_t* hres; bf16_t* hb; float* ssq_out; const float* ssq_in; const bf16_t* pp; float* fout;
    __device__ __forceinline__ void operator()(const f32x4 (&acc)[2][2][4][2], const Unit& u, int wr, int wc, int fr, int fq) const {
        const int row0 = u.pm * BM + wr * 64 + fr, col0 = u.pn * BM + wc * 32 + 8 * fq;
#pragma unroll
        for (int ai = 0; ai < 2; ++ai)
#pragma unroll
            for (int m = 0; m < 4; ++m) {
                const int row = row0 + ai * HALF + m * 16;
                const size_t off = (size_t)row * 1024 + col0;
                float rs = 1.f; if (mode == 1) rs = ssq16_rstd(ssq_in, row);
                float sq = 0.f;
#pragma unroll
                for (int bj = 0; bj < 2; ++bj) {
                    const size_t o = off + bj * HALF;
                    const u32x4 hw = *(const u32x4*)(hres + o);
                    f32x4 v0 = acc[ai][bj][m][0], v1 = acc[ai][bj][m][1];
                    if (mode == 1) {
                        const u32x4 pw = *(const u32x4*)(pp + o);
                        v0[0] = bf_lo(pw.x) * sigmoidf_(v0[0] * rs); v0[1] = bf_hi(pw.x) * sigmoidf_(v0[1] * rs); v0[2] = bf_lo(pw.y) * sigmoidf_(v0[2] * rs); v0[3] = bf_hi(pw.y) * sigmoidf_(v0[3] * rs);
                        v1[0] = bf_lo(pw.z) * sigmoidf_(v1[0] * rs); v1[1] = bf_hi(pw.z) * sigmoidf_(v1[1] * rs); v1[2] = bf_lo(pw.w) * sigmoidf_(v1[2] * rs); v1[3] = bf_hi(pw.w) * sigmoidf_(v1[3] * rs);
                    }
                    f32x4 h0, h1;
                    h0[0] = bf_lo(hw.x) + v0[0]; h0[1] = bf_hi(hw.x) + v0[1]; h0[2] = bf_lo(hw.y) + v0[2]; h0[3] = bf_hi(hw.y) + v0[3];
                    h1[0] = bf_lo(hw.z) + v1[0]; h1[1] = bf_hi(hw.z) + v1[1]; h1[2] = bf_lo(hw.w) + v1[2]; h1[3] = bf_hi(hw.w) + v1[3];
                    if (fout) { *(f32x4*)(fout + o) = h0; *(f32x4*)(fout + o + 4) = h1; }
                    else { u32x4 w; w.x = cvt_pk_bf16(h0[0], h0[1]); w.y = cvt_pk_bf16(h0[2], h0[3]); w.z = cvt_pk_bf16(h1[0], h1[1]); w.w = cvt_pk_bf16(h1[2], h1[3]); *(u32x4*)(hb + o) = w; }
                    sq += ((h0[0] * h0[0] + h0[1] * h0[1]) + (h0[2] * h0[2] + h0[3] * h0[3])) + ((h1[0] * h1[0] + h1[1] * h1[1]) + (h1[2] * h1[2] + h1[3] * h1[3]));
                }
                sq += __shfl_xor(sq, 16); sq += __shfl_xor(sq, 32);
                if (fq == 0 && !fout) ssq_out[(size_t)row * 16 + u.pn * 4 + wc] = sq;
                asm volatile("" ::: "memory");
            }
    }
};

template <class Epi, class Sched, bool ALIGN_EPI = false, bool SP2 = false, bool HS = false>
__device__ __forceinline__ void gemm_phase(PG8_LAS unsigned char* lds, const Gemm g, const Sched& S, const Epi& E, const PG8_LAS float* rt = nullptr) {
    int tid = threadIdx.x; asm volatile("" : "+v"(tid));
    const int wid = __builtin_amdgcn_readfirstlane(tid >> 6), lane = tid & 63, wr = wid >> 2, wc = wid & 3, fr = lane & 15, fq = lane >> 4;
    const int K = g.K, nt = HS ? 4 : K / BK;
    unsigned voffA[2], voffB[2];
#pragma unroll
    for (int i = 0; i < 2; ++i) { int R, C; stage_rc(tid * 16 + i * 8192, R, C); const int Rb = Epi::PERM ? ((R & ~31) + perm32(R & 31)) : R;
        voffA[i] = (unsigned)(R * K + C) * 2u; voffB[i] = (unsigned)(Rb * K + C) * 2u; }
    const size_t kstep = (size_t)(BK * 2);
    const size_t hstep = (size_t)HALF * K * 2;
    const size_t tstep = 2 * hstep;
    const unsigned ldsw = (unsigned)wid * 1024u;
    const int aoff = lds_byte(wr * 64 + fr, fq * 8), boff = lds_byte(wc * 32 + fr, fq * 8);
#define PG8_SA(b, h) (((b) * 2 + (h)) * HTB)
#define PG8_SB(b, h) ((4 + (b) * 2 + (h)) * HTB)
#define PG8_STAGE(bufoff, gbase, voff) do { _Pragma("unroll") for (int _i = 0; _i < 2; ++_i) \
        __builtin_amdgcn_global_load_lds((const unsigned*)((const char*)(gbase) + (voff)[_i]), (PG8_LAS unsigned*)(lds + (bufoff) + ldsw + _i * 8192), 16, 0, 0); } while (0)
#define PG8_LDA(dst, b, h) do { _Pragma("unroll") for (int m = 0; m < 4; ++m) _Pragma("unroll") for (int k = 0; k < 2; ++k) dst[m][k] = *(const PG8_LAS bf16x8*)(lds + PG8_SA(b, h) + aoff + m * 2048 + k * 1024); } while (0)
#define PG8_LDB(dst, b, h) do { _Pragma("unroll") for (int n = 0; n < 2; ++n) _Pragma("unroll") for (int k = 0; k < 2; ++k) dst[n][k] = *(const PG8_LAS bf16x8*)(lds + PG8_SB(b, h) + boff + n * 2048 + k * 1024); } while (0)
#define PG8_MMA(ai, bj, At, Bt) do { __builtin_amdgcn_s_setprio(1); _Pragma("unroll") for (int m = 0; m < 4; ++m) _Pragma("unroll") for (int n = 0; n < 2; ++n) _Pragma("unroll") for (int k = 0; k < 2; ++k) \
        acc[ai][bj][m][n] = __builtin_amdgcn_mfma_f32_16x16x32_bf16(Bt[n][k], At[m][k], acc[ai][bj][m][n], 0, 0, 0); __builtin_amdgcn_s_setprio(0); } while (0)
#define PG8_RESCALE(hsel) do { int lz_ = lane; asm volatile("" : "+v"(lz_));   \
        const PG8_LAS float* rp_ = rt + ((ui >> 2) & 1) * 1024 + (wr * 64 + (lz_ & 15)) * 4 + (hsel); \
        _Pragma("unroll") for (int ai_ = 0; ai_ < 2; ++ai_) _Pragma("unroll") for (int m_ = 0; m_ < 4; ++m_) { const float f_ = rp_[(ai_ * HALF + m_ * 16) * 4]; \
            _Pragma("unroll") for (int bj_ = 0; bj_ < 2; ++bj_) { acc[ai_][bj_][m_][0] = acc[ai_][bj_][m_][0] * f_; acc[ai_][bj_][m_][1] = acc[ai_][bj_][m_][1] * f_; } } } while (0)
#define PG8_WAIT_V(n) asm volatile("s_waitcnt vmcnt(" #n ")" ::: "memory")
#define PG8_WAIT_L(n) asm volatile("s_waitcnt lgkmcnt(" #n ")" ::: "memory")
#define PG8_BAR __builtin_amdgcn_s_barrier()
#define PG8_SCHED __builtin_amdgcn_sched_barrier(0)
    Unit cur, nxt; int ui = 0;
    if (!S.next(0, cur)) return;
    cur.idx = 0;
    constexpr size_t HSTEP = 512;
    f32x4 acc[2][2][4][2];
#pragma unroll
    for (int a = 0; a < 2; ++a)
#pragma unroll
        for (int b = 0; b < 2; ++b)
#pragma unroll
            for (int m = 0; m < 4; ++m)
#pragma unroll
                for (int n = 0; n < 2; ++n) acc[a][b][m][n] = (f32x4){0.f, 0.f, 0.f, 0.f};
    bf16x8 At[4][2], B0[2][2], B1[2][2];
    const char* cA = (const char*)g.A + (size_t)cur.pm * tstep; const char* cB = (const char*)g.Bt + (size_t)cur.pn * tstep;
    S.a_ready(cur);
    if constexpr (SP2) {
        PG8_STAGE(PG8_SB(0, 0), cB, voffB); PG8_STAGE(PG8_SB(0, 1), cB + hstep, voffB); PG8_STAGE(PG8_SA(0, 0), cA, voffA); PG8_STAGE(PG8_SA(0, 1), cA + hstep, voffA);
        if (wr == 1) PG8_BAR;
        PG8_WAIT_V(2); PG8_BAR;
        PG8_STAGE(PG8_SB(1, 0), cB + kstep, voffB); PG8_STAGE(PG8_SA(1, 0), cA + kstep, voffA); PG8_STAGE(PG8_SB(1, 1), cB + hstep + kstep, voffB);
        PG8_WAIT_V(6); PG8_BAR;
    } else {
        PG8_STAGE(PG8_SB(0, 0), cB, voffB); PG8_STAGE(PG8_SA(0, 0), cA, voffA); PG8_STAGE(PG8_SB(0, 1), cB + hstep, voffB); PG8_STAGE(PG8_SA(0, 1), cA + hstep, voffA);
        if (wr == 1) PG8_BAR;
        PG8_WAIT_V(4); PG8_BAR;
        PG8_STAGE(PG8_SB(1, 0), cB + kstep, voffB); PG8_STAGE(PG8_SA(1, 0), cA + kstep, voffA); PG8_STAGE(PG8_SB(1, 1), cB + hstep + kstep, voffB);
        PG8_WAIT_V(6); PG8_BAR;
    }
    for (;;) {
        const bool has_next = S.next(HS ? ((ui + 1) >> 2) : (ui + 1), nxt); nxt.idx = HS ? ((ui + 1) >> 2) : (ui + 1);
        const size_t nko = HS ? (size_t)((ui + 1) & 3) * HSTEP : 0;
        const char* nA = has_next ? (const char*)g.A + (size_t)nxt.pm * tstep + nko : cA; const char* nB = has_next ? (const char*)g.Bt + (size_t)nxt.pn * tstep + nko : cB;
#pragma nounroll
        for (int t = 0; t < nt; t += 2) {
            const bool last = (t == nt - 2);
            const char* a1 = cA + (size_t)(t + 1) * kstep;
            const char* a2 = last ? nA : cA + (size_t)(t + 2) * kstep; const char* b2 = last ? nB : cB + (size_t)(t + 2) * kstep;
            const char* a3 = a2 + kstep; const char* b3 = b2 + kstep;
            if (last && has_next) S.a_ready(nxt);
            if constexpr (SP2) {
            PG8_LDB(B0, 0, 0); PG8_LDB(B1, 0, 1); PG8_SCHED; PG8_LDA(At, 0, 0); PG8_STAGE(PG8_SA(1, 1), a1 + hstep, voffA);
            PG8_WAIT_V(8); PG8_WAIT_L(0); PG8_BAR; PG8_MMA(0, 0, At, B0); PG8_MMA(0, 1, At, B1); PG8_BAR; PG8_SCHED;
            PG8_LDA(At, 0, 1); PG8_STAGE(PG8_SB(0, 0), b2, voffB); PG8_STAGE(PG8_SB(0, 1), b2 + hstep, voffB); PG8_STAGE(PG8_SA(0, 0), a2, voffA);
            PG8_WAIT_V(8); PG8_WAIT_L(0); PG8_BAR; PG8_MMA(1, 0, At, B0); PG8_MMA(1, 1, At, B1); PG8_BAR; PG8_SCHED;
            PG8_LDB(B0, 1, 0); PG8_LDB(B1, 1, 1); PG8_SCHED; PG8_LDA(At, 1, 0); PG8_STAGE(PG8_SA(0, 1), a2 + hstep, voffA);
            PG8_WAIT_V(8); PG8_WAIT_L(0); PG8_BAR; PG8_MMA(0, 0, At, B0); PG8_MMA(0, 1, At, B1); PG8_BAR; PG8_SCHED;
            PG8_LDA(At, 1, 1); PG8_STAGE(PG8_SB(1, 0), b3, voffB); PG8_STAGE(PG8_SB(1, 1), b3 + hstep, voffB); PG8_STAGE(PG8_SA(1, 0), a3, voffA);
            PG8_WAIT_V(8); PG8_WAIT_L(0); PG8_BAR; PG8_MMA(1, 0, At, B0); PG8_MMA(1, 1, At, B1); PG8_BAR; PG8_SCHED;
            } else {
            PG8_LDB(B0, 0, 0); PG8_SCHED; PG8_LDA(At, 0, 0); PG8_STAGE(PG8_SA(1, 1), a1 + hstep, voffA);
            PG8_WAIT_L(8); PG8_BAR; PG8_WAIT_L(0); PG8_MMA(0, 0, At, B0); PG8_BAR; PG8_SCHED;
            PG8_LDB(B1, 0, 1); PG8_STAGE(PG8_SB(0, 0), b2, voffB);
            PG8_BAR; PG8_WAIT_L(0); PG8_MMA(0, 1, At, B1); PG8_BAR;
            PG8_LDA(At, 0, 1); PG8_STAGE(PG8_SA(0, 0), a2, voffA);
            PG8_BAR; PG8_WAIT_L(0); PG8_MMA(1, 0, At, B0); PG8_BAR; PG8_SCHED;
            PG8_STAGE(PG8_SB(0, 1), b2 + hstep, voffB);
            PG8_WAIT_V(6); PG8_BAR; PG8_MMA(1, 1, At, B1); PG8_BAR;
            PG8_LDB(B0, 1, 0); PG8_SCHED; PG8_LDA(At, 1, 0); PG8_STAGE(PG8_SA(0, 1), a2 + hstep, voffA);
            PG8_WAIT_L(8); PG8_BAR; PG8_WAIT_L(0); PG8_MMA(0, 0, At, B0); PG8_BAR; PG8_SCHED;
            PG8_LDB(B1, 1, 1); PG8_STAGE(PG8_SB(1, 0), b3, voffB);
            PG8_BAR; PG8_WAIT_L(0); PG8_MMA(0, 1, At, B1); PG8_BAR;
            PG8_LDA(At, 1, 1); PG8_STAGE(PG8_SA(1, 0), a3, voffA);
            PG8_BAR; PG8_WAIT_L(0); PG8_MMA(1, 0, At, B0); PG8_BAR; PG8_SCHED;
            PG8_STAGE(PG8_SB(1, 1), b3 + hstep, voffB);
            PG8_WAIT_V(6); PG8_BAR; PG8_MMA(1, 1, At, B1); PG8_BAR;
            }
        }
        if constexpr (HS) { PG8_RESCALE(ui & 3); }
        const bool tile_done = !HS || (ui & 3) == 3;
        if (tile_done) {
        if constexpr (ALIGN_EPI) { if (wr == 0) PG8_BAR; }
        if constexpr (!Epi::AFTER_DRAIN) { E(acc, cur, wr, wc, fr, fq); S.done(cur); }
        }
        if (!has_next) break;
        if (tile_done) {
#pragma unroll
        for (int a = 0; a < 2; ++a)
#pragma unroll
            for (int b = 0; b < 2; ++b)
#pragma unroll
                for (int m = 0; m < 4; ++m)
#pragma unroll
                    for (int n = 0; n < 2; ++n) acc[a][b][m][n] = (f32x4){0.f, 0.f, 0.f, 0.f};
        }
        cur = nxt; cA = nA; cB = nB; ++ui;
        if (tile_done) { if constexpr (ALIGN_EPI) { if (wr == 1) PG8_BAR; } }
    }
    PG8_WAIT_V(0);
    if constexpr (!ALIGN_EPI) { if (wr == 0) PG8_BAR; }
    PG8_BAR;
#undef PG8_SA
#undef PG8_SB
#undef PG8_STAGE
#undef PG8_LDA
#undef PG8_LDB
#undef PG8_MMA
#undef PG8_WAIT_V
#undef PG8_RESCALE
#undef PG8_WAIT_L
#undef PG8_BAR
#undef PG8_SCHED
}
}

constexpr size_t MiB = 1u << 20;
constexpr size_t WS_CTL = 0, CTL_ZERO_BYTES = 1 * MiB;
constexpr size_t WS_COS = 2 * MiB, WS_SIN = 3 * MiB;
constexpr size_t WS_WG8 = 4 * MiB;
constexpr size_t WS_GATES = 5 * MiB;
constexpr size_t WS_LSE = 6 * MiB;
constexpr size_t WS_SSQ0 = 8 * MiB, WS_SSQ1 = 10 * MiB;
constexpr size_t WS_SSQH = 12 * MiB;
constexpr size_t WS_WINA = 16 * MiB;
constexpr size_t WS_WOUTA = 32 * MiB;
constexpr size_t WS_WINB0 = 36 * MiB;
constexpr size_t WS_WINB1 = 42 * MiB;
constexpr size_t WS_WOUTB = 46 * MiB;
constexpr size_t WS_WGATE = 48 * MiB;
constexpr size_t WS_WPLE = 56 * MiB;
constexpr size_t WS_HB0 = 64 * MiB, WS_HB1 = 128 * MiB;
constexpr size_t WS_PB = 192 * MiB;
constexpr size_t WS_S0 = WS_S0_, WS_S1 = WS_S1_, WS_S2 = WS_S2_, WS_S3 = WS_S3_, WS_END = 464 * MiB;
constexpr int CW_BAR = 4096;

#define XB_TMO      128
#define XB_XCNT(j)  (256  + 64 * (j))
#define XB_XSUB(j)  (1280 + 64 * (j))
#define XB_XGEN(j)  (2304 + 64 * (j))
#define XB_TOP      3328
#define XB_TOPGEN   3392
#define XCD_BAR_WORDS 3456
#define XB_SPIN_CAP (1u << 18)
__device__ __forceinline__ unsigned xb_ld(unsigned* p)              { return __hip_atomic_load(p, __ATOMIC_RELAXED, __HIP_MEMORY_SCOPE_AGENT); }
__device__ __forceinline__ unsigned xb_add(unsigned* p, unsigned v) { return __hip_atomic_fetch_add(p, v, __ATOMIC_RELAXED, __HIP_MEMORY_SCOPE_AGENT); }
__device__ __forceinline__ unsigned xb_xcc_id() { return (unsigned)__builtin_amdgcn_s_getreg((3 << 11) | 20) & 0xFu; }
#define XB_SPIN(cond, bar) do { unsigned _sp = 0; while (cond) { __builtin_amdgcn_s_sleep(1); \
    if ((++_sp & 255u) == 0u) { if (xb_ld(&(bar)[XB_TMO])) break; if (_sp > XB_SPIN_CAP) { atomicAdd(&(bar)[XB_TMO], 1u); break; } } } } while (0)
struct XcdBarrier { unsigned* bar; unsigned x; volatile LAS unsigned* st; };
__device__ __forceinline__ XcdBarrier xcd_barrier_post(unsigned* bar, volatile LAS unsigned* st) {
    XcdBarrier b; b.bar = bar; b.x = xb_xcc_id(); b.st = st;
    if (threadIdx.x == 0) (void)xb_add(&bar[XB_XCNT(b.x)], 1u);
    return b;
}
__device__ __forceinline__ void xcd_barrier_complete(unsigned* bar, unsigned x, unsigned& nloc, unsigned& nx) {
    const unsigned G = gridDim.x * gridDim.y * gridDim.z;
    unsigned sum, cnt, mine, sp = 0u;
    for (;;) {
        sum = 0u; cnt = 0u; mine = 0u;
#pragma unroll
        for (unsigned j = 0; j < 16; ++j) { const unsigned c = xb_ld(&bar[XB_XCNT(j)]); sum += c; cnt += (c > 0u) ? 1u : 0u; mine = (j == x) ? c : mine; }
        if (sum == G) break;
        __builtin_amdgcn_s_sleep(1);
        if ((++sp & 255u) == 0u) { if (xb_ld(&bar[XB_TMO])) break; if (sp > XB_SPIN_CAP) { atomicAdd(&bar[XB_TMO], 1u); break; } }
    }
    nloc = mine > 0u ? mine : 1u; nx = cnt > 0u ? cnt : 1u;
}
__device__ __forceinline__ void xcd_barrier(const XcdBarrier& b) {
    asm volatile("s_waitcnt vmcnt(0)" ::: "memory");
    __syncthreads();
    if (threadIdx.x == 0) {
        unsigned* bar = b.bar;
        __builtin_amdgcn_s_waitcnt(0);
        unsigned nloc = b.st[0], nx = b.st[1];
        if (nloc == 0u) { xcd_barrier_complete(bar, b.x, nloc, nx); b.st[0] = nloc; b.st[1] = nx; }
        const unsigned old = xb_add(&bar[XB_XSUB(b.x)], 1u);
        const unsigned gen = old / nloc;
        if (old + 1u == (gen + 1u) * nloc) {
            __builtin_amdgcn_fence(__ATOMIC_RELEASE, "agent");
            asm volatile("s_waitcnt vmcnt(0)" ::: "memory");
            const unsigned og = xb_add(&bar[XB_TOP], 1u);
            const unsigned tg = og / nx;
            if (og + 1u == (tg + 1u) * nx) xb_add(&bar[XB_TOPGEN], 1u);
            else XB_SPIN(xb_ld(&bar[XB_TOPGEN]) == tg, bar);
            __builtin_amdgcn_fence(__ATOMIC_ACQUIRE, "agent");
            xb_add(&bar[XB_XGEN(b.x)], 1u);
            asm volatile("s_waitcnt vmcnt(0)" ::: "memory");
        } else {
            XB_SPIN(xb_ld(&bar[XB_XGEN(b.x)]) == gen, bar);
            __builtin_amdgcn_fence(__ATOMIC_ACQUIRE, "agent");
            asm volatile("s_waitcnt vmcnt(0)" ::: "memory");
        }
    }
    __syncthreads();
}

struct Args {
    const float* x; const float* p; const float* norm_a; const float* w_in_a; const float* conv_a; const float* b_gate_a; const float* hnorm_a; const float* w_out_a;
    const float* norm_kv; const float* w_kv; const float* knorm; const float* norm_b; const float* w_in_b; const float* qnorm_b; const float* w_out_b;
    const float* ple_norm; const float* w_ple_gate; const float* w_ple;
    float* out; unsigned char* ws;
};

constexpr int NWAVES = 8, NTHR = 512;
constexpr int RING_OFF = 0;
constexpr int MISC_OFF = 160 * 1024 - 256;
constexpr int LDS_BYTES = 160 * 1024;

#define LDS_WAIT() asm volatile("s_waitcnt lgkmcnt(0)" ::: "memory")
#define LDS_BARRIER() do { asm volatile("s_waitcnt lgkmcnt(0)" ::: "memory"); __builtin_amdgcn_s_barrier(); asm volatile("" ::: "memory"); } while (0)

__device__ __forceinline__ void transpose_item(const float* W, int K, int ldw, int ncol0, int nblk, const float* gain, bf16_t* WT, int row_off, int nperm, LAS float* scr, int item, int lane) {
    const int kb = item / nblk, nb = item % nblk, k0 = 64 * kb, n0 = 32 * nb;
    {
        const int kr = lane >> 3, n4 = (lane & 7) * 4;
        f32x4 wv[8]; float gv[8];
#pragma unroll
        for (int i = 0; i < 8; ++i) { wv[i] = *(const f32x4*)(W + (size_t)(k0 + 8 * i + kr) * ldw + ncol0 + n0 + n4); gv[i] = gain ? gain[k0 + 8 * i + kr] : 1.f; }
#pragma unroll
        for (int i = 0; i < 8; ++i) { LAS float* d = scr + (8 * i + kr) * 33 + n4; d[0] = wv[i].x * gv[i]; d[1] = wv[i].y * gv[i]; d[2] = wv[i].z * gv[i]; d[3] = wv[i].w * gv[i]; }
    }
    LDS_WAIT(); asm volatile("" ::: "memory");
    const int c = lane & 7;
#pragma unroll
    for (int j = 0; j < 4; ++j) { const int n = (lane >> 3) + 8 * j; const LAS float* s = scr + (8 * c) * 33 + n;
        u32x4 o; o.x = cvt_pk_bf16(s[0 * 33], s[1 * 33]); o.y = cvt_pk_bf16(s[2 * 33], s[3 * 33]); o.z = cvt_pk_bf16(s[4 * 33], s[5 * 33]); o.w = cvt_pk_bf16(s[6 * 33], s[7 * 33]);
        int col = n0 + n; if (col < nperm) { const int d = col & 127; col = (col & ~127) + 32 * ((d & 63) >> 4) + 8 * ((d >> 2) & 3) + 4 * (d >> 6) + (d & 3); }
        *(u32x4*)(WT + (size_t)(row_off + col) * K + k0 + 8 * c) = o; }
    LDS_WAIT(); asm volatile("" ::: "memory");
}

__device__ __forceinline__ void prologue(const Args& a, LAS unsigned char* lds, int gw, int NGW, int lane, int wave) {
    unsigned char* ws = a.ws;
    LAS float* scr = (LAS float*)(lds + wave * 16384);
    struct TJ { const float* W; int K, ldw, ncol0, ncols; const float* gain; bf16_t* dst; int row_off, nperm; };
    int it = gw;
    for (int job = 0; job < 17; ++job) {
        TJ j;
        if (job < 2)       j = TJ{a.w_in_a + (size_t)job * 1024 * A_COLS, 1024, A_COLS, 0, 4096, a.norm_a + job * 1024, (bf16_t*)(ws + WS_WINA) + (size_t)job * 4096 * 1024, 0, 0};
        else if (job < 4)  j = TJ{a.w_out_a + (size_t)(job - 2) * 1024 * 1024, 1024, 1024, 0, 1024, a.hnorm_a + (job - 2) * 1024, (bf16_t*)(ws + WS_WOUTA) + (size_t)(job - 2) * 1024 * 1024, 0, 0};
        else if (job == 4) j = TJ{a.w_in_b, 1024, 2048, 0, 2048, a.norm_b, (bf16_t*)(ws + WS_WINB0), 0, 1536};
        else if (job == 5) j = TJ{a.w_in_b + (size_t)1024 * 2048, 1024, 2048, 0, 2048, a.norm_b + 1024, (bf16_t*)(ws + WS_WINB1), 0, 1536};
        else if (job == 6) j = TJ{a.w_kv, 1024, 1024, 0, 1024, a.norm_kv, (bf16_t*)(ws + WS_WINB0), 2048, 512};
        else if (job < 9)  j = TJ{a.w_out_b + (size_t)(job - 7) * 512 * 1024, 512, 1024, 0, 1024, nullptr, (bf16_t*)(ws + WS_WOUTB) + (size_t)(job - 7) * 1024 * 512, 0, 0};
        else if (job < 13) j = TJ{a.w_ple_gate + (size_t)(job - 9) * 1024 * 1024, 1024, 1024, 0, 1024, a.ple_norm + (job - 9) * 1024, (bf16_t*)(ws + WS_WGATE) + (size_t)(job - 9) * 1024 * 1024, 0, 0};
        else               j = TJ{a.w_ple + (size_t)(job - 13) * 256 * 1024, 256, 1024, 0, 1024, nullptr, (bf16_t*)(ws + WS_WPLE) + (size_t)(job - 13) * 1024 * 256, 0, 0};
        const int nblk = j.ncols / 32, nitems = (j.K / 64) * nblk;
        for (; it < nitems; it += NGW) transpose_item(j.W, j.K, j.ldw, j.ncol0, nblk, j.gain, j.dst, j.row_off, j.nperm, scr, it, lane);
        it -= nitems;
    }
    {
        bf16_t* HB = (bf16_t*)(ws + WS_HB0); float* SSQ = (float*)(ws + WS_SSQ0);
        for (int m0 = gw * 4; m0 < T; m0 += NGW * 4) {
            f32x4 v[4][4];
#pragma unroll
            for (int r = 0; r < 4; ++r) { const f32x4* xr = (const f32x4*)(a.x + (size_t)(m0 + r) * D) + lane;
#pragma unroll
                for (int jj = 0; jj < 4; ++jj) v[r][jj] = xr[64 * jj]; }
#pragma unroll
            for (int r = 0; r < 4; ++r) {
                float sq = 0.f;
#pragma unroll
                for (int jj = 0; jj < 4; ++jj) sq += (v[r][jj].x * v[r][jj].x + v[r][jj].y * v[r][jj].y) + (v[r][jj].z * v[r][jj].z + v[r][jj].w * v[r][jj].w);
#pragma unroll
                for (int o = 1; o < 64; o <<= 1) sq += __shfl_xor(sq, o);
                u32x2* o8 = (u32x2*)(HB + (size_t)(m0 + r) * D) + lane;
#pragma unroll
                for (int jj = 0; jj < 4; ++jj) { u32x2 w; w.x = cvt_pk_bf16(v[r][jj].x, v[r][jj].y); w.y = cvt_pk_bf16(v[r][jj].z, v[r][jj].w); o8[64 * jj] = w; }
                if (lane < 16) SSQ[(size_t)(m0 + r) * 16 + lane] = lane == 0 ? sq : 0.f;
            }
        }
    }
    {
        float* COS = (float*)(ws + WS_COS); float* SIN = (float*)(ws + WS_SIN);
        for (int i = gw * 64 + lane; i < SEQ * 64; i += NGW * 64) {
            const int pos = i >> 6, fi = i & 63;
            const float crev = exp2f(-(float)fi * (13.287712379549449f / 64.0f)) * 0.15915494309189535f;
            float tr = (float)pos * crev; tr -= rintf(tr);
            COS[i] = __builtin_amdgcn_cosf(tr); SIN[i] = __builtin_amdgcn_sinf(tr);
        }
    }
    {
        bf16_t* WG = (bf16_t*)(ws + WS_WG8);
        for (int i = gw * 64 + lane; i < 2 * 16 * 1024; i += NGW * 64) {
            const int l = i >> 14, jj = (i >> 10) & 15, k = i & 1023;
            WG[i] = (jj < 8) ? f2bf(a.w_in_a[(size_t)l * 1024 * A_COLS + (size_t)k * A_COLS + 4096 + jj] * a.norm_a[l * 1024 + k]) : (bf16_t)0;
        }
    }
}

__device__ __forceinline__ void convert_p(const Args& a, int layer, int gtid, int NGT) {
    const f32x4* src = (const f32x4*)(a.p + (size_t)layer * T * PLE);
    u32x4* dst = (u32x4*)(a.ws + WS_PB);
    for (int i = gtid; i < T * PLE / 8; i += NGT) {
        const f32x4 v0 = src[2 * i], v1 = src[2 * i + 1];
        u32x4 w; w.x = cvt_pk_bf16(v0.x, v0.y); w.y = cvt_pk_bf16(v0.z, v0.w); w.z = cvt_pk_bf16(v1.x, v1.y); w.w = cvt_pk_bf16(v1.z, v1.w);
        dst[i] = w;
    }
}

__device__ __forceinline__ void gates_job(const Args& a, int layer, const bf16_t* HB, const float* SSQ, int gw, int NGW, int lane) {
    const bf16_t* WG = (const bf16_t*)(a.ws + WS_WG8) + (size_t)layer * 16 * 1024;
    float* GATES = (float*)(a.ws + WS_GATES);
    const int ql = lane & 15, grp = lane >> 4;
#pragma nounroll
    for (int t0 = gw * 16; t0 < T; t0 += NGW * 16) {
        const bf16_t* arow = HB + (size_t)(t0 + ql) * D + 8 * grp;
        const bf16_t* brow = WG + ql * 1024 + 8 * grp;
        f32x4 acc = (f32x4){0.f, 0.f, 0.f, 0.f};
#pragma unroll 8
        for (int ks = 0; ks < 32; ++ks) acc = __builtin_amdgcn_mfma_f32_16x16x32_bf16(*(const bf16x8*)(arow + 32 * ks), *(const bf16x8*)(brow + 32 * ks), acc, 0, 0, 0);
        if (ql < 8) {
            const float bias = a.b_gate_a[layer * 8 + ql];
#pragma unroll
            for (int ii = 0; ii < 4; ++ii) { const int t = t0 + 4 * grp + ii; GATES[(size_t)t * 8 + ql] = acc[ii] * ssq16_rstd(SSQ, t) + bias; }
        }
    }
}

__device__ __forceinline__ void conv_phase(const Args& a, int layer, int gtid, int NGT, int gw, int NGW, int lane) {
    const bf16_t* QKb = (const bf16_t*)(a.ws + WS_S0); bf16_t* QC = (bf16_t*)(a.ws + WS_HB1);
#pragma nounroll
    for (int task = gtid; task < (T / 16) * 128; task += NGT) {
        const int cgp = task & 127, run = task >> 7, t0 = run * 16, ch0 = cgp * 8;
        float cw[4][8];
#pragma unroll
        for (int jj = 0; jj < 4; ++jj) { const f32x4 c0 = *(const f32x4*)(a.conv_a + (size_t)layer * 4096 + jj * 1024 + ch0), c1 = *(const f32x4*)(a.conv_a + (size_t)layer * 4096 + jj * 1024 + ch0 + 4);
            cw[jj][0] = c0.x; cw[jj][1] = c0.y; cw[jj][2] = c0.z; cw[jj][3] = c0.w; cw[jj][4] = c1.x; cw[jj][5] = c1.y; cw[jj][6] = c1.z; cw[jj][7] = c1.w; }
        const float scl = (ch0 >= 512) ? 0.08838834764831845f : 1.f;
        const bool first = (t0 & (SEQ - 1)) == 0;
        const bf16_t* src = QKb + (size_t)t0 * 1024 + ch0; bf16_t* dst = QC + (size_t)t0 * 1024 + ch0;
        u32x4 r[19];
#pragma unroll
        for (int q = 0; q < 19; ++q) r[q] = (q < 3 && first) ? (u32x4){0u, 0u, 0u, 0u} : *(const u32x4*)(src + (q - 3) * 1024);
#pragma unroll
        for (int q = 0; q < 16; ++q) {
            const unsigned w0[4] = {r[q].x, r[q].y, r[q].z, r[q].w}, w1[4] = {r[q + 1].x, r[q + 1].y, r[q + 1].z, r[q + 1].w}, w2[4] = {r[q + 2].x, r[q + 2].y, r[q + 2].z, r[q + 2].w}, w3[4] = {r[q + 3].x, r[q + 3].y, r[q + 3].z, r[q + 3].w};
            unsigned ow[4];
#pragma unroll
            for (int e = 0; e < 4; ++e) {
                float u0 = cw[0][2 * e] * bf_lo(w0[e]) + cw[1][2 * e] * bf_lo(w1[e]) + cw[2][2 * e] * bf_lo(w2[e]) + cw[3][2 * e] * bf_lo(w3[e]);
                float u1 = cw[0][2 * e + 1] * bf_hi(w0[e]) + cw[1][2 * e + 1] * bf_hi(w1[e]) + cw[2][2 * e + 1] * bf_hi(w2[e]) + cw[3][2 * e + 1] * bf_hi(w3[e]);
                u0 = u0 * sigmoidf_(u0) * scl; u1 = u1 * sigmoidf_(u1) * scl;
                ow[e] = cvt_pk_bf16(u0, u1);
            }
            *(u32x4*)(dst + (size_t)q * 1024) = (u32x4){ow[0], ow[1], ow[2], ow[3]};
        }
    }
    const float* GATES = (const float*)(a.ws + WS_GATES); float* TAB = (float*)(a.ws + WS_LSE);
#pragma nounroll
    for (int task = gw; task < 32 * 64; task += NGW) {
        const int bh = task >> 6, cc = task & 63, b = bh >> 2, h = bh & 3, t = cc * 64 + lane;
        const float gi = GATES[((size_t)b * SEQ + t) * 8 + h], gf = GATES[((size_t)b * SEQ + t) * 8 + 4 + h];
        const float lf = fminf(gf, 0.f) - log1pf(expf(-fabsf(gf)));
        float bc = lf;
#pragma unroll
        for (int o = 1; o < 64; o <<= 1) { const float tt = __shfl_up(bc, o); if (lane >= o) bc += tt; }
        const float av = gi - bc;
        float pm = av;
#pragma unroll
        for (int o = 1; o < 64; o <<= 1) { const float tt = __shfl_up(pm, o); if (lane >= o) pm = fmaxf(pm, tt); }
        float* tb = TAB + (size_t)bh * 3 * SEQ + t;
        tb[0] = av; tb[SEQ] = pm; tb[2 * SEQ] = bc;
    }
}

namespace scan {
constexpr int QS = 0, KS = 18432, VS = 36864, CS = 41984, HS1 = 68096, HS2 = 76544, GA = 84992, TA = 86016, TPM = TA + 16384, TB = TPM + 16384;
constexpr int QSTR = 288, VSTR = 80, CSTR = 272, CBUF = 48 * 272;
constexpr int O_EA = 0, O_D1 = 64, O_D2 = 128, O_FL = 192;
typedef short s16x4 __attribute__((ext_vector_type(4)));

__device__ __forceinline__ void flush_out(LAS unsigned char* lds, bf16_t* OGb, float* SSQH, size_t row, int vcol, int tokv, int c4, int h, int s, u32x4 ograw, u32x4 szraw) {
    const LAS float* hs1 = (const LAS float*)(lds + HS1) + tokv * 33 + 8 * c4; const LAS float* hs2 = (const LAS float*)(lds + HS2) + tokv * 33 + 8 * c4;
    const LAS float* ga = (const LAS float*)(lds + GA);
    const float rden = 1.f / fmaxf(fabsf(ga[O_D1 + tokv] + ga[O_D2 + tokv]), ga[O_FL + tokv]);
    const unsigned ow[4] = {ograw.x, ograw.y, ograw.z, ograw.w}, zw[4] = {szraw.x, szraw.y, szraw.z, szraw.w};
    float sq = 0.f; unsigned outw[4];
#pragma unroll
    for (int e = 0; e < 4; ++e) {
        const float g0 = bf_lo(ow[e]) * ((hs1[2 * e] + hs2[2 * e]) * rden), g1 = bf_hi(ow[e]) * ((hs1[2 * e + 1] + hs2[2 * e + 1]) * rden);
        sq += g0 * g0 + g1 * g1;
        outw[e] = cvt_pk_bf16(g0 * bf_lo(zw[e]), g1 * bf_hi(zw[e]));
    }
    sq += __shfl_xor(sq, 1); sq += __shfl_xor(sq, 2);
    *(u32x4*)(OGb + row * 1024 + vcol) = (u32x4){outw[0], outw[1], outw[2], outw[3]};
    if (c4 == 0) SSQH[row * 32 + h * 8 + s] = sq;
}

template <int VAR>
__device__ __forceinline__ void phase(const Args& a, LAS unsigned char* lds, int layer, int G) {
    int tid = threadIdx.x; asm volatile("" : "+v"(tid));
    unsigned char* ws = a.ws; (void)layer;
    const bf16_t* QCb = (const bf16_t*)(ws + WS_HB1); const bf16_t* Vb = (const bf16_t*)(ws + WS_S1);
    bf16_t* OGb = (bf16_t*)(ws + WS_S2); const bf16_t* SZb = (const bf16_t*)(ws + WS_S3);
    float* SSQH = (float*)(ws + WS_SSQH);
    for (int item = blockIdx.x; item < 256; item += G) {
        const int xx = item & 7, kk = item >> 3, bh = xx * 4 + (kk >> 3), s = kk & 7, b = bh >> 2, h = bh & 3;
        const size_t rowbase = (size_t)b * SEQ;
        {
            unsigned z0 = 0u; asm volatile("" : "+v"(z0));
            for (int i = tid; i < 2 * CBUF / 4; i += NTHR) ((LAS unsigned*)(lds + CS))[i] = z0;
        }
        f32x4 Cacc[3][2];
#pragma unroll
        for (int vt = 0; vt < 3; ++vt) { Cacc[vt][0] = (f32x4){0.f, 0.f, 0.f, 0.f}; Cacc[vt][1] = (f32x4){0.f, 0.f, 0.f, 0.f}; }
        float mprev = 0.f;
        u32x4 qk[4]; u32x4 vraw = (u32x4){0u, 0u, 0u, 0u}, ograw = vraw, szraw = vraw;
        {
#pragma unroll
            for (int i = 0; i < 4; ++i) { const int p = (tid + 512 * i) & 1023, row = p >> 4, c16 = p & 15;
                qk[i] = *(const u32x4*)(QCb + (rowbase + row) * 1024 + (i >= 2 ? 512 : 0) + h * 128 + c16 * 8); }
            if (tid < 256) vraw = *(const u32x4*)(Vb + (rowbase + ((tid >> 2) & 63)) * 1024 + h * 256 + s * 32 + 8 * (tid & 3));
        }
        {
            const u32x4* src = (const u32x4*)((const float*)(ws + WS_LSE) + (size_t)bh * 3 * SEQ);
            u32x4 tv[6];
#pragma unroll
            for (int q = 0; q < 6; ++q) tv[q] = src[tid + 512 * q];
#pragma unroll
            for (int q = 0; q < 6; ++q) *(LAS u32x4*)(lds + TA + (tid + 512 * q) * 16) = tv[q];
        }
        __syncthreads();
#pragma nounroll
        for (int c = 0; c < (VAR == 6 ? 0 : 64); ++c) {
            int tl = tid; asm volatile("" : "+v"(tl));
            const int w = __builtin_amdgcn_readfirstlane(tl >> 6), lane = tl & 63, grp = lane >> 4, ql = lane & 15;
            const int tokv = (tl >> 2) & 63, c4 = tl & 3;
            const int vcol = h * 256 + s * 32 + 8 * c4;
            LAS float* ga = (LAS float*)(lds + GA);
            const int t0 = c * 64, cur = c & 1, nxt = cur ^ 1;
            const LAS float* tA = (const LAS float*)(lds + TA) + c * 64; const LAS float* tPM = (const LAS float*)(lds + TPM) + c * 64; const LAS float* tB = (const LAS float*)(lds + TB) + c * 64;
            const float mcur = mprev;
            const float cmax = tPM[63];
            const float Mlast = fmaxf(mcur, cmax);
            const float decay = __expf(mcur - Mlast), sB = __expf(cmax - Mlast);
            mprev = tB[63] + Mlast;
            if (VAR != 5 && c > 0 && tl < 256) flush_out(lds, OGb, SSQH, rowbase + (t0 - 64) + tokv, vcol, tokv, c4, h, s, ograw, szraw);
            if (VAR != 5) {
                const int p0 = tl, p1 = tl + 512;
                *(LAS u32x4*)(lds + QS + (p0 >> 4) * QSTR + (p0 & 15) * 16) = qk[0];
                *(LAS u32x4*)(lds + QS + (p1 >> 4) * QSTR + (p1 & 15) * 16) = qk[1];
                *(LAS u32x4*)(lds + KS + (p0 >> 4) * QSTR + (p0 & 15) * 16) = qk[2];
                *(LAS u32x4*)(lds + KS + (p1 >> 4) * QSTR + (p1 & 15) * 16) = qk[3];
                if (tl < 256) {
                    const float ea = __expf(tA[tokv] - cmax);
                    u32x4 vs; vs.x = cvt_pk_bf16(bf_lo(vraw.x) * ea, bf_hi(vraw.x) * ea); vs.y = cvt_pk_bf16(bf_lo(vraw.y) * ea, bf_hi(vraw.y) * ea);
                    vs.z = cvt_pk_bf16(bf_lo(vraw.z) * ea, bf_hi(vraw.z) * ea); vs.w = cvt_pk_bf16(bf_lo(vraw.w) * ea, bf_hi(vraw.w) * ea);
                    *(LAS u32x4*)(lds + VS + tokv * VSTR + c4 * 16) = vs;
                }
            }
            LDS_WAIT();
            if (w == 7) ga[O_EA + lane] = __expf(tA[lane] - cmax);
            if (VAR != 1 && VAR != 4 && VAR != 5) { if (tl < 256) { const size_t row = rowbase + t0 + tokv; ograw = *(const u32x4*)(OGb + row * 1024 + vcol); szraw = *(const u32x4*)(SZb + row * 1024 + vcol); } }
            if (VAR == 1 || VAR == 4 || VAR == 5) { asm volatile("" : "+v"(qk[0]), "+v"(qk[1]), "+v"(qk[2]), "+v"(qk[3]), "+v"(vraw), "+v"(ograw), "+v"(szraw)); }
            if (VAR != 1 && VAR != 4 && VAR != 5 && c < 63) {
#pragma unroll
                for (int i = 0; i < 4; ++i) { const int p = (tl + 512 * i) & 1023, row = p >> 4, c16 = p & 15;
                    qk[i] = *(const u32x4*)(QCb + (rowbase + t0 + 64 + row) * 1024 + (i >= 2 ? 512 : 0) + h * 128 + c16 * 8); }
                if (tl < 256) vraw = *(const u32x4*)(Vb + (rowbase + t0 + 64 + tokv) * 1024 + vcol);
            }
            LDS_BARRIER();
            const LAS unsigned char* vbase = lds + VS + (4 * grp + (ql >> 2)) * VSTR + (ql & 3) * 8;
            if (VAR == 2 || VAR == 4 || VAR == 5) { } else if (w < 4) {
                const int ti = w, i = 16 * ti + ql;
                bf16x8 Qf[4];
                {
                    const LAS unsigned char* qb = lds + QS + i * QSTR + grp * 16;
#pragma unroll
                    for (int ks = 0; ks < 4; ++ks) Qf[ks] = *(const LAS bf16x8*)(qb + ks * 64);
                }
                const float Mi = fmaxf(mcur, tPM[i]), eb = __expf(cmax - Mi), flr = __expf(-(tB[i] + Mi));
                f32x4 wt[4];
                const LAS unsigned char* kb = lds + KS + ql * QSTR + grp * 16;
#pragma unroll
                for (int tj = 0; tj < 4; ++tj) {
                    f32x4 sacc = (f32x4){0.f, 0.f, 0.f, 0.f};
                    if (tj <= ti) {
#pragma unroll
                        for (int ks = 0; ks < 4; ++ks) sacc = __builtin_amdgcn_mfma_f32_16x16x32_bf16(*(const LAS bf16x8*)(kb + tj * 16 * QSTR + ks * 64), Qf[ks], sacc, 0, 0, 0);
                    }
                    if (tj == ti) {
#pragma unroll
                        for (int ii = 0; ii < 4; ++ii) sacc[ii] = (4 * grp + ii <= ql) ? sacc[ii] : 0.f;
                    }
                    wt[tj] = sacc;
                }
                f32x4 acc1[3];
#pragma unroll
                for (int vt = 0; vt < 3; ++vt) acc1[vt] = (f32x4){0.f, 0.f, 0.f, 0.f};
#pragma unroll
                for (int p = 0; p < 2; ++p) {
                    u32x4 pw; pw.x = cvt_pk_bf16(wt[2 * p][0], wt[2 * p][1]); pw.y = cvt_pk_bf16(wt[2 * p][2], wt[2 * p][3]); pw.z = cvt_pk_bf16(wt[2 * p + 1][0], wt[2 * p + 1][1]); pw.w = cvt_pk_bf16(wt[2 * p + 1][2], wt[2 * p + 1][3]);
                    const bf16x8 Pf = __builtin_bit_cast(bf16x8, pw);
#pragma unroll
                    for (int vt = 0; vt < 2; ++vt) {
                        const s16x4 lo = __builtin_amdgcn_ds_read_tr16_b64_v4i16((LAS s16x4*)(vbase + (32 * p) * VSTR + vt * 32));
                        const s16x4 hi = __builtin_amdgcn_ds_read_tr16_b64_v4i16((LAS s16x4*)(vbase + (32 * p + 16) * VSTR + vt * 32));
                        acc1[vt] = __builtin_amdgcn_mfma_f32_16x16x32_bf16((bf16x8){lo[0], lo[1], lo[2], lo[3], hi[0], hi[1], hi[2], hi[3]}, Pf, acc1[vt], 0, 0, 0);
                    }
                    const f32x4 e0 = *(const LAS f32x4*)(ga + O_EA + 32 * p + 4 * grp), e1 = *(const LAS f32x4*)(ga + O_EA + 32 * p + 16 + 4 * grp);
                    u32x4 aw; aw.x = cvt_pk_bf16(e0[0], e0[1]); aw.y = cvt_pk_bf16(e0[2], e0[3]); aw.z = cvt_pk_bf16(e1[0], e1[1]); aw.w = cvt_pk_bf16(e1[2], e1[3]);
                    if (ql != 0) aw = (u32x4){0u, 0u, 0u, 0u};
                    acc1[2] = __builtin_amdgcn_mfma_f32_16x16x32_bf16(__builtin_bit_cast(bf16x8, aw), Pf, acc1[2], 0, 0, 0);
                }
                LAS float* hsw = (LAS float*)(lds + HS1) + i * 33 + 4 * grp;
#pragma unroll
                for (int vt = 0; vt < 2; ++vt)
#pragma unroll
                    for (int ii = 0; ii < 4; ++ii) hsw[16 * vt + ii] = acc1[vt][ii] * eb;
                if (grp == 0) { ga[O_D1 + i] = acc1[2][0] * eb; ga[O_FL + i] = flr; }
            } else {
                const int wb = w - 4, i = 16 * wb + ql;
                {
                    bf16x8 Qf[4];
                    const LAS unsigned char* qb = lds + QS + i * QSTR + grp * 16;
#pragma unroll
                    for (int ks = 0; ks < 4; ++ks) Qf[ks] = *(const LAS bf16x8*)(qb + ks * 64);
                    f32x4 acc2[3];
#pragma unroll
                    for (int vt = 0; vt < 3; ++vt) acc2[vt] = (f32x4){0.f, 0.f, 0.f, 0.f};
                    const LAS unsigned char* cb = lds + CS + cur * CBUF + ql * CSTR + grp * 16;
#pragma unroll
                    for (int vt = 0; vt < 3; ++vt)
#pragma unroll
                        for (int ks = 0; ks < 4; ++ks) acc2[vt] = __builtin_amdgcn_mfma_f32_16x16x32_bf16(*(const LAS bf16x8*)(cb + vt * 16 * CSTR + ks * 64), Qf[ks], acc2[vt], 0, 0, 0);
                    const float inter = __expf(mcur - fmaxf(mcur, tPM[i]));
                    LAS float* hsw = (LAS float*)(lds + HS2) + i * 33 + 4 * grp;
#pragma unroll
                    for (int vt = 0; vt < 2; ++vt)
#pragma unroll
                        for (int ii = 0; ii < 4; ++ii) hsw[16 * vt + ii] = acc2[vt][ii] * inter;
                    if (grp == 0) ga[O_D2 + i] = acc2[2][0] * inter;
                }
                f32x4 U[3][2];
#pragma unroll
                for (int vt = 0; vt < 3; ++vt) { U[vt][0] = (f32x4){0.f, 0.f, 0.f, 0.f}; U[vt][1] = (f32x4){0.f, 0.f, 0.f, 0.f}; }
                const LAS unsigned char* kbase = lds + KS + (4 * grp + (ql >> 2)) * QSTR + (ql & 3) * 8 + wb * 64;
#pragma unroll
                for (int p = 0; p < 2; ++p) {
                    bf16x8 Af[3];
#pragma unroll
                    for (int vt = 0; vt < 2; ++vt) {
                        const s16x4 lo = __builtin_amdgcn_ds_read_tr16_b64_v4i16((LAS s16x4*)(vbase + (32 * p) * VSTR + vt * 32));
                        const s16x4 hi = __builtin_amdgcn_ds_read_tr16_b64_v4i16((LAS s16x4*)(vbase + (32 * p + 16) * VSTR + vt * 32));
                        Af[vt] = (bf16x8){lo[0], lo[1], lo[2], lo[3], hi[0], hi[1], hi[2], hi[3]};
                    }
                    { const f32x4 e0 = *(const LAS f32x4*)(ga + O_EA + 32 * p + 4 * grp), e1 = *(const LAS f32x4*)(ga + O_EA + 32 * p + 16 + 4 * grp);
                      u32x4 aw; aw.x = cvt_pk_bf16(e0[0], e0[1]); aw.y = cvt_pk_bf16(e0[2], e0[3]); aw.z = cvt_pk_bf16(e1[0], e1[1]); aw.w = cvt_pk_bf16(e1[2], e1[3]);
                      if (ql != 0) aw = (u32x4){0u, 0u, 0u, 0u};
                      Af[2] = __builtin_bit_cast(bf16x8, aw); }
#pragma unroll
                    for (int dl = 0; dl < 2; ++dl) {
                        const s16x4 lo = __builtin_amdgcn_ds_read_tr16_b64_v4i16((LAS s16x4*)(kbase + (32 * p) * QSTR + dl * 32));
                        const s16x4 hi = __builtin_amdgcn_ds_read_tr16_b64_v4i16((LAS s16x4*)(kbase + (32 * p + 16) * QSTR + dl * 32));
                        const bf16x8 Bk = (bf16x8){lo[0], lo[1], lo[2], lo[3], hi[0], hi[1], hi[2], hi[3]};
#pragma unroll
                        for (int vt = 0; vt < 3; ++vt) U[vt][dl] = __builtin_amdgcn_mfma_f32_16x16x32_bf16(Af[vt], Bk, U[vt][dl], 0, 0, 0);
                    }
                }
#pragma unroll
                for (int vt = 0; vt < 3; ++vt)
#pragma unroll
                    for (int dl = 0; dl < 2; ++dl) Cacc[vt][dl] = Cacc[vt][dl] * decay + U[vt][dl] * sB;
                LAS unsigned char* cw_ = lds + CS + nxt * CBUF + (4 * grp) * CSTR + (32 * wb + ql) * 2;
#pragma unroll
                for (int dl = 0; dl < 2; ++dl) {
#pragma unroll
                    for (int vt = 0; vt < 2; ++vt)
#pragma unroll
                        for (int ii = 0; ii < 4; ++ii) *(LAS bf16_t*)(cw_ + (16 * vt + ii) * CSTR + dl * 32) = f2bf(Cacc[vt][dl][ii]);
                    if (grp == 0) *(LAS bf16_t*)(cw_ + 32 * CSTR + dl * 32) = f2bf(Cacc[2][dl][0]);
                }
            }
            LDS_BARRIER();
        }
        if (tid < 256) flush_out(lds, OGb, SSQH, rowbase + 63 * 64 + ((tid >> 2) & 63), h * 256 + s * 32 + 8 * (tid & 3), (tid >> 2) & 63, tid & 3, h, s, ograw, szraw);
        __syncthreads();
    }
}
}

__device__ __forceinline__ void mlstm_norm_phase(const Args& a, int gtid, int NGT) {
    const u32x4* A = (const u32x4*)(a.ws + WS_S2); u32x4* Y = (u32x4*)(a.ws + WS_S0); const float* SSQH = (const float*)(a.ws + WS_SSQH);
    for (int i = gtid; i < T * 128; i += NGT) {
        const int t = i >> 7, c8 = i & 127, h = c8 >> 5;
        const f32x4 s0 = *(const f32x4*)(SSQH + (size_t)t * 32 + h * 8), s1 = *(const f32x4*)(SSQH + (size_t)t * 32 + h * 8 + 4);
        const float rs = rsqrtf((((s0.x + s0.y) + (s0.z + s0.w)) + ((s1.x + s1.y) + (s1.z + s1.w))) * (1.f / 256.f) + EPS);
        const u32x4 v = A[i]; u32x4 o;
        o.x = cvt_pk_bf16(bf_lo(v.x) * rs, bf_hi(v.x) * rs); o.y = cvt_pk_bf16(bf_lo(v.y) * rs, bf_hi(v.y) * rs);
        o.z = cvt_pk_bf16(bf_lo(v.z) * rs, bf_hi(v.z) * rs); o.w = cvt_pk_bf16(bf_lo(v.w) * rs, bf_hi(v.w) * rs);
        Y[i] = o;
    }
}

namespace attn {
constexpr int KS = 0, VS = 69632;
constexpr int KSTR = 272, VSTR = 288;
typedef short s16x4 __attribute__((ext_vector_type(4)));
struct Item { int b, head, g, res, blk, r; };
__device__ __forceinline__ Item decode(int item) {
    const int xcd = item & 7, q = item >> 3, bhh = xcd + 8 * (q / 96), gi = q % 96;
    Item it; it.b = bhh >> 2; it.head = bhh & 3;
    if (gi < 32) { it.g = 0; it.res = 0; it.blk = gi; it.r = 1; } else if (gi < 64) { it.g = 1; it.res = (gi - 32) >> 3; it.blk = (gi - 32) & 7; it.r = 4; } else { it.g = 2; it.res = (gi - 64) >> 1; it.blk = (gi - 64) & 1; it.r = 16; }
    return it;
}
template <int VAR>
__device__ __forceinline__ void phase(const Args& a, LAS unsigned char* lds, int jl, int G) {
    int tid = threadIdx.x; asm volatile("" : "+v"(tid));
    unsigned char* ws = a.ws; (void)jl;
    const bf16_t* Kb = (const bf16_t*)(ws + WS_S0); const bf16_t* Vb = (const bf16_t*)(ws + WS_S0 + 32 * MiB);
    bf16_t* Qb = (bf16_t*)(ws + WS_S1);
    float* LSE = (float*)(ws + WS_LSE);
    { unsigned z0 = 0u; asm volatile("" : "+v"(z0)); if (tid < 16 * 18) *(LAS u32x4*)(lds + VS + 256 * VSTR + tid * 16) = (u32x4){z0, z0, z0, z0}; }
    u32x4 kreg[8], vreg[8]; bf16x8 qreg[4];
#define ATTN_LOAD(itm) do { const Item it_ = decode(itm); const size_t rb_ = (size_t)it_.b * SEQ; \
        _Pragma("unroll") for (int c_ = 0; c_ < 8; ++c_) { const int p_ = tid + 512 * c_, kj_ = p_ >> 4, u_ = (it_.blk - 1) * 128 + kj_, pos_ = u_ >= 0 ? u_ * it_.r + it_.res : 0; \
            const size_t off_ = (rb_ + pos_) * 512 + it_.head * 128 + (p_ & 15) * 8; kreg[c_] = *(const u32x4*)(Kb + off_); vreg[c_] = *(const u32x4*)(Vb + off_); } \
        const int lane_ = tid & 63, w_ = tid >> 6, posq_ = (128 * it_.blk + 16 * w_ + (lane_ & 15)) * it_.r + it_.res; \
        const bf16_t* qs_ = Qb + (rb_ + posq_) * 1536 + (it_.g * 4 + it_.head) * 128 + 8 * (lane_ >> 4); \
        _Pragma("unroll") for (int ks2_ = 0; ks2_ < 4; ++ks2_) qreg[ks2_] = *(const bf16x8*)(qs_ + 32 * ks2_); } while (0)
    int bx0 = blockIdx.x; asm volatile("" : "+s"(bx0));
    if (bx0 < 3072) ATTN_LOAD(bx0);
    if (VAR == 1) { _Pragma("unroll") for (int c_ = 0; c_ < 8; ++c_) asm volatile("" : "+v"(kreg[c_]), "+v"(vreg[c_])); }
#pragma nounroll
    for (int item = bx0; item < 3072; item += G) {
        int tl = tid; asm volatile("" : "+v"(tl));
        const int w = __builtin_amdgcn_readfirstlane(tl >> 6), lane = tl & 63, grp = lane >> 4, ql = lane & 15;
        const Item it = decode(item);
        const int blk = it.blk;
        const size_t rowbase = (size_t)it.b * SEQ;
#pragma unroll
        for (int c = 0; c < 8; ++c) {
            const int p = tl + 512 * c, kj = p >> 4, ch = p & 15;
            u32x4 kv = kreg[c], vv = vreg[c];
            if (blk == 0 && kj < 128) { kv = (u32x4){0u, 0u, 0u, 0u}; vv = kv; }
            *(LAS u32x4*)(lds + KS + kj * KSTR + ch * 16) = kv; *(LAS u32x4*)(lds + VS + kj * VSTR + ch * 16) = vv;
        }
        bf16x8 Qf[4];
#pragma unroll
        for (int ks = 0; ks < 4; ++ks) Qf[ks] = qreg[ks];
        const int qi = 16 * w + ql;
        const int posq = (128 * blk + qi) * it.r + it.res;
        bf16_t* orow = Qb + (rowbase + posq) * 1536 + (it.g * 4 + it.head) * 128 + 4 * grp;
        LDS_BARRIER();
        float mx = -__builtin_inff(); float den = 0.f;
        f32x4 oacc[8];
#pragma unroll
        for (int dt = 0; dt < 8; ++dt) oacc[dt] = (f32x4){0.f, 0.f, 0.f, 0.f};
        if (VAR != 2) {
        f32x4 sc[9];
        const int dbase = 128 + ql - 4 * grp; const unsigned dmax = (blk > 0) ? 128u : (unsigned)qi;
        const LAS unsigned char* kbase = lds + KS + (16 * w + ql) * KSTR + grp * 16;
        bf16x8 kf[2][4];
#pragma unroll
        for (int ks = 0; ks < 4; ++ks) kf[0][ks] = *(const LAS bf16x8*)(kbase + ks * 64);
#pragma unroll
        for (int tt = 0; tt < 9; ++tt) {
            if (tt < 8) {
#pragma unroll
                for (int ks = 0; ks < 4; ++ks) kf[(tt + 1) & 1][ks] = *(const LAS bf16x8*)(kbase + (tt + 1) * 16 * KSTR + ks * 64);
            }
            f32x4 acc = (f32x4){0.f, 0.f, 0.f, 0.f};
#pragma unroll
            for (int ks = 0; ks < 4; ++ks) acc = __builtin_amdgcn_mfma_f32_16x16x32_bf16(kf[tt & 1][ks], Qf[ks], acc, 0, 0, 0);
#pragma unroll
            for (int ii = 0; ii < 4; ++ii) {
                const int dist = dbase - 16 * tt - ii;
                const float v = ((unsigned)dist <= dmax) ? acc[ii] * 0.08838834764831845f : -__builtin_inff();
                sc[tt][ii] = v; mx = fmaxf(mx, v);
            }
        }
        if (VAR != 1) { if (item + G < 3072) ATTN_LOAD(item + G); }
        mx = fmaxf(mx, __shfl_xor(mx, 16)); mx = fmaxf(mx, __shfl_xor(mx, 32));
#pragma unroll
        for (int tt = 0; tt < 9; ++tt)
#pragma unroll
            for (int ii = 0; ii < 4; ++ii) { const float e = __expf(sc[tt][ii] - mx); sc[tt][ii] = e; den += e; }
        den += __shfl_xor(den, 16); den += __shfl_xor(den, 32);
        const LAS unsigned char* vbase = lds + VS + (16 * w + 4 * grp + (ql >> 2)) * VSTR + (ql & 3) * 8;
#pragma unroll
        for (int pp = 0; pp < 5; ++pp) {
            u32x4 pw;
            pw.x = cvt_pk_bf16(sc[2 * pp][0], sc[2 * pp][1]); pw.y = cvt_pk_bf16(sc[2 * pp][2], sc[2 * pp][3]);
            if (pp < 4) { pw.z = cvt_pk_bf16(sc[2 * pp + 1][0], sc[2 * pp + 1][1]); pw.w = cvt_pk_bf16(sc[2 * pp + 1][2], sc[2 * pp + 1][3]); } else { pw.z = 0u; pw.w = 0u; }
            const bf16x8 Pf = __builtin_bit_cast(bf16x8, pw);
#pragma unroll
            for (int dh = 0; dh < 2; ++dh) {
                s16x4 lo[4], hi[4];
#pragma unroll
                for (int d4 = 0; d4 < 4; ++d4) {
                    lo[d4] = __builtin_amdgcn_ds_read_tr16_b64_v4i16((LAS s16x4*)(vbase + pp * 32 * VSTR + (4 * dh + d4) * 32));
                    hi[d4] = __builtin_amdgcn_ds_read_tr16_b64_v4i16((LAS s16x4*)(vbase + pp * 32 * VSTR + 16 * VSTR + (4 * dh + d4) * 32));
                }
#pragma unroll
                for (int d4 = 0; d4 < 4; ++d4) {
                    const bf16x8 av = (bf16x8){lo[d4][0], lo[d4][1], lo[d4][2], lo[d4][3], hi[d4][0], hi[d4][1], hi[d4][2], hi[d4][3]};
                    oacc[4 * dh + d4] = __builtin_amdgcn_mfma_f32_16x16x32_bf16(av, Pf, oacc[4 * dh + d4], 0, 0, 0);
                }
            }
        }
        } else { den = 1.f; mx = 0.f; if (item + G < 3072) ATTN_LOAD(item + G); }
        const float inv = 1.f / den;
#pragma unroll
        for (int dt = 0; dt < 8; ++dt) { u32x2 o; o.x = cvt_pk_bf16(oacc[dt][0] * inv, oacc[dt][1] * inv); o.y = cvt_pk_bf16(oacc[dt][2] * inv, oacc[dt][3] * inv);
            *(u32x2*)(orow + 16 * dt) = o; }
        if (grp == 0) LSE[((size_t)it.g * T + rowbase + posq) * 4 + it.head] = mx + __logf(den);
        LDS_BARRIER();
    }
#undef ATTN_LOAD
}
}

__device__ __forceinline__ void attn_combine_phase(const Args& a, int gtid, int NGT) {
    const bf16_t* O = (const bf16_t*)(a.ws + WS_S1); const u32x4* SZ = (const u32x4*)(a.ws + WS_S3); u32x4* Y = (u32x4*)(a.ws + WS_S3 + 32 * MiB);
    const float* LSE = (const float*)(a.ws + WS_LSE);
    for (int i = gtid; i < T * 64; i += NGT) {
        const int t = i >> 6, c8 = i & 63, h = c8 >> 4;
        const float l0 = LSE[((size_t)0 * T + t) * 4 + h], l1 = LSE[((size_t)1 * T + t) * 4 + h], l2 = LSE[((size_t)2 * T + t) * 4 + h];
        const float m = fmaxf(l0, fmaxf(l1, l2));
        float w0 = __expf(l0 - m), w1 = __expf(l1 - m), w2 = __expf(l2 - m);
        const float inv = 1.f / (w0 + w1 + w2); w0 *= inv; w1 *= inv; w2 *= inv;
        const u32x4 o0 = *(const u32x4*)(O + (size_t)t * 1536 + c8 * 8), o1 = *(const u32x4*)(O + (size_t)t * 1536 + 512 + c8 * 8), o2 = *(const u32x4*)(O + (size_t)t * 1536 + 1024 + c8 * 8);
        const u32x4 z = SZ[i];
        const unsigned a0[4] = {o0.x, o0.y, o0.z, o0.w}, a1[4] = {o1.x, o1.y, o1.z, o1.w}, a2[4] = {o2.x, o2.y, o2.z, o2.w}, zz[4] = {z.x, z.y, z.z, z.w};
        unsigned ow[4];
#pragma unroll
        for (int e = 0; e < 4; ++e) {
            const float lo = (w0 * bf_lo(a0[e]) + w1 * bf_lo(a1[e]) + w2 * bf_lo(a2[e])) * bf_lo(zz[e]);
            const float hi = (w0 * bf_hi(a0[e]) + w1 * bf_hi(a1[e]) + w2 * bf_hi(a2[e])) * bf_hi(zz[e]);
            ow[e] = cvt_pk_bf16(lo, hi);
        }
        Y[i] = (u32x4){ow[0], ow[1], ow[2], ow[3]};
    }
}

typedef const __attribute__((address_space(4))) Args* KArgs;
#define LOADARGS(name) Args name; { KArgs _k = kp; asm volatile("" : "+s"(_k)); name = *_k; }

__global__ void __launch_bounds__(NTHR, 2) fwd_megakernel(Args args_unused) {
#if defined(__HIP_DEVICE_COMPILE__)
    extern __shared__ __attribute__((aligned(16))) unsigned char lds_raw[];
    LAS unsigned char* lds = (LAS unsigned char*)lds_raw;
    KArgs kp = (KArgs)__builtin_amdgcn_kernarg_segment_ptr();
    const int G = gridDim.x, bx = blockIdx.x;
    {
        const int tid = threadIdx.x;
        volatile LAS unsigned* MISC0 = (volatile LAS unsigned*)(lds + MISC_OFF);
        if (tid < 64) MISC0[tid] = 0u;
        __syncthreads();
    }
    { LOADARGS(a); (void)xcd_barrier_post((unsigned*)(a.ws + WS_CTL) + CW_BAR, (volatile LAS unsigned*)(lds + MISC_OFF) + 8); }
#define GRID_BAR() do { LOADARGS(a_); XcdBarrier b_; b_.bar = (unsigned*)(a_.ws + WS_CTL) + CW_BAR; b_.x = xb_xcc_id(); b_.st = (volatile LAS unsigned*)(lds + MISC_OFF) + 8; xcd_barrier(b_); } while (0)
#define THREAD_IDS() int tid = threadIdx.x; asm volatile("" : "+v"(tid)); const int lane = tid & 63, wave = __builtin_amdgcn_readfirstlane(tid >> 6); \
    const int vcu = (G % 8 == 0) ? (bx % 8) * (G / 8) + bx / 8 : bx; const int gw = vcu * NWAVES + wave, NGW = G * NWAVES, gtid = vcu * NTHR + tid, NGT = G * NTHR; (void)lane; (void)gw; (void)NGW; (void)gtid; (void)NGT;

#define PH_PROLOGUE() { LOADARGS(a); THREAD_IDS(); prologue(a, lds, gw, NGW, lane, wave); }
#define PH_P1A(layer) { \
            { LOADARGS(a); unsigned char* ws = a.ws; \
              pg8::Gemm g{(const bf16_t*)(ws + WS_HB0), (const bf16_t*)(ws + WS_WINA) + (size_t)(layer) * 4096 * 1024, T, 4096, 1024}; \
              pg8::StaticOrder S; S.init(T, 4096, G, bx); \
              pg8::EpiP E{0, (const float*)(ws + WS_SSQ0), ws, nullptr, nullptr, lds}; \
              pg8::gemm_phase<pg8::EpiP, pg8::StaticOrder, true, true>(lds + RING_OFF, g, S, E); } \
            { LOADARGS(a); THREAD_IDS(); gates_job(a, (layer), (const bf16_t*)(a.ws + WS_HB0), (const float*)(a.ws + WS_SSQ0), gw, NGW, lane); } \
            { LOADARGS(a); THREAD_IDS(); convert_p(a, (layer), gtid, NGT); } }
#define PH_CONV(layer) { LOADARGS(a); THREAD_IDS(); conv_phase(a, (layer), gtid, NGT, gw, NGW, lane); }
#if defined(PROBE_VARIANT) && PROBE_KIND == 2
#define PH_SCAN(layer) { LOADARGS(a); if (pass == 0 && r_ > 0) scan::phase<PROBE_VARIANT>(a, lds, (layer), G); else scan::phase<0>(a, lds, (layer), G); }
#else
#define PH_SCAN(layer) { LOADARGS(a); scan::phase<0>(a, lds, (layer), G); }
#endif
#define PH_NORM() { LOADARGS(a); THREAD_IDS(); mlstm_norm_phase(a, gtid, NGT); }
#define PH_P3A(layer) { \
              LOADARGS(a); unsigned char* ws = a.ws; \
              pg8::Gemm g{(const bf16_t*)(ws + WS_S2), (const bf16_t*)(ws + WS_WOUTA) + (size_t)(layer) * 1024 * 1024, T, 1024, 1024}; \
              pg8::StaticOrder S; S.init(T, 1024, G, bx); \
              LAS float* RT_ = (LAS float*)(lds + 131072); \
              { THREAD_IDS(); int bxl_ = bx; asm volatile("" : "+s"(bxl_)); pg8::StaticOrder S2_; S2_.init(T, 1024, G, bxl_); pg8::Unit u0_, u1_; const bool v0_ = S2_.next(0, u0_), v1_ = S2_.next(1, u1_); const int pm_ = (tid >> 8) ? u1_.pm : u0_.pm; if ((tid >> 8) ? v1_ : v0_) { const float* sp_ = (const float*)(ws + WS_SSQH) + (size_t)(pm_ * 256 + (tid & 255)) * 32; float r_[4]; \
                  _Pragma("unroll") for (int h_ = 0; h_ < 4; ++h_) { const f32x4 s0_ = *(const f32x4*)(sp_ + 8 * h_), s1_ = *(const f32x4*)(sp_ + 8 * h_ + 4); r_[h_] = rsqrtf((((s0_.x + s0_.y) + (s0_.z + s0_.w)) + ((s1_.x + s1_.y) + (s1_.z + s1_.w))) * (1.f / 256.f) + EPS); } \
                  *(LAS f32x4*)(RT_ + (size_t)tid * 4) = (f32x4){r_[0] / r_[1], r_[1] / r_[2], r_[2] / r_[3], r_[3]}; } \
                __syncthreads(); } \
              pg8::EpiF E{0, (const bf16_t*)(ws + WS_HB0), (bf16_t*)(ws + WS_HB1), (float*)(ws + WS_SSQ1), nullptr, nullptr, nullptr}; \
              pg8::gemm_phase<pg8::EpiF, pg8::StaticOrder, true, true, true>(lds + RING_OFF, g, S, E, RT_); }
#define PH_P1B(jl, layer) { \
            { LOADARGS(a); unsigned char* ws = a.ws; \
              const int N = ((jl) == 0) ? 3072 : 2048; \
              pg8::Gemm g{(const bf16_t*)(ws + WS_HB0), (const bf16_t*)(ws + ((jl) == 0 ? WS_WINB0 : WS_WINB1)), T, N, 1024}; \
              pg8::StaticOrder S; S.init(T, N, G, bx); \
              pg8::EpiP E{1, (const float*)(ws + WS_SSQ0), ws, a.qnorm_b + (jl) * 128, a.knorm, lds}; \
              pg8::gemm_phase<pg8::EpiP, pg8::StaticOrder, true, true>(lds + RING_OFF, g, S, E); } \
            { LOADARGS(a); THREAD_IDS(); convert_p(a, (layer), gtid, NGT); } }
#if defined(PROBE_VARIANT) && PROBE_KIND == 3
#define PH_ATTN(jl) { LOADARGS(a); if (pass == 0 && r_ > 0) attn::phase<PROBE_VARIANT>(a, lds, (jl), G); else attn::phase<0>(a, lds, (jl), G); }
#else
#define PH_ATTN(jl) { LOADARGS(a); attn::phase<0>(a, lds, (jl), G); }
#endif
#define PH_COMBINE() { LOADARGS(a); THREAD_IDS(); attn_combine_phase(a, gtid, NGT); }
#define PH_P3B(jl) { \
              LOADARGS(a); unsigned char* ws = a.ws; \
              pg8::Gemm g{(const bf16_t*)(ws + WS_S3 + 32 * MiB), (const bf16_t*)(ws + WS_WOUTB) + (size_t)(jl) * 1024 * 512, T, 1024, 512}; \
              pg8::StaticOrder S; S.init(T, 1024, G, bx); \
              pg8::EpiF E{0, (const bf16_t*)(ws + WS_HB0), (bf16_t*)(ws + WS_HB1), (float*)(ws + WS_SSQ1), nullptr, nullptr, nullptr}; \
              pg8::gemm_phase<pg8::EpiF, pg8::StaticOrder, true, true>(lds + RING_OFF, g, S, E); }
#define PH_PP(layer) { \
            LOADARGS(a); unsigned char* ws = a.ws; \
            pg8::Gemm g2{(const bf16_t*)(ws + WS_PB), (const bf16_t*)(ws + WS_WPLE) + (size_t)(layer) * 1024 * 256, T, 1024, 256}; \
            pg8::StaticOrder S; S.init(T, 1024, G, bx); \
            pg8::EpiP E2{2, nullptr, ws, nullptr, nullptr, lds}; \
            pg8::gemm_phase<pg8::EpiP, pg8::StaticOrder, true, true>(lds + RING_OFF, g2, S, E2); }
#define PH_P4(layer) { \
            LOADARGS(a); unsigned char* ws = a.ws; \
            pg8::Gemm g{(const bf16_t*)(ws + WS_HB1), (const bf16_t*)(ws + WS_WGATE) + (size_t)(layer) * 1024 * 1024, T, 1024, 1024}; \
            pg8::StaticOrder S; S.init(T, 1024, G, bx); \
            pg8::EpiF E{1, (const bf16_t*)(ws + WS_HB1), (bf16_t*)(ws + WS_HB0), (float*)(ws + WS_SSQ0), (const float*)(ws + WS_SSQ1), (const bf16_t*)(ws + WS_S1), ((layer) == DEPTH - 1) ? a.out : nullptr}; \
            pg8::gemm_phase<pg8::EpiF, pg8::StaticOrder, true, true>(lds + RING_OFF, g, S, E); }

#if defined(PROBE_KIND)
#define REP(kind) _Pragma("nounroll") for (int r_ = 0; r_ < ((PROBE_KIND == (kind) && pass == 0) ? PROBE_REPS : 1); ++r_)
#define LASTBAR() GRID_BAR()
#pragma nounroll
    for (int pass = 0; pass < 2; ++pass) {
#else
#define REP(kind)
#define LASTBAR() if (layer < DEPTH - 1) GRID_BAR()
    {
#endif
    REP(1) { PH_PROLOGUE(); GRID_BAR(); }
#define LAYER_A(layer) { \
        REP(4) { PH_P1A(layer); GRID_BAR(); } \
        REP(12) { PH_CONV(layer); GRID_BAR(); } \
        REP(2) { PH_SCAN(layer); GRID_BAR(); } \
        REP(9) { PH_P3A(layer); } \
        REP(8) { PH_PP(layer); } \
        GRID_BAR(); \
        REP(5) { PH_P4(layer); GRID_BAR(); } }
#define LAYER_B(jl, layer, last) { \
        REP(11) { PH_P1B(jl, layer); GRID_BAR(); } \
        REP(3) { PH_ATTN(jl); GRID_BAR(); } \
        REP(7) { PH_COMBINE(); GRID_BAR(); } \
        REP(10) { PH_P3B(jl); } \
        REP(8) { PH_PP(layer); } \
        GRID_BAR(); \
        REP(5) { PH_P4(layer); if (!(last)) GRID_BAR(); } }
    LAYER_A(0);
    LAYER_A(1);
    LAYER_B(0, 2, false);
#if defined(PROBE_KIND)
    LAYER_B(1, 3, false);
#else
    LAYER_B(1, 3, true);
#endif
    }
#endif
}

extern "C" void kernel_launch(void* const* d_in, const int* in_sizes, int n_in, void* d_out, int out_size, void* d_ws, size_t ws_size, hipStream_t stream) {
    static int grid = 0;
    if (grid == 0) {
        if (n_in != 18 || in_sizes[0] != T * D || out_size != T * D || ws_size < WS_END) { fprintf(stderr, "kernel_launch: unexpected shapes (n_in %d, in0 %d, out %d, ws %zu)\n", n_in, n_in > 0 ? in_sizes[0] : -1, out_size, ws_size); grid = -1; return; }
        int dev = 0, cus = 0, per_cu = 0;
        if (hipGetDevice(&dev) != hipSuccess || hipDeviceGetAttribute(&cus, hipDeviceAttributeMultiprocessorCount, dev) != hipSuccess) { fprintf(stderr, "kernel_launch: device query failed\n"); grid = -1; return; }
        if (hipFuncSetAttribute((const void*)fwd_megakernel, hipFuncAttributeMaxDynamicSharedMemorySize, LDS_BYTES) != hipSuccess) { fprintf(stderr, "kernel_launch: hipFuncSetAttribute failed\n"); grid = -1; return; }
        if (hipOccupancyMaxActiveBlocksPerMultiprocessor(&per_cu, (const void*)fwd_megakernel, NTHR, LDS_BYTES) != hipSuccess || per_cu < 1)
            fprintf(stderr, "kernel_launch: note: occupancy query reports %d workgroups per CU\n", per_cu);
        (void)hipGetLastError();
        grid = cus;
        if (grid > 256) grid = 256;
    }
    if (grid < 0) return;
    if (hipMemsetAsync((char*)d_ws + WS_CTL, 0, CTL_ZERO_BYTES, stream) != hipSuccess) { fprintf(stderr, "kernel_launch: memset failed\n"); return; }
    Args a{};
    a.x = (const float*)d_in[0]; a.p = (const float*)d_in[1]; a.norm_a = (const float*)d_in[2]; a.w_in_a = (const float*)d_in[3]; a.conv_a = (const float*)d_in[4];
    a.b_gate_a = (const float*)d_in[5]; a.hnorm_a = (const float*)d_in[6]; a.w_out_a = (const float*)d_in[7]; a.norm_kv = (const float*)d_in[8]; a.w_kv = (const float*)d_in[9];
    a.knorm = (const float*)d_in[10]; a.norm_b = (const float*)d_in[11]; a.w_in_b = (const float*)d_in[12]; a.qnorm_b = (const float*)d_in[13]; a.w_out_b = (const float*)d_in[14];
    a.ple_norm = (const float*)d_in[15]; a.w_ple_gate = (const float*)d_in[16]; a.w_ple = (const float*)d_in[17];
    a.out = (float*)d_out; a.ws = (unsigned char*)d_ws;
    hipLaunchKernelGGL(fwd_megakernel, dim3(grid), dim3(NTHR), LDS_BYTES, stream, a);
    const hipError_t le = hipPeekAtLastError();
    if (le != hipSuccess) fprintf(stderr, "kernel_launch: launch failed: %s\n", hipGetErrorName(le));
}
```

```cpp
#include <hip/hip_runtime.h>
#include <cstdio>
#include <cstdint>

#define LAS __attribute__((address_space(3)))
#define GAS __attribute__((address_space(1)))
typedef unsigned short bf16_t;
typedef short bf16x8 __attribute__((ext_vector_type(8)));
typedef float f32x4 __attribute__((ext_vector_type(4)));
typedef unsigned u32x4 __attribute__((ext_vector_type(4)));
typedef unsigned u32x2 __attribute__((ext_vector_type(2)));

constexpr int BATCH = 8, SEQ = 4096, T = BATCH * SEQ, D = 1024, DEPTH = 4, PLE = 256;
constexpr int A_COLS = 4104;
constexpr float EPS = 1e-6f;

typedef __bf16 bf16x2_t __attribute__((ext_vector_type(2)));
typedef float f32x2_t __attribute__((ext_vector_type(2)));
__device__ __forceinline__ unsigned cvt_pk_bf16(float lo, float hi) { const f32x2_t v = {lo, hi}; return __builtin_bit_cast(unsigned, __builtin_convertvector(v, bf16x2_t)); }
__device__ __forceinline__ float bf_lo(unsigned w) { return __uint_as_float(w << 16); }
__device__ __forceinline__ float bf_hi(unsigned w) { return __uint_as_float(w & 0xffff0000u); }
__device__ __forceinline__ float bf2f(bf16_t b) { return __uint_as_float(((unsigned)b) << 16); }
__device__ __forceinline__ bf16_t f2bf(float f) { return (bf16_t)(cvt_pk_bf16(f, 0.f) & 0xffffu); }
__device__ __forceinline__ float sigmoidf_(float x) { return 1.f / (1.f + __expf(-x)); }
__device__ __forceinline__ float ssq16_rstd(const float* ssq, int row) {
    const f32x4* p = (const f32x4*)(ssq + (size_t)row * 16);
    const f32x4 a = p[0], b = p[1], c = p[2], d = p[3];
    const float s = ((a.x + a.y) + (a.z + a.w)) + ((b.x + b.y) + (b.z + b.w)) + ((c.x + c.y) + (c.z + c.w)) + ((d.x + d.y) + (d.z + d.w));
    return rsqrtf(s * (1.f / 1024.f) + EPS);
}

constexpr int RS_OFF = 139264;

constexpr size_t WS_S0_ = (size_t)208 << 20, WS_S1_ = (size_t)272 << 20, WS_S2_ = (size_t)336 << 20, WS_S3_ = (size_t)400 << 20;
namespace pg8 {
#define PG8_LAS __attribute__((address_space(3)))
constexpr int BM = 256, BK = 64, HALF = 128, HTB = HALF * BK * 2, STAGE_BYTES = 8 * HTB, NXCD = 8, WGM = 8;
__host__ __device__ __forceinline__ int lds_byte(int r, int c) { const int st = (r >> 4) * 2 + (c >> 5), rr = r & 15, cc = c & 31, ob = rr * 64 + cc * 2; return st * 1024 + (ob ^ (((ob >> 9) & 1) << 5)); }
__host__ __device__ __forceinline__ void stage_rc(int b, int& R, int& C) { const int st = b / 1024, sb = b % 1024, swz = sb ^ (((sb >> 9) & 1) << 5); R = (st >> 1) * 16 + swz / 64; C = (st & 1) * 32 + (swz % 64) / 2; }
__host__ __device__ __forceinline__ int perm32(int rho) { const int n = rho >> 4, i = rho & 15; return 8 * (i >> 2) + 4 * n + (i & 3); }

struct Unit { int pm, pn, idx; };
struct Gemm { const bf16_t* A; const bf16_t* Bt; int M, N, K; };
struct StaticOrder {
    int nM, nN, nwg, G, c;
    __host__ __device__ void init(int M, int N, int G_, int c_) { nM = M / BM; nN = N / BM; nwg = nM * nN; G = G_; c = c_; }
    __host__ __device__ __forceinline__ bool next(int i, Unit& u) const {
        const long L = (long)i * G + c; if (L >= nwg) return false;
        int wgid = (int)L; { const int q = nwg / NXCD, r = nwg % NXCD, xcd = wgid % NXCD, off = wgid / NXCD; wgid = (xcd < r ? xcd * (q + 1) : r * (q + 1) + (xcd - r) * q) + off; }
        const int nig = WGM * nN, gid = wgid / nig, fm = gid * WGM, gsz = (nM - fm) < WGM ? (nM - fm) : WGM;
        u.pm = fm + ((wgid % nig) % gsz); u.pn = (wgid % nig) / gsz; return true;
    }
    __device__ __forceinline__ void a_ready(const Unit&) const {}
    __device__ __forceinline__ void done(const Unit&) const {}
};


struct EpiP {
    static constexpr bool PERM = true, AFTER_DRAIN = false;
    int mode; const float* ssq; unsigned char* ws; const float* qg; const float* kg; PG8_LAS unsigned char* lds;
    __device__ __forceinline__ void operator()(const f32x4 (&acc)[2][2][4][2], const Unit& u, int wr, int wc, int fr, int fq) const {
        const int row0 = u.pm * BM + wr * 64 + fr;
        size_t boff; int ldc, colt, act = 0;
        if (mode == 0) { const int ten = u.pn >> 2; boff = WS_S0_ + (size_t)ten * (64u << 20); ldc = 1024; colt = (u.pn & 3) * 256; act = ten == 2 ? 1 : ten == 3 ? 2 : 0; }
        else if (mode == 1) {
            if (u.pn < 6) { boff = WS_S1_; ldc = 1536; colt = u.pn * 256; act = 3; }
            else if (u.pn < 8) { boff = WS_S3_; ldc = 512; colt = (u.pn - 6) * 256; act = 2; }
            else if (u.pn < 10) { boff = WS_S0_; ldc = 512; colt = (u.pn - 8) * 256; act = 3; }
            else { boff = WS_S0_ + (32u << 20); ldc = 512; colt = (u.pn - 10) * 256; }
        } else { boff = WS_S1_; ldc = 1024; colt = u.pn * 256; }
        bf16_t* base = (bf16_t*)(ws + boff);
        if (act == 3) {
            PG8_LAS float* X = (PG8_LAS float*)(lds + 131072);
            const float* gn = (u.pn < 6) ? qg : kg;
            const float* COS = (const float*)(ws + ((size_t)2 << 20)); const float* SIN = (const float*)(ws + ((size_t)3 << 20));
#pragma unroll
            for (int ai = 0; ai < 2; ++ai)
#pragma unroll
                for (int m = 0; m < 4; ++m) {
                    const int rl = ai * HALF + wr * 64 + m * 16 + fr;
                    const float rs = ((const PG8_LAS float*)(lds + RS_OFF))[(u.idx & 7) * 256 + rl];
#pragma unroll
                    for (int bj = 0; bj < 2; ++bj) {
                        const f32x4 v0 = acc[ai][bj][m][0] * rs, v1 = acc[ai][bj][m][1] * rs;
                        float sq = (v0[0] * v0[0] + v0[1] * v0[1]) + (v0[2] * v0[2] + v0[3] * v0[3]) + (v1[0] * v1[0] + v1[1] * v1[1]) + (v1[2] * v1[2] + v1[3] * v1[3]);
                        sq += __shfl_xor(sq, 16); sq += __shfl_xor(sq, 32);
                        if (fq == 0) X[(rl * 2 + bj) * 4 + wc] = sq;
                    }
                }
            asm volatile("s_waitcnt lgkmcnt(0)" ::: "memory"); __builtin_amdgcn_s_barrier(); asm volatile("" ::: "memory");
            const int d0 = 16 * wc + 4 * fq;
            const f32x4 g1 = *(const f32x4*)(gn + d0), g2 = *(const f32x4*)(gn + 64 + d0);
            f32x4 csb[2], snb[2];
            { const int pos0 = (u.pm * BM + wr * 64 + fr) & (SEQ - 1); csb[0] = *(const f32x4*)(COS + pos0 * 64 + d0); snb[0] = *(const f32x4*)(SIN + pos0 * 64 + d0); }
#pragma unroll
            for (int g = 0; g < 8; ++g) {
                const int ai = g >> 2, m = g & 3, cb = g & 1, nb = cb ^ 1;
                const int rl = ai * HALF + wr * 64 + m * 16 + fr, row = u.pm * BM + rl;
                if (g < 7) { const int g1i = g + 1, pos1 = (u.pm * BM + (g1i >> 2) * HALF + wr * 64 + (g1i & 3) * 16 + fr) & (SEQ - 1); csb[nb] = *(const f32x4*)(COS + pos1 * 64 + d0); snb[nb] = *(const f32x4*)(SIN + pos1 * 64 + d0); }
                const float rs = ((const PG8_LAS float*)(lds + RS_OFF))[(u.idx & 7) * 256 + rl];
                const f32x4 cs = csb[cb], sn = snb[cb];
#pragma unroll
                for (int bj = 0; bj < 2; ++bj) {
                    const f32x4 xs = *(const PG8_LAS f32x4*)(X + (rl * 2 + bj) * 4);
                    const float rh = rs * rsqrtf(((xs[0] + xs[1]) + (xs[2] + xs[3])) * (1.f / 128.f) + EPS);
                    const f32x4 x1 = acc[ai][bj][m][0] * rh * g1, x2 = acc[ai][bj][m][1] * rh * g2;
                    const f32x4 o1 = x1 * cs - x2 * sn, o2 = x2 * cs + x1 * sn;
                    bf16_t* p = base + (size_t)row * ldc + colt + bj * HALF + d0;
                    u32x2 w1, w2; w1.x = cvt_pk_bf16(o1[0], o1[1]); w1.y = cvt_pk_bf16(o1[2], o1[3]); w2.x = cvt_pk_bf16(o2[0], o2[1]); w2.y = cvt_pk_bf16(o2[2], o2[3]);
                    *(u32x2*)p = w1; *(u32x2*)(p + 64) = w2;
                }
            }
            return;
        }
        const int col0 = colt + wc * 32 + 8 * fq;
#pragma unroll
        for (int ai = 0; ai < 2; ++ai)
#pragma unroll
            for (int m = 0; m < 4; ++m) {
                const int row = row0 + ai * HALF + m * 16;
                const float rs = (mode == 2) ? 1.f : ((const PG8_LAS float*)(lds + RS_OFF))[(u.idx & 7) * 256 + ai * HALF + wr * 64 + m * 16 + fr];
                bf16_t* rowp = base + (size_t)row * ldc + col0;
#pragma unroll
                for (int bj = 0; bj < 2; ++bj) {
                    f32x4 v0 = acc[ai][bj][m][0] * rs, v1 = acc[ai][bj][m][1] * rs;
                    if (act == 1) {
#pragma unroll
                        for (int j = 0; j < 4; ++j) { v0[j] = sigmoidf_(v0[j]); v1[j] = sigmoidf_(v1[j]); }
                    } else if (act == 2) {
#pragma unroll
                        for (int j = 0; j < 4; ++j) { v0[j] = v0[j] * sigmoidf_(v0[j]); v1[j] = v1[j] * sigmoidf_(v1[j]); }
                    }
                    u32x4 w; w.x = cvt_pk_bf16(v0[0], v0[1]); w.y = cvt_pk_bf16(v0[2], v0[3]); w.z = cvt_pk_bf16(v1[0], v1[1]); w.w = cvt_pk_bf16(v1[2], v1[3]);
                    *(u32x4*)(rowp + bj * HALF) = w;
                }
                asm volatile("" ::: "memory");
            }
    }
};
struct EpiF {
    static constexpr bool PERM = true, AFTER_DRAIN = false;
    int mode; const bf16_t* hres; bf16_t* hb; float* ssq_out; const float* ssq_in; const bf16_t* pp; float* fout; PG8_LAS unsigned char* lds;
    __device__ __forceinline__ void operator()(const f32x4 (&acc)[2][2][4][2], const Unit& u, int wr, int wc, int fr, int fq) const {
        const int row0 = u.pm * BM + wr * 64 + fr, col0 = u.pn * BM + wc * 32 + 8 * fq;
        const PG8_LAS float* rst = (const PG8_LAS float*)(lds + RS_OFF) + (u.idx & 7) * 256 + wr * 64 + fr;
        u32x4 hw[2][2], pw[2][2];
        { const size_t o = (size_t)row0 * 1024 + col0; hw[0][0] = *(const u32x4*)(hres + o); hw[0][1] = *(const u32x4*)(hres + o + HALF);
          if (mode == 1) { pw[0][0] = *(const u32x4*)(pp + o); pw[0][1] = *(const u32x4*)(pp + o + HALF); } }
#pragma unroll
        for (int g = 0; g < 8; ++g) {
            const int ai = g >> 2, m = g & 3, cb = g & 1, nb = cb ^ 1;
            const int row = row0 + ai * HALF + m * 16;
            const size_t off = (size_t)row * 1024 + col0;
            if (g < 7) { const int g1 = g + 1; const size_t o = (size_t)(row0 + (g1 >> 2) * HALF + (g1 & 3) * 16) * 1024 + col0;
                hw[nb][0] = *(const u32x4*)(hres + o); hw[nb][1] = *(const u32x4*)(hres + o + HALF);
                if (mode == 1) { pw[nb][0] = *(const u32x4*)(pp + o); pw[nb][1] = *(const u32x4*)(pp + o + HALF); } }
            float rs = 1.f; if (mode == 1) rs = rst[ai * HALF + m * 16];
            float sq = 0.f;
#pragma unroll
            for (int bj = 0; bj < 2; ++bj) {
                const size_t o = off + bj * HALF;
                const u32x4 h_ = hw[cb][bj];
                f32x4 v0 = acc[ai][bj][m][0], v1 = acc[ai][bj][m][1];
                if (mode == 1) {
                    const u32x4 p_ = pw[cb][bj];
                    v0[0] = bf_lo(p_.x) * sigmoidf_(v0[0] * rs); v0[1] = bf_hi(p_.x) * sigmoidf_(v0[1] * rs); v0[2] = bf_lo(p_.y) * sigmoidf_(v0[2] * rs); v0[3] = bf_hi(p_.y) * sigmoidf_(v0[3] * rs);
                    v1[0] = bf_lo(p_.z) * sigmoidf_(v1[0] * rs); v1[1] = bf_hi(p_.z) * sigmoidf_(v1[1] * rs); v1[2] = bf_lo(p_.w) * sigmoidf_(v1[2] * rs); v1[3] = bf_hi(p_.w) * sigmoidf_(v1[3] * rs);
                }
                f32x4 h0, h1;
                h0[0] = bf_lo(h_.x) + v0[0]; h0[1] = bf_hi(h_.x) + v0[1]; h0[2] = bf_lo(h_.y) + v0[2]; h0[3] = bf_hi(h_.y) + v0[3];
                h1[0] = bf_lo(h_.z) + v1[0]; h1[1] = bf_hi(h_.z) + v1[1]; h1[2] = bf_lo(h_.w) + v1[2]; h1[3] = bf_hi(h_.w) + v1[3];
                if (fout) { *(f32x4*)(fout + o) = h0; *(f32x4*)(fout + o + 4) = h1; }
                else { u32x4 w; w.x = cvt_pk_bf16(h0[0], h0[1]); w.y = cvt_pk_bf16(h0[2], h0[3]); w.z = cvt_pk_bf16(h1[0], h1[1]); w.w = cvt_pk_bf16(h1[2], h1[3]); *(u32x4*)(hb + o) = w; }
                sq += ((h0[0] * h0[0] + h0[1] * h0[1]) + (h0[2] * h0[2] + h0[3] * h0[3])) + ((h1[0] * h1[0] + h1[1] * h1[1]) + (h1[2] * h1[2] + h1[3] * h1[3]));
            }
            sq += __shfl_xor(sq, 16); sq += __shfl_xor(sq, 32);
            if (fq == 0 && !fout) ssq_out[(size_t)row * 16 + u.pn * 4 + wc] = sq;
        }
    }
};

template <class Epi, class Sched, bool ALIGN_EPI = false, bool SP2 = false, bool HS = false>
__device__ __forceinline__ void gemm_phase(PG8_LAS unsigned char* lds, const Gemm g, const Sched& S, const Epi& E, const PG8_LAS float* rt = nullptr) {
    int tid = threadIdx.x; asm volatile("" : "+v"(tid));
    const int wid = __builtin_amdgcn_readfirstlane(tid >> 6), lane = tid & 63, wr = wid >> 2, wc = wid & 3, fr = lane & 15, fq = lane >> 4;
    const int K = g.K, nt = HS ? 4 : K / BK;
    unsigned voffA[2], voffB[2];
#pragma unroll
    for (int i = 0; i < 2; ++i) { int R, C; stage_rc(tid * 16 + i * 8192, R, C); const int Rb = Epi::PERM ? ((R & ~31) + perm32(R & 31)) : R;
        voffA[i] = (unsigned)(R * K + C) * 2u; voffB[i] = (unsigned)(Rb * K + C) * 2u; }
    const size_t kstep = (size_t)(BK * 2);
    const size_t hstep = (size_t)HALF * K * 2;
    const size_t tstep = 2 * hstep;
    const unsigned ldsw = (unsigned)wid * 1024u;
    const int aoff = lds_byte(wr * 64 + fr, fq * 8), boff = lds_byte(wc * 32 + fr, fq * 8);
#define PG8_SA(b, h) (((b) * 2 + (h)) * HTB)
#define PG8_SB(b, h) ((4 + (b) * 2 + (h)) * HTB)
#define PG8_STAGE(bufoff, gbase, voff) do { _Pragma("unroll") for (int _i = 0; _i < 2; ++_i) \
        __builtin_amdgcn_global_load_lds((const unsigned*)((const char*)(gbase) + (voff)[_i]), (PG8_LAS unsigned*)(lds + (bufoff) + ldsw + _i * 8192), 16, 0, 0); } while (0)
#define PG8_LDA(dst, b, h) do { _Pragma("unroll") for (int m = 0; m < 4; ++m) _Pragma("unroll") for (int k = 0; k < 2; ++k) dst[m][k] = *(const PG8_LAS bf16x8*)(lds + PG8_SA(b, h) + aoff + m * 2048 + k * 1024); } while (0)
#define PG8_LDB(dst, b, h) do { _Pragma("unroll") for (int n = 0; n < 2; ++n) _Pragma("unroll") for (int k = 0; k < 2; ++k) dst[n][k] = *(const PG8_LAS bf16x8*)(lds + PG8_SB(b, h) + boff + n * 2048 + k * 1024); } while (0)
#define PG8_MMA(ai, bj, At, Bt) do { __builtin_amdgcn_s_setprio(1); _Pragma("unroll") for (int m = 0; m < 4; ++m) _Pragma("unroll") for (int n = 0; n < 2; ++n) _Pragma("unroll") for (int k = 0; k < 2; ++k) \
        acc[ai][bj][m][n] = __builtin_amdgcn_mfma_f32_16x16x32_bf16(Bt[n][k], At[m][k], acc[ai][bj][m][n], 0, 0, 0); __builtin_amdgcn_s_setprio(0); } while (0)
#define PG8_RESCALE(hsel) do { int lz_ = lane; asm volatile("" : "+v"(lz_));   \
        const PG8_LAS float* rp_ = rt + ((ui >> 2) & 1) * 1024 + (wr * 64 + (lz_ & 15)) * 4 + (hsel); \
        _Pragma("unroll") for (int ai_ = 0; ai_ < 2; ++ai_) _Pragma("unroll") for (int m_ = 0; m_ < 4; ++m_) { const float f_ = rp_[(ai_ * HALF + m_ * 16) * 4]; \
            _Pragma("unroll") for (int bj_ = 0; bj_ < 2; ++bj_) { acc[ai_][bj_][m_][0] = acc[ai_][bj_][m_][0] * f_; acc[ai_][bj_][m_][1] = acc[ai_][bj_][m_][1] * f_; } } } while (0)
#define PG8_WAIT_V(n) asm volatile("s_waitcnt vmcnt(" #n ")" ::: "memory")
#define PG8_WAIT_L(n) asm volatile("s_waitcnt lgkmcnt(" #n ")" ::: "memory")
#define PG8_BAR __builtin_amdgcn_s_barrier()
#define PG8_SCHED __builtin_amdgcn_sched_barrier(0)
    Unit cur, nxt; int ui = 0;
    if (!S.next(0, cur)) return;
    cur.idx = 0;
    constexpr size_t HSTEP = 512;
    f32x4 acc[2][2][4][2];
#pragma unroll
    for (int a = 0; a < 2; ++a)
#pragma unroll
        for (int b = 0; b < 2; ++b)
#pragma unroll
            for (int m = 0; m < 4; ++m)
#pragma unroll
                for (int n = 0; n < 2; ++n) acc[a][b][m][n] = (f32x4){0.f, 0.f, 0.f, 0.f};
    bf16x8 At[4][2], B0[2][2], B1[2][2];
    const char* cA = (const char*)g.A + (size_t)cur.pm * tstep; const char* cB = (const char*)g.Bt + (size_t)cur.pn * tstep;
    S.a_ready(cur);
    if constexpr (SP2) {
        PG8_STAGE(PG8_SB(0, 0), cB, voffB); PG8_STAGE(PG8_SB(0, 1), cB + hstep, voffB); PG8_STAGE(PG8_SA(0, 0), cA, voffA); PG8_STAGE(PG8_SA(0, 1), cA + hstep, voffA);
        if (wr == 1) PG8_BAR;
        PG8_WAIT_V(2); PG8_BAR;
        PG8_STAGE(PG8_SB(1, 0), cB + kstep, voffB); PG8_STAGE(PG8_SA(1, 0), cA + kstep, voffA); PG8_STAGE(PG8_SB(1, 1), cB + hstep + kstep, voffB);
        PG8_WAIT_V(6); PG8_BAR;
    } else {
        PG8_STAGE(PG8_SB(0, 0), cB, voffB); PG8_STAGE(PG8_SA(0, 0), cA, voffA); PG8_STAGE(PG8_SB(0, 1), cB + hstep, voffB); PG8_STAGE(PG8_SA(0, 1), cA + hstep, voffA);
        if (wr == 1) PG8_BAR;
        PG8_WAIT_V(4); PG8_BAR;
        PG8_STAGE(PG8_SB(1, 0), cB + kstep, voffB); PG8_STAGE(PG8_SA(1, 0), cA + kstep, voffA); PG8_STAGE(PG8_SB(1, 1), cB + hstep + kstep, voffB);
        PG8_WAIT_V(6); PG8_BAR;
    }
    for (;;) {
        const bool has_next = S.next(HS ? ((ui + 1) >> 2) : (ui + 1), nxt); nxt.idx = HS ? ((ui + 1) >> 2) : (ui + 1);
        const size_t nko = HS ? (size_t)((ui + 1) & 3) * HSTEP : 0;
        const char* nA = has_next ? (const char*)g.A + (size_t)nxt.pm * tstep + nko : cA; const char* nB = has_next ? (const char*)g.Bt + (size_t)nxt.pn * tstep + nko : cB;
#pragma nounroll
        for (int t = 0; t < nt; t += 2) {
            const bool last = (t == nt - 2);
            const char* a1 = cA + (size_t)(t + 1) * kstep;
            const char* a2 = last ? nA : cA + (size_t)(t + 2) * kstep; const char* b2 = last ? nB : cB + (size_t)(t + 2) * kstep;
            const char* a3 = a2 + kstep; const char* b3 = b2 + kstep;
            if (last && has_next) S.a_ready(nxt);
            if constexpr (SP2) {
            PG8_LDB(B0, 0, 0); PG8_LDB(B1, 0, 1); PG8_SCHED; PG8_LDA(At, 0, 0); PG8_STAGE(PG8_SA(1, 1), a1 + hstep, voffA);
            PG8_WAIT_V(8); PG8_WAIT_L(0); PG8_BAR; PG8_MMA(0, 0, At, B0); PG8_MMA(0, 1, At, B1); PG8_BAR; PG8_SCHED;
            PG8_LDA(At, 0, 1); PG8_STAGE(PG8_SB(0, 0), b2, voffB); PG8_STAGE(PG8_SB(0, 1), b2 + hstep, voffB); PG8_STAGE(PG8_SA(0, 0), a2, voffA);
            PG8_WAIT_V(8); PG8_WAIT_L(0); PG8_BAR; PG8_MMA(1, 0, At, B0); PG8_MMA(1, 1, At, B1); PG8_BAR; PG8_SCHED;
            PG8_LDB(B0, 1, 0); PG8_LDB(B1, 1, 1); PG8_SCHED; PG8_LDA(At, 1, 0); PG8_STAGE(PG8_SA(0, 1), a2 + hstep, voffA);
            PG8_WAIT_V(8); PG8_WAIT_L(0); PG8_BAR; PG8_MMA(0, 0, At, B0); PG8_MMA(0, 1, At, B1); PG8_BAR; PG8_SCHED;
            PG8_LDA(At, 1, 1); PG8_STAGE(PG8_SB(1, 0), b3, voffB); PG8_STAGE(PG8_SB(1, 1), b3 + hstep, voffB); PG8_STAGE(PG8_SA(1, 0), a3, voffA);
            PG8_WAIT_V(8); PG8_WAIT_L(0); PG8_BAR; PG8_MMA(1, 0, At, B0); PG8_MMA(1, 1, At, B1); PG8_BAR; PG8_SCHED;
            } else {
            PG8_LDB(B0, 0, 0); PG8_SCHED; PG8_LDA(At, 0, 0); PG8_STAGE(PG8_SA(1, 1), a1 + hstep, voffA);
            PG8_WAIT_L(8); PG8_BAR; PG8_WAIT_L(0); PG8_MMA(0, 0, At, B0); PG8_BAR; PG8_SCHED;
            PG8_LDB(B1, 0, 1); PG8_STAGE(PG8_SB(0, 0), b2, voffB);
            PG8_BAR; PG8_WAIT_L(0); PG8_MMA(0, 1, At, B1); PG8_BAR;
            PG8_LDA(At, 0, 1); PG8_STAGE(PG8_SA(0, 0), a2, voffA);
            PG8_BAR; PG8_WAIT_L(0); PG8_MMA(1, 0, At, B0); PG8_BAR; PG8_SCHED;
            PG8_STAGE(PG8_SB(0, 1), b2 + hstep, voffB);
            PG8_WAIT_V(6); PG8_BAR; PG8_MMA(1, 1, At, B1); PG8_BAR;
            PG8_LDB(B0, 1, 0); PG8_SCHED; PG8_LDA(At, 1, 0); PG8_STAGE(PG8_SA(0, 1), a2 + hstep, voffA);
            PG8_WAIT_L(8); PG8_BAR; PG8_WAIT_L(0); PG8_MMA(0, 0, At, B0); PG8_BAR; PG8_SCHED;
            PG8_LDB(B1, 1, 1); PG8_STAGE(PG8_SB(1, 0), b3, voffB);
            PG8_BAR; PG8_WAIT_L(0); PG8_MMA(0, 1, At, B1); PG8_BAR;
            PG8_LDA(At, 1, 1); PG8_STAGE(PG8_SA(1, 0), a3, voffA);
            PG8_BAR; PG8_WAIT_L(0); PG8_MMA(1, 0, At, B0); PG8_BAR; PG8_SCHED;
            PG8_STAGE(PG8_SB(1, 1), b3 + hstep, voffB);
            PG8_WAIT_V(6); PG8_BAR; PG8_MMA(1, 1, At, B1); PG8_BAR;
            }
        }
        if constexpr (HS) { PG8_RESCALE(ui & 3); }
        const bool tile_done = !HS || (ui & 3) == 3;
        if (tile_done) {
        if constexpr (ALIGN_EPI) { if (wr == 0) PG8_BAR; }
        if constexpr (!Epi::AFTER_DRAIN) { E(acc, cur, wr, wc, fr, fq); S.done(cur); }
        }
        if (!has_next) break;
        if (tile_done) {
#pragma unroll
        for (int a = 0; a < 2; ++a)
#pragma unroll
            for (int b = 0; b < 2; ++b)
#pragma unroll
                for (int m = 0; m < 4; ++m)
#pragma unroll
                    for (int n = 0; n < 2; ++n) acc[a][b][m][n] = (f32x4){0.f, 0.f, 0.f, 0.f};
        }
        cur = nxt; cA = nA; cB = nB; ++ui;
        if (tile_done) { if constexpr (ALIGN_EPI) { if (wr == 1) PG8_BAR; } }
    }
    PG8_WAIT_V(0);
    if constexpr (!ALIGN_EPI) { if (wr == 0) PG8_BAR; }
    PG8_BAR;
#undef PG8_SA
#undef PG8_SB
#undef PG8_STAGE
#undef PG8_LDA
#undef PG8_LDB
#undef PG8_MMA
#undef PG8_WAIT_V
#undef PG8_RESCALE
#undef PG8_WAIT_L
#undef PG8_BAR
#undef PG8_SCHED
}
}

constexpr size_t MiB = 1u << 20;
constexpr size_t WS_CTL = 0, CTL_ZERO_BYTES = 1 * MiB;
constexpr size_t WS_COS = 2 * MiB, WS_SIN = 3 * MiB;
constexpr size_t WS_WG8 = 4 * MiB;
constexpr size_t WS_GATES = 5 * MiB;
constexpr size_t WS_LSE = 6 * MiB;
constexpr size_t WS_SSQ0 = 8 * MiB, WS_SSQ1 = 10 * MiB;
constexpr size_t WS_SSQH = 12 * MiB;
constexpr size_t WS_WINA = 16 * MiB;
constexpr size_t WS_WOUTA = 32 * MiB;
constexpr size_t WS_WINB0 = 36 * MiB;
constexpr size_t WS_WINB1 = 42 * MiB;
constexpr size_t WS_WOUTB = 46 * MiB;
constexpr size_t WS_WGATE = 48 * MiB;
constexpr size_t WS_WPLE = 56 * MiB;
constexpr size_t WS_HB0 = 64 * MiB, WS_HB1 = 128 * MiB;
constexpr size_t WS_PB = 192 * MiB;
constexpr size_t WS_S0 = WS_S0_, WS_S1 = WS_S1_, WS_S2 = WS_S2_, WS_S3 = WS_S3_, WS_END = 464 * MiB;
constexpr int CW_BAR = 4096;

#define XB_TMO      128
#define XB_XCNT(j)  (256  + 64 * (j))
#define XB_XSUB(j)  (1280 + 64 * (j))
#define XB_XGEN(j)  (2304 + 64 * (j))
#define XB_TOP      3328
#define XB_TOPGEN   3392
#define XCD_BAR_WORDS 3456
#define XB_SPIN_CAP (1u << 18)
__device__ __forceinline__ unsigned xb_ld(unsigned* p)              { return __hip_atomic_load(p, __ATOMIC_RELAXED, __HIP_MEMORY_SCOPE_AGENT); }
__device__ __forceinline__ unsigned xb_add(unsigned* p, unsigned v) { return __hip_atomic_fetch_add(p, v, __ATOMIC_RELAXED, __HIP_MEMORY_SCOPE_AGENT); }
__device__ __forceinline__ unsigned xb_xcc_id() { return (unsigned)__builtin_amdgcn_s_getreg((3 << 11) | 20) & 0xFu; }
#define XB_SPIN(cond, bar) do { unsigned _sp = 0; while (cond) { __builtin_amdgcn_s_sleep(1); \
    if ((++_sp & 255u) == 0u) { if (xb_ld(&(bar)[XB_TMO])) break; if (_sp > XB_SPIN_CAP) { atomicAdd(&(bar)[XB_TMO], 1u); break; } } } } while (0)
struct XcdBarrier { unsigned* bar; unsigned x; volatile LAS unsigned* st; };
__device__ __forceinline__ XcdBarrier xcd_barrier_post(unsigned* bar, volatile LAS unsigned* st) {
    XcdBarrier b; b.bar = bar; b.x = xb_xcc_id(); b.st = st;
    if (threadIdx.x == 0) (void)xb_add(&bar[XB_XCNT(b.x)], 1u);
    return b;
}
__device__ __forceinline__ void xcd_barrier_complete(unsigned* bar, unsigned x, unsigned& nloc, unsigned& nx) {
    const unsigned G = gridDim.x * gridDim.y * gridDim.z;
    unsigned sum, cnt, mine, sp = 0u;
    for (;;) {
        sum = 0u; cnt = 0u; mine = 0u;
#pragma unroll
        for (unsigned j = 0; j < 16; ++j) { const unsigned c = xb_ld(&bar[XB_XCNT(j)]); sum += c; cnt += (c > 0u) ? 1u : 0u; mine = (j == x) ? c : mine; }
        if (sum == G) break;
        __builtin_amdgcn_s_sleep(1);
        if ((++sp & 255u) == 0u) { if (xb_ld(&bar[XB_TMO])) break; if (sp > XB_SPIN_CAP) { atomicAdd(&bar[XB_TMO], 1u); break; } }
    }
    nloc = mine > 0u ? mine : 1u; nx = cnt > 0u ? cnt : 1u;
}
__device__ __forceinline__ void xcd_barrier(const XcdBarrier& b) {
    asm volatile("s_waitcnt vmcnt(0)" ::: "memory");
    __syncthreads();
    if (threadIdx.x == 0) {
        unsigned* bar = b.bar;
        __builtin_amdgcn_s_waitcnt(0);
        unsigned nloc = b.st[0], nx = b.st[1];
        if (nloc == 0u) { xcd_barrier_complete(bar, b.x, nloc, nx); b.st[0] = nloc; b.st[1] = nx; }
        const unsigned old = xb_add(&bar[XB_XSUB(b.x)], 1u);
        const unsigned gen = old / nloc;
        if (old + 1u == (gen + 1u) * nloc) {
            __builtin_amdgcn_fence(__ATOMIC_RELEASE, "agent");
            asm volatile("s_waitcnt vmcnt(0)" ::: "memory");
            const unsigned og = xb_add(&bar[XB_TOP], 1u);
            const unsigned tg = og / nx;
            if (og + 1u == (tg + 1u) * nx) xb_add(&bar[XB_TOPGEN], 1u);
            else XB_SPIN(xb_ld(&bar[XB_TOPGEN]) == tg, bar);
            __builtin_amdgcn_fence(__ATOMIC_ACQUIRE, "agent");
            xb_add(&bar[XB_XGEN(b.x)], 1u);
            asm volatile("s_waitcnt vmcnt(0)" ::: "memory");
        } else {
            XB_SPIN(xb_ld(&bar[XB_XGEN(b.x)]) == gen, bar);
            __builtin_amdgcn_fence(__ATOMIC_ACQUIRE, "agent");
            asm volatile("s_waitcnt vmcnt(0)" ::: "memory");
        }
    }
    __syncthreads();
}

struct Args {
    const float* x; const float* p; const float* norm_a; const float* w_in_a; const float* conv_a; const float* b_gate_a; const float* hnorm_a; const float* w_out_a;
    const float* norm_kv; const float* w_kv; const float* knorm; const float* norm_b; const float* w_in_b; const float* qnorm_b; const float* w_out_b;
    const float* ple_norm; const float* w_ple_gate; const float* w_ple;
    float* out; unsigned char* ws;
};

constexpr int NWAVES = 8, NTHR = 512;
constexpr int RING_OFF = 0;
constexpr int MISC_OFF = 160 * 1024 - 256;
constexpr int LDS_BYTES = 160 * 1024;

#define LDS_WAIT() asm volatile("s_waitcnt lgkmcnt(0)" ::: "memory")
#define LDS_BARRIER() do { asm volatile("s_waitcnt lgkmcnt(0)" ::: "memory"); __builtin_amdgcn_s_barrier(); asm volatile("" ::: "memory"); } while (0)

__device__ __forceinline__ void transpose_item(const float* W, int K, int ldw, int ncol0, int nblk, const float* gain, bf16_t* WT, int row_off, int nperm, LAS float* scr, int item, int lane) {
    const int kb = item / nblk, nb = item % nblk, k0 = 64 * kb, n0 = 32 * nb;
    {
        const int kr = lane >> 3, n4 = (lane & 7) * 4;
        f32x4 wv[8]; float gv[8];
#pragma unroll
        for (int i = 0; i < 8; ++i) { wv[i] = *(const f32x4*)(W + (size_t)(k0 + 8 * i + kr) * ldw + ncol0 + n0 + n4); gv[i] = gain ? gain[k0 + 8 * i + kr] : 1.f; }
#pragma unroll
        for (int i = 0; i < 8; ++i) { LAS float* d = scr + (8 * i + kr) * 33 + n4; d[0] = wv[i].x * gv[i]; d[1] = wv[i].y * gv[i]; d[2] = wv[i].z * gv[i]; d[3] = wv[i].w * gv[i]; }
    }
    LDS_WAIT(); asm volatile("" ::: "memory");
    const int c = lane & 7;
#pragma unroll
    for (int j = 0; j < 4; ++j) { const int n = (lane >> 3) + 8 * j; const LAS float* s = scr + (8 * c) * 33 + n;
        u32x4 o; o.x = cvt_pk_bf16(s[0 * 33], s[1 * 33]); o.y = cvt_pk_bf16(s[2 * 33], s[3 * 33]); o.z = cvt_pk_bf16(s[4 * 33], s[5 * 33]); o.w = cvt_pk_bf16(s[6 * 33], s[7 * 33]);
        int col = n0 + n; if (col < nperm) { const int d = col & 127; col = (col & ~127) + 32 * ((d & 63) >> 4) + 8 * ((d >> 2) & 3) + 4 * (d >> 6) + (d & 3); }
        *(u32x4*)(WT + (size_t)(row_off + col) * K + k0 + 8 * c) = o; }
    LDS_WAIT(); asm volatile("" ::: "memory");
}

__device__ __forceinline__ void prologue(const Args& a, LAS unsigned char* lds, int gw, int NGW, int lane, int wave) {
    unsigned char* ws = a.ws;
    LAS float* scr = (LAS float*)(lds + wave * 16384);
    struct TJ { const float* W; int K, ldw, ncol0, ncols; const float* gain; bf16_t* dst; int row_off, nperm; };
    int it = gw;
    for (int job = 0; job < 17; ++job) {
        TJ j;
        if (job < 2)       j = TJ{a.w_in_a + (size_t)job * 1024 * A_COLS, 1024, A_COLS, 0, 4096, a.norm_a + job * 1024, (bf16_t*)(ws + WS_WINA) + (size_t)job * 4096 * 1024, 0, 0};
        else if (job < 4)  j = TJ{a.w_out_a + (size_t)(job - 2) * 1024 * 1024, 1024, 1024, 0, 1024, a.hnorm_a + (job - 2) * 1024, (bf16_t*)(ws + WS_WOUTA) + (size_t)(job - 2) * 1024 * 1024, 0, 0};
        else if (job == 4) j = TJ{a.w_in_b, 1024, 2048, 0, 2048, a.norm_b, (bf16_t*)(ws + WS_WINB0), 0, 1536};
        else if (job == 5) j = TJ{a.w_in_b + (size_t)1024 * 2048, 1024, 2048, 0, 2048, a.norm_b + 1024, (bf16_t*)(ws + WS_WINB1), 0, 1536};
        else if (job == 6) j = TJ{a.w_kv, 1024, 1024, 0, 1024, a.norm_kv, (bf16_t*)(ws + WS_WINB0), 2048, 512};
        else if (job < 9)  j = TJ{a.w_out_b + (size_t)(job - 7) * 512 * 1024, 512, 1024, 0, 1024, nullptr, (bf16_t*)(ws + WS_WOUTB) + (size_t)(job - 7) * 1024 * 512, 0, 0};
        else if (job < 13) j = TJ{a.w_ple_gate + (size_t)(job - 9) * 1024 * 1024, 1024, 1024, 0, 1024, a.ple_norm + (job - 9) * 1024, (bf16_t*)(ws + WS_WGATE) + (size_t)(job - 9) * 1024 * 1024, 0, 0};
        else               j = TJ{a.w_ple + (size_t)(job - 13) * 256 * 1024, 256, 1024, 0, 1024, nullptr, (bf16_t*)(ws + WS_WPLE) + (size_t)(job - 13) * 1024 * 256, 0, 0};
        const int nblk = j.ncols / 32, nitems = (j.K / 64) * nblk;
        for (; it < nitems; it += NGW) transpose_item(j.W, j.K, j.ldw, j.ncol0, nblk, j.gain, j.dst, j.row_off, j.nperm, scr, it, lane);
        it -= nitems;
    }
    {
        bf16_t* HB = (bf16_t*)(ws + WS_HB0); float* SSQ = (float*)(ws + WS_SSQ0);
        for (int m0 = gw * 4; m0 < T; m0 += NGW * 4) {
            f32x4 v[4][4];
#pragma unroll
            for (int r = 0; r < 4; ++r) { const f32x4* xr = (const f32x4*)(a.x + (size_t)(m0 + r) * D) + lane;
#pragma unroll
                for (int jj = 0; jj < 4; ++jj) v[r][jj] = xr[64 * jj]; }
#pragma unroll
            for (int r = 0; r < 4; ++r) {
                float sq = 0.f;
#pragma unroll
                for (int jj = 0; jj < 4; ++jj) sq += (v[r][jj].x * v[r][jj].x + v[r][jj].y * v[r][jj].y) + (v[r][jj].z * v[r][jj].z + v[r][jj].w * v[r][jj].w);
#pragma unroll
                for (int o = 1; o < 64; o <<= 1) sq += __shfl_xor(sq, o);
                u32x2* o8 = (u32x2*)(HB + (size_t)(m0 + r) * D) + lane;
#pragma unroll
                for (int jj = 0; jj < 4; ++jj) { u32x2 w; w.x = cvt_pk_bf16(v[r][jj].x, v[r][jj].y); w.y = cvt_pk_bf16(v[r][jj].z, v[r][jj].w); o8[64 * jj] = w; }
                if (lane < 16) SSQ[(size_t)(m0 + r) * 16 + lane] = lane == 0 ? sq : 0.f;
            }
        }
    }
    {
        float* COS = (float*)(ws + WS_COS); float* SIN = (float*)(ws + WS_SIN);
        for (int i = gw * 64 + lane; i < SEQ * 64; i += NGW * 64) {
            const int pos = i >> 6, fi = i & 63;
            const float crev = exp2f(-(float)fi * (13.287712379549449f / 64.0f)) * 0.15915494309189535f;
            float tr = (float)pos * crev; tr -= rintf(tr);
            COS[i] = __builtin_amdgcn_cosf(tr); SIN[i] = __builtin_amdgcn_sinf(tr);
        }
    }
    {
        bf16_t* WG = (bf16_t*)(ws + WS_WG8);
        for (int i = gw * 64 + lane; i < 2 * 16 * 1024; i += NGW * 64) {
            const int l = i >> 14, jj = (i >> 10) & 15, k = i & 1023;
            WG[i] = (jj < 8) ? f2bf(a.w_in_a[(size_t)l * 1024 * A_COLS + (size_t)k * A_COLS + 4096 + jj] * a.norm_a[l * 1024 + k]) : (bf16_t)0;
        }
    }
}

__device__ __forceinline__ void convert_p(const Args& a, int layer, int gtid, int NGT) {
    const f32x4* src = (const f32x4*)(a.p + (size_t)layer * T * PLE);
    u32x4* dst = (u32x4*)(a.ws + WS_PB);
    for (int i0 = gtid; i0 < T * PLE / 8; i0 += 8 * NGT) {
        f32x4 v[8][2];
#pragma unroll
        for (int q = 0; q < 8; ++q) { const int i = i0 + q * NGT; if (i < T * PLE / 8) { v[q][0] = src[2 * i]; v[q][1] = src[2 * i + 1]; } }
#pragma unroll
        for (int q = 0; q < 8; ++q) { const int i = i0 + q * NGT; if (i < T * PLE / 8) {
            u32x4 w; w.x = cvt_pk_bf16(v[q][0].x, v[q][0].y); w.y = cvt_pk_bf16(v[q][0].z, v[q][0].w); w.z = cvt_pk_bf16(v[q][1].x, v[q][1].y); w.w = cvt_pk_bf16(v[q][1].z, v[q][1].w);
            dst[i] = w; } }
    }
}

__device__ __forceinline__ void gates_job(const Args& a, int layer, const bf16_t* HB, const float* SSQ, int gw, int NGW, int lane) {
    const bf16_t* WG = (const bf16_t*)(a.ws + WS_WG8) + (size_t)layer * 16 * 1024;
    float* GATES = (float*)(a.ws + WS_GATES);
    const int ql = lane & 15, grp = lane >> 4;
#pragma nounroll
    for (int t0 = gw * 16; t0 < T; t0 += NGW * 16) {
        const bf16_t* arow = HB + (size_t)(t0 + ql) * D + 8 * grp;
        const bf16_t* brow = WG + ql * 1024 + 8 * grp;
        f32x4 acc = (f32x4){0.f, 0.f, 0.f, 0.f};
#pragma unroll 8
        for (int ks = 0; ks < 32; ++ks) acc = __builtin_amdgcn_mfma_f32_16x16x32_bf16(*(const bf16x8*)(arow + 32 * ks), *(const bf16x8*)(brow + 32 * ks), acc, 0, 0, 0);
        if (ql < 8) {
            const float bias = a.b_gate_a[layer * 8 + ql];
#pragma unroll
            for (int ii = 0; ii < 4; ++ii) { const int t = t0 + 4 * grp + ii; GATES[(size_t)t * 8 + ql] = acc[ii] * ssq16_rstd(SSQ, t) + bias; }
        }
    }
}

__device__ __forceinline__ void conv_phase(const Args& a, int layer, int gtid, int NGT, int gw, int NGW, int lane) {
    const bf16_t* QKb = (const bf16_t*)(a.ws + WS_S0); bf16_t* QC = (bf16_t*)(a.ws + WS_HB1);
#pragma nounroll
    for (int task = gtid; task < (T / 16) * 128; task += NGT) {
        const int cgp = task & 127, run = task >> 7, t0 = run * 16, ch0 = cgp * 8;
        float cw[4][8];
#pragma unroll
        for (int jj = 0; jj < 4; ++jj) { const f32x4 c0 = *(const f32x4*)(a.conv_a + (size_t)layer * 4096 + jj * 1024 + ch0), c1 = *(const f32x4*)(a.conv_a + (size_t)layer * 4096 + jj * 1024 + ch0 + 4);
            cw[jj][0] = c0.x; cw[jj][1] = c0.y; cw[jj][2] = c0.z; cw[jj][3] = c0.w; cw[jj][4] = c1.x; cw[jj][5] = c1.y; cw[jj][6] = c1.z; cw[jj][7] = c1.w; }
        const float scl = (ch0 >= 512) ? 0.08838834764831845f : 1.f;
        const bool first = (t0 & (SEQ - 1)) == 0;
        const bf16_t* src = QKb + (size_t)t0 * 1024 + ch0; bf16_t* dst = QC + (size_t)t0 * 1024 + ch0;
        u32x4 r[19];
#pragma unroll
        for (int q = 0; q < 19; ++q) r[q] = (q < 3 && first) ? (u32x4){0u, 0u, 0u, 0u} : *(const u32x4*)(src + (q - 3) * 1024);
#pragma unroll
        for (int q = 0; q < 16; ++q) {
            const unsigned w0[4] = {r[q].x, r[q].y, r[q].z, r[q].w}, w1[4] = {r[q + 1].x, r[q + 1].y, r[q + 1].z, r[q + 1].w}, w2[4] = {r[q + 2].x, r[q + 2].y, r[q + 2].z, r[q + 2].w}, w3[4] = {r[q + 3].x, r[q + 3].y, r[q + 3].z, r[q + 3].w};
            unsigned ow[4];
#pragma unroll
            for (int e = 0; e < 4; ++e) {
                float u0 = cw[0][2 * e] * bf_lo(w0[e]) + cw[1][2 * e] * bf_lo(w1[e]) + cw[2][2 * e] * bf_lo(w2[e]) + cw[3][2 * e] * bf_lo(w3[e]);
                float u1 = cw[0][2 * e + 1] * bf_hi(w0[e]) + cw[1][2 * e + 1] * bf_hi(w1[e]) + cw[2][2 * e + 1] * bf_hi(w2[e]) + cw[3][2 * e + 1] * bf_hi(w3[e]);
                u0 = u0 * sigmoidf_(u0) * scl; u1 = u1 * sigmoidf_(u1) * scl;
                ow[e] = cvt_pk_bf16(u0, u1);
            }
            *(u32x4*)(dst + (size_t)q * 1024) = (u32x4){ow[0], ow[1], ow[2], ow[3]};
        }
    }
    const float* GATES = (const float*)(a.ws + WS_GATES); float* TAB = (float*)(a.ws + WS_LSE);
#pragma nounroll
    for (int task = gw; task < 32 * 64; task += NGW) {
        const int bh = task >> 6, cc = task & 63, b = bh >> 2, h = bh & 3, t = cc * 64 + lane;
        const float gi = GATES[((size_t)b * SEQ + t) * 8 + h], gf = GATES[((size_t)b * SEQ + t) * 8 + 4 + h];
        const float lf = fminf(gf, 0.f) - log1pf(expf(-fabsf(gf)));
        float bc = lf;
#pragma unroll
        for (int o = 1; o < 64; o <<= 1) { const float tt = __shfl_up(bc, o); if (lane >= o) bc += tt; }
        const float av = gi - bc;
        float pm = av;
#pragma unroll
        for (int o = 1; o < 64; o <<= 1) { const float tt = __shfl_up(pm, o); if (lane >= o) pm = fmaxf(pm, tt); }
        float* tb = TAB + (size_t)bh * 3 * SEQ + t;
        tb[0] = av; tb[SEQ] = pm; tb[2 * SEQ] = bc;
    }
}

namespace scan {
constexpr int QS = 0, KS = 18432, VS = 36864, CS = 41984, HS1 = 68096, HS2 = 76544, GA = 84992, TA = 86016, TPM = TA + 16384, TB = TPM + 16384;
constexpr int QSTR = 288, VSTR = 80, CSTR = 272, CBUF = 48 * 272;
constexpr int O_EA = 0, O_D1 = 64, O_D2 = 128, O_FL = 192;
typedef short s16x4 __attribute__((ext_vector_type(4)));

__device__ __forceinline__ void flush_out(LAS unsigned char* lds, bf16_t* OGb, float* SSQH, size_t row, int vcol, int tokv, int c4, int h, int s, u32x4 ograw, u32x4 szraw) {
    const LAS float* hs1 = (const LAS float*)(lds + HS1) + tokv * 33 + 8 * c4; const LAS float* hs2 = (const LAS float*)(lds + HS2) + tokv * 33 + 8 * c4;
    const LAS float* ga = (const LAS float*)(lds + GA);
    const float rden = 1.f / fmaxf(fabsf(ga[O_D1 + tokv] + ga[O_D2 + tokv]), ga[O_FL + tokv]);
    const unsigned ow[4] = {ograw.x, ograw.y, ograw.z, ograw.w}, zw[4] = {szraw.x, szraw.y, szraw.z, szraw.w};
    float sq = 0.f; unsigned outw[4];
#pragma unroll
    for (int e = 0; e < 4; ++e) {
        const float g0 = bf_lo(ow[e]) * ((hs1[2 * e] + hs2[2 * e]) * rden), g1 = bf_hi(ow[e]) * ((hs1[2 * e + 1] + hs2[2 * e + 1]) * rden);
        sq += g0 * g0 + g1 * g1;
        outw[e] = cvt_pk_bf16(g0 * bf_lo(zw[e]), g1 * bf_hi(zw[e]));
    }
    sq += __shfl_xor(sq, 1); sq += __shfl_xor(sq, 2);
    *(u32x4*)(OGb + row * 1024 + vcol) = (u32x4){outw[0], outw[1], outw[2], outw[3]};
    if (c4 == 0) SSQH[row * 32 + h * 8 + s] = sq;
}

template <int VAR>
__device__ __forceinline__ void phase(const Args& a, LAS unsigned char* lds, int layer, int G) {
    int tid = threadIdx.x; asm volatile("" : "+v"(tid));
    unsigned char* ws = a.ws; (void)layer;
    const bf16_t* QCb = (const bf16_t*)(ws + WS_HB1); const bf16_t* Vb = (const bf16_t*)(ws + WS_S1);
    bf16_t* OGb = (bf16_t*)(ws + WS_S2); const bf16_t* SZb = (const bf16_t*)(ws + WS_S3);
    float* SSQH = (float*)(ws + WS_SSQH);
    for (int item = blockIdx.x; item < 256; item += G) {
        const int xx = item & 7, kk = item >> 3, bh = xx * 4 + (kk >> 3), s = kk & 7, b = bh >> 2, h = bh & 3;
        const size_t rowbase = (size_t)b * SEQ;
        {
            unsigned z0 = 0u; asm volatile("" : "+v"(z0));
            for (int i = tid; i < 2 * CBUF / 4; i += NTHR) ((LAS unsigned*)(lds + CS))[i] = z0;
        }
        f32x4 Cacc[3][2];
#pragma unroll
        for (int vt = 0; vt < 3; ++vt) { Cacc[vt][0] = (f32x4){0.f, 0.f, 0.f, 0.f}; Cacc[vt][1] = (f32x4){0.f, 0.f, 0.f, 0.f}; }
        float mprev = 0.f;
        u32x4 qk[4]; u32x4 vraw = (u32x4){0u, 0u, 0u, 0u}, ograw = vraw, szraw = vraw;
        {
#pragma unroll
            for (int i = 0; i < 4; ++i) { const int p = (tid + 512 * i) & 1023, row = p >> 4, c16 = p & 15;
                qk[i] = *(const u32x4*)(QCb + (rowbase + row) * 1024 + (i >= 2 ? 512 : 0) + h * 128 + c16 * 8); }
            if (tid < 256) vraw = *(const u32x4*)(Vb + (rowbase + ((tid >> 2) & 63)) * 1024 + h * 256 + s * 32 + 8 * (tid & 3));
        }
        {
            const u32x4* src = (const u32x4*)((const float*)(ws + WS_LSE) + (size_t)bh * 3 * SEQ);
            u32x4 tv[6];
#pragma unroll
            for (int q = 0; q < 6; ++q) tv[q] = src[tid + 512 * q];
#pragma unroll
            for (int q = 0; q < 6; ++q) *(LAS u32x4*)(lds + TA + (tid + 512 * q) * 16) = tv[q];
        }
        __syncthreads();
#pragma nounroll
        for (int c = 0; c < (VAR == 6 ? 0 : 64); ++c) {
            int tl = tid; asm volatile("" : "+v"(tl));
            const int w = __builtin_amdgcn_readfirstlane(tl >> 6), lane = tl & 63, grp = lane >> 4, ql = lane & 15;
            const int tokv = (tl >> 2) & 63, c4 = tl & 3;
            const int vcol = h * 256 + s * 32 + 8 * c4;
            LAS float* ga = (LAS float*)(lds + GA);
            const int t0 = c * 64, cur = c & 1, nxt = cur ^ 1;
            const LAS float* tA = (const LAS float*)(lds + TA) + c * 64; const LAS float* tPM = (const LAS float*)(lds + TPM) + c * 64; const LAS float* tB = (const LAS float*)(lds + TB) + c * 64;
            const float mcur = mprev;
            const float cmax = tPM[63];
            const float Mlast = fmaxf(mcur, cmax);
            const float decay = __expf(mcur - Mlast), sB = __expf(cmax - Mlast);
            mprev = tB[63] + Mlast;
            if (VAR != 5 && c > 0 && tl < 256) flush_out(lds, OGb, SSQH, rowbase + (t0 - 64) + tokv, vcol, tokv, c4, h, s, ograw, szraw);
            if (VAR != 5) {
                const int p0 = tl, p1 = tl + 512;
                *(LAS u32x4*)(lds + QS + (p0 >> 4) * QSTR + (p0 & 15) * 16) = qk[0];
                *(LAS u32x4*)(lds + QS + (p1 >> 4) * QSTR + (p1 & 15) * 16) = qk[1];
                *(LAS u32x4*)(lds + KS + (p0 >> 4) * QSTR + (p0 & 15) * 16) = qk[2];
                *(LAS u32x4*)(lds + KS + (p1 >> 4) * QSTR + (p1 & 15) * 16) = qk[3];
                if (tl < 256) {
                    const float ea = __expf(tA[tokv] - cmax);
                    u32x4 vs; vs.x = cvt_pk_bf16(bf_lo(vraw.x) * ea, bf_hi(vraw.x) * ea); vs.y = cvt_pk_bf16(bf_lo(vraw.y) * ea, bf_hi(vraw.y) * ea);
                    vs.z = cvt_pk_bf16(bf_lo(vraw.z) * ea, bf_hi(vraw.z) * ea); vs.w = cvt_pk_bf16(bf_lo(vraw.w) * ea, bf_hi(vraw.w) * ea);
                    *(LAS u32x4*)(lds + VS + tokv * VSTR + c4 * 16) = vs;
                }
            }
            LDS_WAIT();
            if (w == 7) ga[O_EA + lane] = __expf(tA[lane] - cmax);
            if (VAR != 1 && VAR != 4 && VAR != 5) { if (tl < 256) { const size_t row = rowbase + t0 + tokv; ograw = *(const u32x4*)(OGb + row * 1024 + vcol); szraw = *(const u32x4*)(SZb + row * 1024 + vcol); } }
            if (VAR == 1 || VAR == 4 || VAR == 5) { asm volatile("" : "+v"(qk[0]), "+v"(qk[1]), "+v"(qk[2]), "+v"(qk[3]), "+v"(vraw), "+v"(ograw), "+v"(szraw)); }
            if (VAR != 1 && VAR != 4 && VAR != 5 && c < 63) {
#pragma unroll
                for (int i = 0; i < 4; ++i) { const int p = (tl + 512 * i) & 1023, row = p >> 4, c16 = p & 15;
                    qk[i] = *(const u32x4*)(QCb + (rowbase + t0 + 64 + row) * 1024 + (i >= 2 ? 512 : 0) + h * 128 + c16 * 8); }
                if (tl < 256) vraw = *(const u32x4*)(Vb + (rowbase + t0 + 64 + tokv) * 1024 + vcol);
            }
            LDS_BARRIER();
            const LAS unsigned char* vbase = lds + VS + (4 * grp + (ql >> 2)) * VSTR + (ql & 3) * 8;
            if (VAR == 2 || VAR == 4 || VAR == 5) { } else if (w < 4) {
                const int ti = w, i = 16 * ti + ql;
                bf16x8 Qf[4];
                {
                    const LAS unsigned char* qb = lds + QS + i * QSTR + grp * 16;
#pragma unroll
                    for (int ks = 0; ks < 4; ++ks) Qf[ks] = *(const LAS bf16x8*)(qb + ks * 64);
                }
                const float Mi = fmaxf(mcur, tPM[i]), eb = __expf(cmax - Mi), flr = __expf(-(tB[i] + Mi));
                f32x4 wt[4];
                const LAS unsigned char* kb = lds + KS + ql * QSTR + grp * 16;
#pragma unroll
                for (int tj = 0; tj < 4; ++tj) {
                    f32x4 sacc = (f32x4){0.f, 0.f, 0.f, 0.f};
                    if (tj <= ti) {
#pragma unroll
                        for (int ks = 0; ks < 4; ++ks) sacc = __builtin_amdgcn_mfma_f32_16x16x32_bf16(*(const LAS bf16x8*)(kb + tj * 16 * QSTR + ks * 64), Qf[ks], sacc, 0, 0, 0);
                    }
                    if (tj == ti) {
#pragma unroll
                        for (int ii = 0; ii < 4; ++ii) sacc[ii] = (4 * grp + ii <= ql) ? sacc[ii] : 0.f;
                    }
                    wt[tj] = sacc;
                }
                f32x4 acc1[3];
#pragma unroll
                for (int vt = 0; vt < 3; ++vt) acc1[vt] = (f32x4){0.f, 0.f, 0.f, 0.f};
#pragma unroll
                for (int p = 0; p < 2; ++p) {
                    u32x4 pw; pw.x = cvt_pk_bf16(wt[2 * p][0], wt[2 * p][1]); pw.y = cvt_pk_bf16(wt[2 * p][2], wt[2 * p][3]); pw.z = cvt_pk_bf16(wt[2 * p + 1][0], wt[2 * p + 1][1]); pw.w = cvt_pk_bf16(wt[2 * p + 1][2], wt[2 * p + 1][3]);
                    const bf16x8 Pf = __builtin_bit_cast(bf16x8, pw);
#pragma unroll
                    for (int vt = 0; vt < 2; ++vt) {
                        const s16x4 lo = __builtin_amdgcn_ds_read_tr16_b64_v4i16((LAS s16x4*)(vbase + (32 * p) * VSTR + vt * 32));
                        const s16x4 hi = __builtin_amdgcn_ds_read_tr16_b64_v4i16((LAS s16x4*)(vbase + (32 * p + 16) * VSTR + vt * 32));
                        acc1[vt] = __builtin_amdgcn_mfma_f32_16x16x32_bf16((bf16x8){lo[0], lo[1], lo[2], lo[3], hi[0], hi[1], hi[2], hi[3]}, Pf, acc1[vt], 0, 0, 0);
                    }
                    const f32x4 e0 = *(const LAS f32x4*)(ga + O_EA + 32 * p + 4 * grp), e1 = *(const LAS f32x4*)(ga + O_EA + 32 * p + 16 + 4 * grp);
                    u32x4 aw; aw.x = cvt_pk_bf16(e0[0], e0[1]); aw.y = cvt_pk_bf16(e0[2], e0[3]); aw.z = cvt_pk_bf16(e1[0], e1[1]); aw.w = cvt_pk_bf16(e1[2], e1[3]);
                    if (ql != 0) aw = (u32x4){0u, 0u, 0u, 0u};
                    acc1[2] = __builtin_amdgcn_mfma_f32_16x16x32_bf16(__builtin_bit_cast(bf16x8, aw), Pf, acc1[2], 0, 0, 0);
                }
                LAS float* hsw = (LAS float*)(lds + HS1) + i * 33 + 4 * grp;
#pragma unroll
                for (int vt = 0; vt < 2; ++vt)
#pragma unroll
                    for (int ii = 0; ii < 4; ++ii) hsw[16 * vt + ii] = acc1[vt][ii] * eb;
                if (grp == 0) { ga[O_D1 + i] = acc1[2][0] * eb; ga[O_FL + i] = flr; }
            } else {
                const int wb = w - 4, i = 16 * wb + ql;
                {
                    bf16x8 Qf[4];
                    const LAS unsigned char* qb = lds + QS + i * QSTR + grp * 16;
#pragma unroll
                    for (int ks = 0; ks < 4; ++ks) Qf[ks] = *(const LAS bf16x8*)(qb + ks * 64);
                    f32x4 acc2[3];
#pragma unroll
                    for (int vt = 0; vt < 3; ++vt) acc2[vt] = (f32x4){0.f, 0.f, 0.f, 0.f};
                    const LAS unsigned char* cb = lds + CS + cur * CBUF + ql * CSTR + grp * 16;
#pragma unroll
                    for (int vt = 0; vt < 3; ++vt)
#pragma unroll
                        for (int ks = 0; ks < 4; ++ks) acc2[vt] = __builtin_amdgcn_mfma_f32_16x16x32_bf16(*(const LAS bf16x8*)(cb + vt * 16 * CSTR + ks * 64), Qf[ks], acc2[vt], 0, 0, 0);
                    const float inter = __expf(mcur - fmaxf(mcur, tPM[i]));
                    LAS float* hsw = (LAS float*)(lds + HS2) + i * 33 + 4 * grp;
#pragma unroll
                    for (int vt = 0; vt < 2; ++vt)
#pragma unroll
                        for (int ii = 0; ii < 4; ++ii) hsw[16 * vt + ii] = acc2[vt][ii] * inter;
                    if (grp == 0) ga[O_D2 + i] = acc2[2][0] * inter;
                }
                f32x4 U[3][2];
#pragma unroll
                for (int vt = 0; vt < 3; ++vt) { U[vt][0] = (f32x4){0.f, 0.f, 0.f, 0.f}; U[vt][1] = (f32x4){0.f, 0.f, 0.f, 0.f}; }
                const LAS unsigned char* kbase = lds + KS + (4 * grp + (ql >> 2)) * QSTR + (ql & 3) * 8 + wb * 64;
#pragma unroll
                for (int p = 0; p < 2; ++p) {
                    bf16x8 Af[3];
#pragma unroll
                    for (int vt = 0; vt < 2; ++vt) {
                        const s16x4 lo = __builtin_amdgcn_ds_read_tr16_b64_v4i16((LAS s16x4*)(vbase + (32 * p) * VSTR + vt * 32));
                        const s16x4 hi = __builtin_amdgcn_ds_read_tr16_b64_v4i16((LAS s16x4*)(vbase + (32 * p + 16) * VSTR + vt * 32));
                        Af[vt] = (bf16x8){lo[0], lo[1], lo[2], lo[3], hi[0], hi[1], hi[2], hi[3]};
                    }
                    { const f32x4 e0 = *(const LAS f32x4*)(ga + O_EA + 32 * p + 4 * grp), e1 = *(const LAS f32x4*)(ga + O_EA + 32 * p + 16 + 4 * grp);
                      u32x4 aw; aw.x = cvt_pk_bf16(e0[0], e0[1]); aw.y = cvt_pk_bf16(e0[2], e0[3]); aw.z = cvt_pk_bf16(e1[0], e1[1]); aw.w = cvt_pk_bf16(e1[2], e1[3]);
                      if (ql != 0) aw = (u32x4){0u, 0u, 0u, 0u};
                      Af[2] = __builtin_bit_cast(bf16x8, aw); }
#pragma unroll
                    for (int dl = 0; dl < 2; ++dl) {
                        const s16x4 lo = __builtin_amdgcn_ds_read_tr16_b64_v4i16((LAS s16x4*)(kbase + (32 * p) * QSTR + dl * 32));
                        const s16x4 hi = __builtin_amdgcn_ds_read_tr16_b64_v4i16((LAS s16x4*)(kbase + (32 * p + 16) * QSTR + dl * 32));
                        const bf16x8 Bk = (bf16x8){lo[0], lo[1], lo[2], lo[3], hi[0], hi[1], hi[2], hi[3]};
#pragma unroll
                        for (int vt = 0; vt < 3; ++vt) U[vt][dl] = __builtin_amdgcn_mfma_f32_16x16x32_bf16(Af[vt], Bk, U[vt][dl], 0, 0, 0);
                    }
                }
#pragma unroll
                for (int vt = 0; vt < 3; ++vt)
#pragma unroll
                    for (int dl = 0; dl < 2; ++dl) Cacc[vt][dl] = Cacc[vt][dl] * decay + U[vt][dl] * sB;
                LAS unsigned char* cw_ = lds + CS + nxt * CBUF + (4 * grp) * CSTR + (32 * wb + ql) * 2;
#pragma unroll
                for (int dl = 0; dl < 2; ++dl) {
#pragma unroll
                    for (int vt = 0; vt < 2; ++vt)
#pragma unroll
                        for (int ii = 0; ii < 4; ++ii) *(LAS bf16_t*)(cw_ + (16 * vt + ii) * CSTR + dl * 32) = f2bf(Cacc[vt][dl][ii]);
                    if (grp == 0) *(LAS bf16_t*)(cw_ + 32 * CSTR + dl * 32) = f2bf(Cacc[2][dl][0]);
                }
            }
            LDS_BARRIER();
        }
        if (tid < 256) flush_out(lds, OGb, SSQH, rowbase + 63 * 64 + ((tid >> 2) & 63), h * 256 + s * 32 + 8 * (tid & 3), (tid >> 2) & 63, tid & 3, h, s, ograw, szraw);
        __syncthreads();
    }
}
}

__device__ __forceinline__ void mlstm_norm_phase(const Args& a, int gtid, int NGT) {
    const u32x4* A = (const u32x4*)(a.ws + WS_S2); u32x4* Y = (u32x4*)(a.ws + WS_S0); const float* SSQH = (const float*)(a.ws + WS_SSQH);
    for (int i = gtid; i < T * 128; i += NGT) {
        const int t = i >> 7, c8 = i & 127, h = c8 >> 5;
        const f32x4 s0 = *(const f32x4*)(SSQH + (size_t)t * 32 + h * 8), s1 = *(const f32x4*)(SSQH + (size_t)t * 32 + h * 8 + 4);
        const float rs = rsqrtf((((s0.x + s0.y) + (s0.z + s0.w)) + ((s1.x + s1.y) + (s1.z + s1.w))) * (1.f / 256.f) + EPS);
        const u32x4 v = A[i]; u32x4 o;
        o.x = cvt_pk_bf16(bf_lo(v.x) * rs, bf_hi(v.x) * rs); o.y = cvt_pk_bf16(bf_lo(v.y) * rs, bf_hi(v.y) * rs);
        o.z = cvt_pk_bf16(bf_lo(v.z) * rs, bf_hi(v.z) * rs); o.w = cvt_pk_bf16(bf_lo(v.w) * rs, bf_hi(v.w) * rs);
        Y[i] = o;
    }
}

namespace attn {
constexpr int KS = 0, VS = 69632;
constexpr int KSTR = 272, VSTR = 288;
typedef short s16x4 __attribute__((ext_vector_type(4)));
struct Item { int b, head, g, res, blk, r; };
__device__ __forceinline__ Item decode(int item) {
    const int xcd = item & 7, q = item >> 3, bhh = xcd + 8 * (q / 96), gi = q % 96;
    Item it; it.b = bhh >> 2; it.head = bhh & 3;
    if (gi < 32) { it.g = 0; it.res = 0; it.blk = gi; it.r = 1; } else if (gi < 64) { it.g = 1; it.res = (gi - 32) >> 3; it.blk = (gi - 32) & 7; it.r = 4; } else { it.g = 2; it.res = (gi - 64) >> 1; it.blk = (gi - 64) & 1; it.r = 16; }
    return it;
}
template <int VAR>
__device__ __forceinline__ void phase(const Args& a, LAS unsigned char* lds, int jl, int G) {
    int tid = threadIdx.x; asm volatile("" : "+v"(tid));
    unsigned char* ws = a.ws; (void)jl;
    const bf16_t* Kb = (const bf16_t*)(ws + WS_S0); const bf16_t* Vb = (const bf16_t*)(ws + WS_S0 + 32 * MiB);
    bf16_t* Qb = (bf16_t*)(ws + WS_S1);
    float* LSE = (float*)(ws + WS_LSE);
    { unsigned z0 = 0u; asm volatile("" : "+v"(z0)); if (tid < 16 * 18) *(LAS u32x4*)(lds + VS + 256 * VSTR + tid * 16) = (u32x4){z0, z0, z0, z0}; }
    u32x4 kreg[8], vreg[8]; bf16x8 qreg[4];
#define ATTN_LOAD(itm) do { const Item it_ = decode(itm); const size_t rb_ = (size_t)it_.b * SEQ; \
        _Pragma("unroll") for (int c_ = 0; c_ < (VAR == 3 ? 4 : 8); ++c_) { const int p_ = tid + 512 * c_, kj_ = p_ >> 4, u_ = (it_.blk - 1) * 128 + kj_, pos_ = u_ >= 0 ? u_ * it_.r + it_.res : 0; \
            const size_t off_ = (rb_ + pos_) * 512 + it_.head * 128 + (p_ & 15) * 8; kreg[c_] = *(const u32x4*)(Kb + off_); vreg[c_] = *(const u32x4*)(Vb + off_); } \
        const int lane_ = tid & 63, w_ = tid >> 6, posq_ = (128 * it_.blk + 16 * w_ + (lane_ & 15)) * it_.r + it_.res; \
        const bf16_t* qs_ = Qb + (rb_ + posq_) * 1536 + (it_.g * 4 + it_.head) * 128 + 8 * (lane_ >> 4); \
        _Pragma("unroll") for (int ks2_ = 0; ks2_ < 4; ++ks2_) qreg[ks2_] = *(const bf16x8*)(qs_ + 32 * ks2_); } while (0)
    int bx0 = blockIdx.x; asm volatile("" : "+s"(bx0));
    if (bx0 < 3072) ATTN_LOAD(bx0);
    if (VAR == 1) { _Pragma("unroll") for (int c_ = 0; c_ < 8; ++c_) asm volatile("" : "+v"(kreg[c_]), "+v"(vreg[c_])); }
#pragma nounroll
    for (int item = bx0; item < 3072; item += G) {
        int tl = tid; asm volatile("" : "+v"(tl));
        const int w = __builtin_amdgcn_readfirstlane(tl >> 6), lane = tl & 63, grp = lane >> 4, ql = lane & 15;
        const Item it = decode(item);
        const int blk = it.blk;
        const size_t rowbase = (size_t)it.b * SEQ;
#pragma unroll
        for (int c = 0; c < 8; ++c) {
            const int p = tl + 512 * c, kj = p >> 4, ch = p & 15;
            u32x4 kv = kreg[c], vv = vreg[c];
            if (blk == 0 && kj < 128) { kv = (u32x4){0u, 0u, 0u, 0u}; vv = kv; }
            *(LAS u32x4*)(lds + KS + kj * KSTR + ch * 16) = kv; *(LAS u32x4*)(lds + VS + kj * VSTR + ch * 16) = vv;
        }
        bf16x8 Qf[4];
#pragma unroll
        for (int ks = 0; ks < 4; ++ks) Qf[ks] = qreg[ks];
        const int qi = 16 * w + ql;
        const int posq = (128 * blk + qi) * it.r + it.res;
        bf16_t* orow = Qb + (rowbase + posq) * 1536 + (it.g * 4 + it.head) * 128 + 4 * grp;
        LDS_BARRIER();
        float mx = -__builtin_inff(); float den = 0.f;
        f32x4 oacc[8];
#pragma unroll
        for (int dt = 0; dt < 8; ++dt) oacc[dt] = (f32x4){0.f, 0.f, 0.f, 0.f};
        if (VAR != 2) {
        f32x4 sc[9];
        const int dbase = 128 + ql - 4 * grp; const unsigned dmax = (blk > 0) ? 128u : (unsigned)qi;
        const LAS unsigned char* kbase = lds + KS + (16 * w + ql) * KSTR + grp * 16;
        bf16x8 kf[2][4];
#pragma unroll
        for (int ks = 0; ks < 4; ++ks) kf[0][ks] = *(const LAS bf16x8*)(kbase + ks * 64);
#pragma unroll
        for (int tt = 0; tt < 9; ++tt) {
            if (tt < 8) {
#pragma unroll
                for (int ks = 0; ks < 4; ++ks) kf[(tt + 1) & 1][ks] = *(const LAS bf16x8*)(kbase + (tt + 1) * 16 * KSTR + ks * 64);
            }
            f32x4 acc = (f32x4){0.f, 0.f, 0.f, 0.f};
#pragma unroll
            for (int ks = 0; ks < 4; ++ks) acc = __builtin_amdgcn_mfma_f32_16x16x32_bf16(kf[tt & 1][ks], Qf[ks], acc, 0, 0, 0);
#pragma unroll
            for (int ii = 0; ii < 4; ++ii) {
                const int dist = dbase - 16 * tt - ii;
                const float v = ((unsigned)dist <= dmax) ? acc[ii] * 0.08838834764831845f : -__builtin_inff();
                sc[tt][ii] = v; mx = fmaxf(mx, v);
            }
        }
        if (VAR != 1) { if (item + G < 3072) ATTN_LOAD(item + G); }
        mx = fmaxf(mx, __shfl_xor(mx, 16)); mx = fmaxf(mx, __shfl_xor(mx, 32));
#pragma unroll
        for (int tt = 0; tt < 9; ++tt)
#pragma unroll
            for (int ii = 0; ii < 4; ++ii) { const float e = __expf(sc[tt][ii] - mx); sc[tt][ii] = e; den += e; }
        den += __shfl_xor(den, 16); den += __shfl_xor(den, 32);
        const LAS unsigned char* vbase = lds + VS + (16 * w + 4 * grp + (ql >> 2)) * VSTR + (ql & 3) * 8;
#pragma unroll
        for (int pp = 0; pp < 5; ++pp) {
            u32x4 pw;
            pw.x = cvt_pk_bf16(sc[2 * pp][0], sc[2 * pp][1]); pw.y = cvt_pk_bf16(sc[2 * pp][2], sc[2 * pp][3]);
            if (pp < 4) { pw.z = cvt_pk_bf16(sc[2 * pp + 1][0], sc[2 * pp + 1][1]); pw.w = cvt_pk_bf16(sc[2 * pp + 1][2], sc[2 * pp + 1][3]); } else { pw.z = 0u; pw.w = 0u; }
            const bf16x8 Pf = __builtin_bit_cast(bf16x8, pw);
#pragma unroll
            for (int dh = 0; dh < 2; ++dh) {
                s16x4 lo[4], hi[4];
#pragma unroll
                for (int d4 = 0; d4 < 4; ++d4) {
                    lo[d4] = __builtin_amdgcn_ds_read_tr16_b64_v4i16((LAS s16x4*)(vbase + pp * 32 * VSTR + (4 * dh + d4) * 32));
                    hi[d4] = __builtin_amdgcn_ds_read_tr16_b64_v4i16((LAS s16x4*)(vbase + pp * 32 * VSTR + 16 * VSTR + (4 * dh + d4) * 32));
                }
#pragma unroll
                for (int d4 = 0; d4 < 4; ++d4) {
                    const bf16x8 av = (bf16x8){lo[d4][0], lo[d4][1], lo[d4][2], lo[d4][3], hi[d4][0], hi[d4][1], hi[d4][2], hi[d4][3]};
                    oacc[4 * dh + d4] = __builtin_amdgcn_mfma_f32_16x16x32_bf16(av, Pf, oacc[4 * dh + d4], 0, 0, 0);
                }
            }
        }
        } else { den = 1.f; mx = 0.f; if (item + G < 3072) ATTN_LOAD(item + G); }
        const float inv = 1.f / den;
#pragma unroll
        for (int dt = 0; dt < 8; ++dt) { u32x2 o; o.x = cvt_pk_bf16(oacc[dt][0] * inv, oacc[dt][1] * inv); o.y = cvt_pk_bf16(oacc[dt][2] * inv, oacc[dt][3] * inv);
            *(u32x2*)(orow + 16 * dt) = o; }
        if (grp == 0) LSE[((size_t)it.g * T + rowbase + posq) * 4 + it.head] = mx + __logf(den);
        LDS_BARRIER();
    }
#undef ATTN_LOAD
}
}

__device__ __forceinline__ void attn_combine_phase(const Args& a, int gtid, int NGT) {
    const bf16_t* O = (const bf16_t*)(a.ws + WS_S1); const u32x4* SZ = (const u32x4*)(a.ws + WS_S3); u32x4* Y = (u32x4*)(a.ws + WS_S3 + 32 * MiB);
    const float* LSE = (const float*)(a.ws + WS_LSE);
    for (int i = gtid; i < T * 64; i += NGT) {
        const int t = i >> 6, c8 = i & 63, h = c8 >> 4;
        const float l0 = LSE[((size_t)0 * T + t) * 4 + h], l1 = LSE[((size_t)1 * T + t) * 4 + h], l2 = LSE[((size_t)2 * T + t) * 4 + h];
        const float m = fmaxf(l0, fmaxf(l1, l2));
        float w0 = __expf(l0 - m), w1 = __expf(l1 - m), w2 = __expf(l2 - m);
        const float inv = 1.f / (w0 + w1 + w2); w0 *= inv; w1 *= inv; w2 *= inv;
        const u32x4 o0 = *(const u32x4*)(O + (size_t)t * 1536 + c8 * 8), o1 = *(const u32x4*)(O + (size_t)t * 1536 + 512 + c8 * 8), o2 = *(const u32x4*)(O + (size_t)t * 1536 + 1024 + c8 * 8);
        const u32x4 z = SZ[i];
        const unsigned a0[4] = {o0.x, o0.y, o0.z, o0.w}, a1[4] = {o1.x, o1.y, o1.z, o1.w}, a2[4] = {o2.x, o2.y, o2.z, o2.w}, zz[4] = {z.x, z.y, z.z, z.w};
        unsigned ow[4];
#pragma unroll
        for (int e = 0; e < 4; ++e) {
            const float lo = (w0 * bf_lo(a0[e]) + w1 * bf_lo(a1[e]) + w2 * bf_lo(a2[e])) * bf_lo(zz[e]);
            const float hi = (w0 * bf_hi(a0[e]) + w1 * bf_hi(a1[e]) + w2 * bf_hi(a2[e])) * bf_hi(zz[e]);
            ow[e] = cvt_pk_bf16(lo, hi);
        }
        Y[i] = (u32x4){ow[0], ow[1], ow[2], ow[3]};
    }
}

typedef const __attribute__((address_space(4))) Args* KArgs;
#define LOADARGS(name) Args name; { KArgs _k = kp; asm volatile("" : "+s"(_k)); name = *_k; }

__global__ void __launch_bounds__(NTHR, 2) fwd_megakernel(Args args_unused) {
#if defined(__HIP_DEVICE_COMPILE__)
    extern __shared__ __attribute__((aligned(16))) unsigned char lds_raw[];
    LAS unsigned char* lds = (LAS unsigned char*)lds_raw;
    KArgs kp = (KArgs)__builtin_amdgcn_kernarg_segment_ptr();
    const int G = gridDim.x, bx = blockIdx.x;
    {
        const int tid = threadIdx.x;
        volatile LAS unsigned* MISC0 = (volatile LAS unsigned*)(lds + MISC_OFF);
        if (tid < 64) MISC0[tid] = 0u;
        __syncthreads();
    }
    { LOADARGS(a); (void)xcd_barrier_post((unsigned*)(a.ws + WS_CTL) + CW_BAR, (volatile LAS unsigned*)(lds + MISC_OFF) + 8); }
#define GRID_BAR() do { LOADARGS(a_); XcdBarrier b_; b_.bar = (unsigned*)(a_.ws + WS_CTL) + CW_BAR; b_.x = xb_xcc_id(); b_.st = (volatile LAS unsigned*)(lds + MISC_OFF) + 8; xcd_barrier(b_); } while (0)
#define THREAD_IDS() int tid = threadIdx.x; asm volatile("" : "+v"(tid)); const int lane = tid & 63, wave = __builtin_amdgcn_readfirstlane(tid >> 6); \
    const int vcu = (G % 8 == 0) ? (bx % 8) * (G / 8) + bx / 8 : bx; const int gw = vcu * NWAVES + wave, NGW = G * NWAVES, gtid = vcu * NTHR + tid, NGT = G * NTHR; (void)lane; (void)gw; (void)NGW; (void)gtid; (void)NGT;

#define FILL_RS(S_, ssq_) { THREAD_IDS(); (void)wave; \
        int pm_[4]; _Pragma("unroll") for (int q_ = 0; q_ < 4; ++q_) { pg8::Unit uu_; pm_[q_] = S_.next((tid >> 8) + 2 * q_, uu_) ? uu_.pm : -1; } \
        f32x4 sv_[4][4]; \
        _Pragma("unroll") for (int q_ = 0; q_ < 4; ++q_) { const f32x4* sp_ = (const f32x4*)((ssq_) + (size_t)((pm_[q_] < 0 ? 0 : pm_[q_]) * 256 + (tid & 255)) * 16); \
            _Pragma("unroll") for (int e_ = 0; e_ < 4; ++e_) sv_[q_][e_] = sp_[e_]; } \
        _Pragma("unroll") for (int q_ = 0; q_ < 4; ++q_) { float t_ = 0.f; _Pragma("unroll") for (int e_ = 0; e_ < 4; ++e_) t_ += (sv_[q_][e_].x + sv_[q_][e_].y) + (sv_[q_][e_].z + sv_[q_][e_].w); \
            if (pm_[q_] >= 0) ((LAS float*)(lds + RS_OFF))[((tid >> 8) + 2 * q_) * 256 + (tid & 255)] = rsqrtf(t_ * (1.f / 1024.f) + EPS); } \
        __syncthreads(); }
#define PH_PROLOGUE() { LOADARGS(a); THREAD_IDS(); prologue(a, lds, gw, NGW, lane, wave); }
#define PH_P1A(layer) { \
            { LOADARGS(a); unsigned char* ws = a.ws; \
              pg8::Gemm g{(const bf16_t*)(ws + WS_HB0), (const bf16_t*)(ws + WS_WINA) + (size_t)(layer) * 4096 * 1024, T, 4096, 1024}; \
              pg8::StaticOrder S; S.init(T, 4096, G, bx); \
              pg8::EpiP E{0, (const float*)(ws + WS_SSQ0), ws, nullptr, nullptr, lds}; \
              FILL_RS(S, (const float*)(ws + WS_SSQ0)); \
              pg8::gemm_phase<pg8::EpiP, pg8::StaticOrder, true, true>(lds + RING_OFF, g, S, E); } \
            { LOADARGS(a); THREAD_IDS(); gates_job(a, (layer), (const bf16_t*)(a.ws + WS_HB0), (const float*)(a.ws + WS_SSQ0), gw, NGW, lane); } \
            { LOADARGS(a); THREAD_IDS(); convert_p(a, (layer), gtid, NGT); } }
#define PH_CONV(layer) { LOADARGS(a); THREAD_IDS(); conv_phase(a, (layer), gtid, NGT, gw, NGW, lane); }
#if defined(PROBE_VARIANT) && PROBE_KIND == 2
#define PH_SCAN(layer) { LOADARGS(a); if (pass == 0 && r_ > 0) scan::phase<PROBE_VARIANT>(a, lds, (layer), G); else scan::phase<0>(a, lds, (layer), G); }
#else
#define PH_SCAN(layer) { LOADARGS(a); scan::phase<0>(a, lds, (layer), G); }
#endif
#define PH_NORM() { LOADARGS(a); THREAD_IDS(); mlstm_norm_phase(a, gtid, NGT); }
#define PH_P3A(layer) { \
              LOADARGS(a); unsigned char* ws = a.ws; \
              pg8::Gemm g{(const bf16_t*)(ws + WS_S2), (const bf16_t*)(ws + WS_WOUTA) + (size_t)(layer) * 1024 * 1024, T, 1024, 1024}; \
              pg8::StaticOrder S; S.init(T, 1024, G, bx); \
              LAS float* RT_ = (LAS float*)(lds + 131072); \
              { THREAD_IDS(); int bxl_ = bx; asm volatile("" : "+s"(bxl_)); pg8::StaticOrder S2_; S2_.init(T, 1024, G, bxl_); pg8::Unit u0_, u1_; const bool v0_ = S2_.next(0, u0_), v1_ = S2_.next(1, u1_); const int pm_ = (tid >> 8) ? u1_.pm : u0_.pm; if ((tid >> 8) ? v1_ : v0_) { const float* sp_ = (const float*)(ws + WS_SSQH) + (size_t)(pm_ * 256 + (tid & 255)) * 32; float r_[4]; \
                  _Pragma("unroll") for (int h_ = 0; h_ < 4; ++h_) { const f32x4 s0_ = *(const f32x4*)(sp_ + 8 * h_), s1_ = *(const f32x4*)(sp_ + 8 * h_ + 4); r_[h_] = rsqrtf((((s0_.x + s0_.y) + (s0_.z + s0_.w)) + ((s1_.x + s1_.y) + (s1_.z + s1_.w))) * (1.f / 256.f) + EPS); } \
                  *(LAS f32x4*)(RT_ + (size_t)tid * 4) = (f32x4){r_[0] / r_[1], r_[1] / r_[2], r_[2] / r_[3], r_[3]}; } \
                __syncthreads(); } \
              pg8::EpiF E{0, (const bf16_t*)(ws + WS_HB0), (bf16_t*)(ws + WS_HB1), (float*)(ws + WS_SSQ1), nullptr, nullptr, nullptr, lds}; \
              pg8::gemm_phase<pg8::EpiF, pg8::StaticOrder, true, true, true>(lds + RING_OFF, g, S, E, RT_); }
#define PH_P1B(jl, layer) { \
            { LOADARGS(a); unsigned char* ws = a.ws; \
              const int N = ((jl) == 0) ? 3072 : 2048; \
              pg8::Gemm g{(const bf16_t*)(ws + WS_HB0), (const bf16_t*)(ws + ((jl) == 0 ? WS_WINB0 : WS_WINB1)), T, N, 1024}; \
              pg8::StaticOrder S; S.init(T, N, G, bx); \
              pg8::EpiP E{1, (const float*)(ws + WS_SSQ0), ws, a.qnorm_b + (jl) * 128, a.knorm, lds}; \
              FILL_RS(S, (const float*)(ws + WS_SSQ0)); \
              pg8::gemm_phase<pg8::EpiP, pg8::StaticOrder, true, true>(lds + RING_OFF, g, S, E); } \
            { LOADARGS(a); THREAD_IDS(); convert_p(a, (layer), gtid, NGT); } }
#if defined(PROBE_VARIANT) && PROBE_KIND == 3
#define PH_ATTN(jl) { LOADARGS(a); if (pass == 0 && r_ > 0) attn::phase<PROBE_VARIANT>(a, lds, (jl), G); else attn::phase<0>(a, lds, (jl), G); }
#else
#define PH_ATTN(jl) { LOADARGS(a); attn::phase<0>(a, lds, (jl), G); }
#endif
#define PH_COMBINE() { LOADARGS(a); THREAD_IDS(); attn_combine_phase(a, gtid, NGT); }
#define PH_P3B(jl) { \
              LOADARGS(a); unsigned char* ws = a.ws; \
              pg8::Gemm g{(const bf16_t*)(ws + WS_S3 + 32 * MiB), (const bf16_t*)(ws + WS_WOUTB) + (size_t)(jl) * 1024 * 512, T, 1024, 512}; \
              pg8::StaticOrder S; S.init(T, 1024, G, bx); \
              pg8::EpiF E{0, (const bf16_t*)(ws + WS_HB0), (bf16_t*)(ws + WS_HB1), (float*)(ws + WS_SSQ1), nullptr, nullptr, nullptr, lds}; \
              pg8::gemm_phase<pg8::EpiF, pg8::StaticOrder, true, true>(lds + RING_OFF, g, S, E); }
#define PH_PP(layer) { \
            LOADARGS(a); unsigned char* ws = a.ws; \
            pg8::Gemm g2{(const bf16_t*)(ws + WS_PB), (const bf16_t*)(ws + WS_WPLE) + (size_t)(layer) * 1024 * 256, T, 1024, 256}; \
            pg8::StaticOrder S; S.init(T, 1024, G, bx); \
            pg8::EpiP E2{2, nullptr, ws, nullptr, nullptr, lds}; \
            pg8::gemm_phase<pg8::EpiP, pg8::StaticOrder, true, true>(lds + RING_OFF, g2, S, E2); }
#define PH_P4(layer) { \
            LOADARGS(a); unsigned char* ws = a.ws; \
            pg8::Gemm g{(const bf16_t*)(ws + WS_HB1), (const bf16_t*)(ws + WS_WGATE) + (size_t)(layer) * 1024 * 1024, T, 1024, 1024}; \
            pg8::StaticOrder S; S.init(T, 1024, G, bx); \
            pg8::EpiF E{1, (const bf16_t*)(ws + WS_HB1), (bf16_t*)(ws + WS_HB0), (float*)(ws + WS_SSQ0), (const float*)(ws + WS_SSQ1), (const bf16_t*)(ws + WS_S1), ((layer) == DEPTH - 1) ? a.out : nullptr, lds}; \
            FILL_RS(S, (const float*)(ws + WS_SSQ1)); \
            pg8::gemm_phase<pg8::EpiF, pg8::StaticOrder, true, true>(lds + RING_OFF, g, S, E); }

#if defined(PROBE_KIND)
#define REP(kind) _Pragma("nounroll") for (int r_ = 0; r_ < ((PROBE_KIND == (kind) && pass == 0) ? PROBE_REPS : 1); ++r_)
#define LASTBAR() GRID_BAR()
#pragma nounroll
    for (int pass = 0; pass < 2; ++pass) {
#else
#define REP(kind)
#define LASTBAR() if (layer < DEPTH - 1) GRID_BAR()
    {
#endif
    REP(1) { PH_PROLOGUE(); GRID_BAR(); }
#define LAYER_A(layer) { \
        REP(4) { PH_P1A(layer); GRID_BAR(); } \
        REP(12) { PH_CONV(layer); GRID_BAR(); } \
        REP(2) { PH_SCAN(layer); GRID_BAR(); } \
        REP(9) { PH_P3A(layer); } \
        REP(8) { PH_PP(layer); } \
        GRID_BAR(); \
        REP(5) { PH_P4(layer); GRID_BAR(); } }
#define LAYER_B(jl, layer, last) { \
        REP(11) { PH_P1B(jl, layer); GRID_BAR(); } \
        REP(3) { PH_ATTN(jl); GRID_BAR(); } \
        REP(7) { PH_COMBINE(); GRID_BAR(); } \
        REP(10) { PH_P3B(jl); } \
        REP(8) { PH_PP(layer); } \
        GRID_BAR(); \
        REP(5) { PH_P4(layer); if (!(last)) GRID_BAR(); } }
    LAYER_A(0);
    LAYER_A(1);
    LAYER_B(0, 2, false);
#if defined(PROBE_KIND)
    LAYER_B(1, 3, false);
#else
    LAYER_B(1, 3, true);
#endif
    }
#endif
}

extern "C" void kernel_launch(void* const* d_in, const int* in_sizes, int n_in, void* d_out, int out_size, void* d_ws, size_t ws_size, hipStream_t stream) {
    static int grid = 0;
    if (grid == 0) {
        if (n_in != 18 || in_sizes[0] != T * D || out_size != T * D || ws_size < WS_END) { fprintf(stderr, "kernel_launch: unexpected shapes (n_in %d, in0 %d, out %d, ws %zu)\n", n_in, n_in > 0 ? in_sizes[0] : -1, out_size, ws_size); grid = -1; return; }
        int dev = 0, cus = 0, per_cu = 0;
        if (hipGetDevice(&dev) != hipSuccess || hipDeviceGetAttribute(&cus, hipDeviceAttributeMultiprocessorCount, dev) != hipSuccess) { fprintf(stderr, "kernel_launch: device query failed\n"); grid = -1; return; }
        if (hipFuncSetAttribute((const void*)fwd_megakernel, hipFuncAttributeMaxDynamicSharedMemorySize, LDS_BYTES) != hipSuccess) { fprintf(stderr, "kernel_launch: hipFuncSetAttribute failed\n"); grid = -1; return; }
        if (hipOccupancyMaxActiveBlocksPerMultiprocessor(&per_cu, (const void*)fwd_megakernel, NTHR, LDS_BYTES) != hipSuccess || per_cu < 1)
            fprintf(stderr, "kernel_launch: note: occupancy query reports %d workgroups per CU\n", per_cu);
        (void)hipGetLastError();
        grid = cus;
        if (grid > 256) grid = 256;
    }
    if (grid < 0) return;
    if (hipMemsetAsync((char*)d_ws + WS_CTL, 0, CTL_ZERO_BYTES, stream) != hipSuccess) { fprintf(stderr, "kernel_launch: memset failed\n"); return; }
    Args a{};
    a.x = (const float*)d_in[0]; a.p = (const float*)d_in[1]; a.norm_a = (const float*)d_in[2]; a.w_in_a = (const float*)d_in[3]; a.conv_a = (const float*)d_in[4];
    a.b_gate_a = (const float*)d_in[5]; a.hnorm_a = (const float*)d_in[6]; a.w_out_a = (const float*)d_in[7]; a.norm_kv = (const float*)d_in[8]; a.w_kv = (const float*)d_in[9];
    a.knorm = (const float*)d_in[10]; a.norm_b = (const float*)d_in[11]; a.w_in_b = (const float*)d_in[12]; a.qnorm_b = (const float*)d_in[13]; a.w_out_b = (const float*)d_in[14];
    a.ple_norm = (const float*)d_in[15]; a.w_ple_gate = (const float*)d_in[16]; a.w_ple = (const float*)d_in[17];
    a.out = (float*)d_out; a.ws = (unsigned char*)d_ws;
    hipLaunchKernelGGL(fwd_megakernel, dim3(grid), dim3(NTHR), LDS_BYTES, stream, a);
    const hipError_t le = hipPeekAtLastError();
    if (le != hipSuccess) fprintf(stderr, "kernel_launch: launch failed: %s\n", hipGetErrorName(le));
}
```

```cpp
#include <hip/hip_runtime.h>
#include <cstdio>
#include <cstdint>

#define LAS __attribute__((address_space(3)))
#define GAS __attribute__((address_space(1)))
typedef unsigned short bf16_t;
typedef short bf16x8 __attribute__((ext_vector_type(8)));
typedef float f32x4 __attribute__((ext_vector_type(4)));
typedef unsigned u32x4 __attribute__((ext_vector_type(4)));
typedef unsigned u32x2 __attribute__((ext_vector_type(2)));

constexpr int BATCH = 8, SEQ = 4096, T = BATCH * SEQ, D = 1024, DEPTH = 4, PLE = 256;
constexpr int A_COLS = 4104;
constexpr float EPS = 1e-6f;

typedef __bf16 bf16x2_t __attribute__((ext_vector_type(2)));
typedef float f32x2_t __attribute__((ext_vector_type(2)));
__device__ __forceinline__ unsigned cvt_pk_bf16(float lo, float hi) { const f32x2_t v = {lo, hi}; return __builtin_bit_cast(unsigned, __builtin_convertvector(v, bf16x2_t)); }
__device__ __forceinline__ float bf_lo(unsigned w) { return __uint_as_float(w << 16); }
__device__ __forceinline__ float bf_hi(unsigned w) { return __uint_as_float(w & 0xffff0000u); }
__device__ __forceinline__ float bf2f(bf16_t b) { return __uint_as_float(((unsigned)b) << 16); }
__device__ __forceinline__ bf16_t f2bf(float f) { return (bf16_t)(cvt_pk_bf16(f, 0.f) & 0xffffu); }
__device__ __forceinline__ float sigmoidf_(float x) { return __builtin_amdgcn_rcpf(1.f + __expf(-x)); }
__device__ __forceinline__ float ssq16_rstd(const float* ssq, int row) {
    const f32x4* p = (const f32x4*)(ssq + (size_t)row * 16);
    const f32x4 a = p[0], b = p[1], c = p[2], d = p[3];
    const float s = ((a.x + a.y) + (a.z + a.w)) + ((b.x + b.y) + (b.z + b.w)) + ((c.x + c.y) + (c.z + c.w)) + ((d.x + d.y) + (d.z + d.w));
    return rsqrtf(s * (1.f / 1024.f) + EPS);
}

constexpr int RS_OFF = 139264;

constexpr size_t WS_S0_ = (size_t)208 << 20, WS_S1_ = (size_t)272 << 20, WS_S2_ = (size_t)336 << 20, WS_S3_ = (size_t)400 << 20;
namespace pg8 {
#define PG8_LAS __attribute__((address_space(3)))
constexpr int BM = 256, BK = 64, HALF = 128, HTB = HALF * BK * 2, STAGE_BYTES = 8 * HTB, NXCD = 8, WGM = 8;
__host__ __device__ __forceinline__ int lds_byte(int r, int c) { const int st = (r >> 4) * 2 + (c >> 5), rr = r & 15, cc = c & 31, ob = rr * 64 + cc * 2; return st * 1024 + (ob ^ (((ob >> 9) & 1) << 5)); }
__host__ __device__ __forceinline__ void stage_rc(int b, int& R, int& C) { const int st = b / 1024, sb = b % 1024, swz = sb ^ (((sb >> 9) & 1) << 5); R = (st >> 1) * 16 + swz / 64; C = (st & 1) * 32 + (swz % 64) / 2; }
__host__ __device__ __forceinline__ int perm32(int rho) { const int n = rho >> 4, i = rho & 15; return 8 * (i >> 2) + 4 * n + (i & 3); }

struct Unit { int pm, pn, idx; };
struct Gemm { const bf16_t* A; const bf16_t* Bt; int M, N, K; };
struct StaticOrder {
    int nM, nN, nwg, G, c;
    __host__ __device__ void init(int M, int N, int G_, int c_) { nM = M / BM; nN = N / BM; nwg = nM * nN; G = G_; c = c_; }
    __host__ __device__ __forceinline__ bool next(int i, Unit& u) const {
        const long L = (long)i * G + c; if (L >= nwg) return false;
        int wgid = (int)L; { const int q = nwg / NXCD, r = nwg % NXCD, xcd = wgid % NXCD, off = wgid / NXCD; wgid = (xcd < r ? xcd * (q + 1) : r * (q + 1) + (xcd - r) * q) + off; }
        const int nig = WGM * nN, gid = wgid / nig, fm = gid * WGM, gsz = (nM - fm) < WGM ? (nM - fm) : WGM;
        u.pm = fm + ((wgid % nig) % gsz); u.pn = (wgid % nig) / gsz; return true;
    }
    __device__ __forceinline__ void a_ready(const Unit&) const {}
    __device__ __forceinline__ void done(const Unit&) const {}
};


struct EpiP {
    static constexpr bool PERM = true, AFTER_DRAIN = false;
    int mode; const float* ssq; unsigned char* ws; const float* qg; const float* kg; PG8_LAS unsigned char* lds;
    __device__ __forceinline__ void operator()(const f32x4 (&acc)[2][2][4][2], const Unit& u, int wr, int wc, int fr, int fq) const {
        const int row0 = u.pm * BM + wr * 64 + fr;
        size_t boff; int ldc, colt, act = 0;
        if (mode == 0) { const int ten = u.pn >> 2; boff = WS_S0_ + (size_t)ten * (64u << 20); ldc = 1024; colt = (u.pn & 3) * 256; act = ten == 2 ? 1 : ten == 3 ? 2 : 0; }
        else if (mode == 1) {
            if (u.pn < 6) { boff = WS_S1_; ldc = 1536; colt = u.pn * 256; act = 3; }
            else if (u.pn < 8) { boff = WS_S3_; ldc = 512; colt = (u.pn - 6) * 256; act = 2; }
            else if (u.pn < 10) { boff = WS_S0_; ldc = 512; colt = (u.pn - 8) * 256; act = 3; }
            else { boff = WS_S0_ + (32u << 20); ldc = 512; colt = (u.pn - 10) * 256; }
        } else { boff = WS_S1_; ldc = 1024; colt = u.pn * 256; }
        bf16_t* base = (bf16_t*)(ws + boff);
        if (act == 3) {
            PG8_LAS float* X = (PG8_LAS float*)(lds + 131072);
            const float* gn = (u.pn < 6) ? qg : kg;
            const float* COS = (const float*)(ws + ((size_t)2 << 20)); const float* SIN = (const float*)(ws + ((size_t)3 << 20));
#pragma unroll
            for (int ai = 0; ai < 2; ++ai)
#pragma unroll
                for (int m = 0; m < 4; ++m) {
                    const int rl = ai * HALF + wr * 64 + m * 16 + fr;
                    const float rs = ((const PG8_LAS float*)(lds + RS_OFF))[(u.idx & 7) * 256 + rl];
#pragma unroll
                    for (int bj = 0; bj < 2; ++bj) {
                        const f32x4 v0 = acc[ai][bj][m][0] * rs, v1 = acc[ai][bj][m][1] * rs;
                        float sq = (v0[0] * v0[0] + v0[1] * v0[1]) + (v0[2] * v0[2] + v0[3] * v0[3]) + (v1[0] * v1[0] + v1[1] * v1[1]) + (v1[2] * v1[2] + v1[3] * v1[3]);
                        sq += __shfl_xor(sq, 16); sq += __shfl_xor(sq, 32);
                        if (fq == 0) X[(rl * 2 + bj) * 4 + wc] = sq;
                    }
                }
            asm volatile("s_waitcnt lgkmcnt(0)" ::: "memory"); __builtin_amdgcn_s_barrier(); asm volatile("" ::: "memory");
            const int d0 = 16 * wc + 4 * fq;
            const f32x4 g1 = *(const f32x4*)(gn + d0), g2 = *(const f32x4*)(gn + 64 + d0);
            f32x4 csb[2], snb[2];
            { const int pos0 = (u.pm * BM + wr * 64 + fr) & (SEQ - 1); csb[0] = *(const f32x4*)(COS + pos0 * 64 + d0); snb[0] = *(const f32x4*)(SIN + pos0 * 64 + d0); }
#pragma unroll
            for (int g = 0; g < 8; ++g) {
                const int ai = g >> 2, m = g & 3, cb = g & 1, nb = cb ^ 1;
                const int rl = ai * HALF + wr * 64 + m * 16 + fr, row = u.pm * BM + rl;
                if (g < 7) { const int g1i = g + 1, pos1 = (u.pm * BM + (g1i >> 2) * HALF + wr * 64 + (g1i & 3) * 16 + fr) & (SEQ - 1); csb[nb] = *(const f32x4*)(COS + pos1 * 64 + d0); snb[nb] = *(const f32x4*)(SIN + pos1 * 64 + d0); }
                const float rs = ((const PG8_LAS float*)(lds + RS_OFF))[(u.idx & 7) * 256 + rl];
                const f32x4 cs = csb[cb], sn = snb[cb];
#pragma unroll
                for (int bj = 0; bj < 2; ++bj) {
                    const f32x4 xs = *(const PG8_LAS f32x4*)(X + (rl * 2 + bj) * 4);
                    const float rh = rs * rsqrtf(((xs[0] + xs[1]) + (xs[2] + xs[3])) * (1.f / 128.f) + EPS);
                    const f32x4 x1 = acc[ai][bj][m][0] * rh * g1, x2 = acc[ai][bj][m][1] * rh * g2;
                    const f32x4 o1 = x1 * cs - x2 * sn, o2 = x2 * cs + x1 * sn;
                    bf16_t* p = base + (size_t)row * ldc + colt + bj * HALF + d0;
                    u32x2 w1, w2; w1.x = cvt_pk_bf16(o1[0], o1[1]); w1.y = cvt_pk_bf16(o1[2], o1[3]); w2.x = cvt_pk_bf16(o2[0], o2[1]); w2.y = cvt_pk_bf16(o2[2], o2[3]);
                    *(u32x2*)p = w1; *(u32x2*)(p + 64) = w2;
                }
            }
            return;
        }
        const int col0 = colt + wc * 32 + 8 * fq;
#pragma unroll
        for (int ai = 0; ai < 2; ++ai)
#pragma unroll
            for (int m = 0; m < 4; ++m) {
                const int row = row0 + ai * HALF + m * 16;
                const float rs = (mode == 2) ? 1.f : ((const PG8_LAS float*)(lds + RS_OFF))[(u.idx & 7) * 256 + ai * HALF + wr * 64 + m * 16 + fr];
                bf16_t* rowp = base + (size_t)row * ldc + col0;
#pragma unroll
                for (int bj = 0; bj < 2; ++bj) {
                    f32x4 v0 = acc[ai][bj][m][0] * rs, v1 = acc[ai][bj][m][1] * rs;
                    if (act == 1) {
#pragma unroll
                        for (int j = 0; j < 4; ++j) { v0[j] = sigmoidf_(v0[j]); v1[j] = sigmoidf_(v1[j]); }
                    } else if (act == 2) {
#pragma unroll
                        for (int j = 0; j < 4; ++j) { v0[j] = v0[j] * sigmoidf_(v0[j]); v1[j] = v1[j] * sigmoidf_(v1[j]); }
                    }
                    u32x4 w; w.x = cvt_pk_bf16(v0[0], v0[1]); w.y = cvt_pk_bf16(v0[2], v0[3]); w.z = cvt_pk_bf16(v1[0], v1[1]); w.w = cvt_pk_bf16(v1[2], v1[3]);
                    *(u32x4*)(rowp + bj * HALF) = w;
                }
                asm volatile("" ::: "memory");
            }
    }
};
struct EpiF {
    static constexpr bool PERM = true, AFTER_DRAIN = false;
    int mode; const bf16_t* hres; bf16_t* hb; float* ssq_out; const float* ssq_in; const bf16_t* pp; float* fout; PG8_LAS unsigned char* lds;
    __device__ __forceinline__ void operator()(const f32x4 (&acc)[2][2][4][2], const Unit& u, int wr, int wc, int fr, int fq) const {
        const int row0 = u.pm * BM + wr * 64 + fr, col0 = u.pn * BM + wc * 32 + 8 * fq;
        const PG8_LAS float* rst = (const PG8_LAS float*)(lds + RS_OFF) + (u.idx & 7) * 256 + wr * 64 + fr;
        u32x4 hw[2][2], pw[2][2];
        { const size_t o = (size_t)row0 * 1024 + col0; hw[0][0] = *(const u32x4*)(hres + o); hw[0][1] = *(const u32x4*)(hres + o + HALF);
          if (mode == 1) { pw[0][0] = *(const u32x4*)(pp + o); pw[0][1] = *(const u32x4*)(pp + o + HALF); } }
#pragma unroll
        for (int g = 0; g < 8; ++g) {
            const int ai = g >> 2, m = g & 3, cb = g & 1, nb = cb ^ 1;
            const int row = row0 + ai * HALF + m * 16;
            const size_t off = (size_t)row * 1024 + col0;
            if (g < 7) { const int g1 = g + 1; const size_t o = (size_t)(row0 + (g1 >> 2) * HALF + (g1 & 3) * 16) * 1024 + col0;
                hw[nb][0] = *(const u32x4*)(hres + o); hw[nb][1] = *(const u32x4*)(hres + o + HALF);
                if (mode == 1) { pw[nb][0] = *(const u32x4*)(pp + o); pw[nb][1] = *(const u32x4*)(pp + o + HALF); } }
            float rs = 1.f; if (mode == 1) rs = rst[ai * HALF + m * 16];
            float sq = 0.f;
#pragma unroll
            for (int bj = 0; bj < 2; ++bj) {
                const size_t o = off + bj * HALF;
                const u32x4 h_ = hw[cb][bj];
                f32x4 v0 = acc[ai][bj][m][0], v1 = acc[ai][bj][m][1];
                if (mode == 1) {
                    const u32x4 p_ = pw[cb][bj];
                    v0[0] = bf_lo(p_.x) * sigmoidf_(v0[0] * rs); v0[1] = bf_hi(p_.x) * sigmoidf_(v0[1] * rs); v0[2] = bf_lo(p_.y) * sigmoidf_(v0[2] * rs); v0[3] = bf_hi(p_.y) * sigmoidf_(v0[3] * rs);
                    v1[0] = bf_lo(p_.z) * sigmoidf_(v1[0] * rs); v1[1] = bf_hi(p_.z) * sigmoidf_(v1[1] * rs); v1[2] = bf_lo(p_.w) * sigmoidf_(v1[2] * rs); v1[3] = bf_hi(p_.w) * sigmoidf_(v1[3] * rs);
                }
                f32x4 h0, h1;
                h0[0] = bf_lo(h_.x) + v0[0]; h0[1] = bf_hi(h_.x) + v0[1]; h0[2] = bf_lo(h_.y) + v0[2]; h0[3] = bf_hi(h_.y) + v0[3];
                h1[0] = bf_lo(h_.z) + v1[0]; h1[1] = bf_hi(h_.z) + v1[1]; h1[2] = bf_lo(h_.w) + v1[2]; h1[3] = bf_hi(h_.w) + v1[3];
                if (fout) { *(f32x4*)(fout + o) = h0; *(f32x4*)(fout + o + 4) = h1; }
                else { u32x4 w; w.x = cvt_pk_bf16(h0[0], h0[1]); w.y = cvt_pk_bf16(h0[2], h0[3]); w.z = cvt_pk_bf16(h1[0], h1[1]); w.w = cvt_pk_bf16(h1[2], h1[3]); *(u32x4*)(hb + o) = w; }
                sq += ((h0[0] * h0[0] + h0[1] * h0[1]) + (h0[2] * h0[2] + h0[3] * h0[3])) + ((h1[0] * h1[0] + h1[1] * h1[1]) + (h1[2] * h1[2] + h1[3] * h1[3]));
            }
            sq += __shfl_xor(sq, 16); sq += __shfl_xor(sq, 32);
            if (fq == 0 && !fout) ssq_out[(size_t)row * 16 + u.pn * 4 + wc] = sq;
        }
    }
};

template <class Epi, class Sched, bool ALIGN_EPI = false, bool SP2 = false, bool HS = false>
__device__ __forceinline__ void gemm_phase(PG8_LAS unsigned char* lds, const Gemm g, const Sched& S, const Epi& E, const PG8_LAS float* rt = nullptr) {
    int tid = threadIdx.x; asm volatile("" : "+v"(tid));
    const int wid = __builtin_amdgcn_readfirstlane(tid >> 6), lane = tid & 63, wr = wid >> 2, wc = wid & 3, fr = lane & 15, fq = lane >> 4;
    const int K = g.K, nt = HS ? 4 : K / BK;
    unsigned voffA[2], voffB[2];
#pragma unroll
    for (int i = 0; i < 2; ++i) { int R, C; stage_rc(tid * 16 + i * 8192, R, C); const int Rb = Epi::PERM ? ((R & ~31) + perm32(R & 31)) : R;
        voffA[i] = (unsigned)(R * K + C) * 2u; voffB[i] = (unsigned)(Rb * K + C) * 2u; }
    const size_t kstep = (size_t)(BK * 2);
    const size_t hstep = (size_t)HALF * K * 2;
    const size_t tstep = 2 * hstep;
    const unsigned ldsw = (unsigned)wid * 1024u;
    const int aoff = lds_byte(wr * 64 + fr, fq * 8), boff = lds_byte(wc * 32 + fr, fq * 8);
#define PG8_SA(b, h) (((b) * 2 + (h)) * HTB)
#define PG8_SB(b, h) ((4 + (b) * 2 + (h)) * HTB)
#define PG8_STAGE(bufoff, gbase, voff) do { _Pragma("unroll") for (int _i = 0; _i < 2; ++_i) \
        __builtin_amdgcn_global_load_lds((const unsigned*)((const char*)(gbase) + (voff)[_i]), (PG8_LAS unsigned*)(lds + (bufoff) + ldsw + _i * 8192), 16, 0, 0); } while (0)
#define PG8_LDA(dst, b, h) do { _Pragma("unroll") for (int m = 0; m < 4; ++m) _Pragma("unroll") for (int k = 0; k < 2; ++k) dst[m][k] = *(const PG8_LAS bf16x8*)(lds + PG8_SA(b, h) + aoff + m * 2048 + k * 1024); } while (0)
#define PG8_LDB(dst, b, h) do { _Pragma("unroll") for (int n = 0; n < 2; ++n) _Pragma("unroll") for (int k = 0; k < 2; ++k) dst[n][k] = *(const PG8_LAS bf16x8*)(lds + PG8_SB(b, h) + boff + n * 2048 + k * 1024); } while (0)
#define PG8_MMA(ai, bj, At, Bt) do { __builtin_amdgcn_s_setprio(1); _Pragma("unroll") for (int m = 0; m < 4; ++m) _Pragma("unroll") for (int n = 0; n < 2; ++n) _Pragma("unroll") for (int k = 0; k < 2; ++k) \
        acc[ai][bj][m][n] = __builtin_amdgcn_mfma_f32_16x16x32_bf16(Bt[n][k], At[m][k], acc[ai][bj][m][n], 0, 0, 0); __builtin_amdgcn_s_setprio(0); } while (0)
#define PG8_RESCALE(hsel) do { int lz_ = lane; asm volatile("" : "+v"(lz_));   \
        const PG8_LAS float* rp_ = rt + ((ui >> 2) & 1) * 1024 + (wr * 64 + (lz_ & 15)) * 4 + (hsel); \
        _Pragma("unroll") for (int ai_ = 0; ai_ < 2; ++ai_) _Pragma("unroll") for (int m_ = 0; m_ < 4; ++m_) { const float f_ = rp_[(ai_ * HALF + m_ * 16) * 4]; \
            _Pragma("unroll") for (int bj_ = 0; bj_ < 2; ++bj_) { acc[ai_][bj_][m_][0] = acc[ai_][bj_][m_][0] * f_; acc[ai_][bj_][m_][1] = acc[ai_][bj_][m_][1] * f_; } } } while (0)
#define PG8_WAIT_V(n) asm volatile("s_waitcnt vmcnt(" #n ")" ::: "memory")
#define PG8_WAIT_L(n) asm volatile("s_waitcnt lgkmcnt(" #n ")" ::: "memory")
#define PG8_BAR __builtin_amdgcn_s_barrier()
#define PG8_SCHED __builtin_amdgcn_sched_barrier(0)
    Unit cur, nxt; int ui = 0;
    if (!S.next(0, cur)) return;
    cur.idx = 0;
    constexpr size_t HSTEP = 512;
    f32x4 acc[2][2][4][2];
#pragma unroll
    for (int a = 0; a < 2; ++a)
#pragma unroll
        for (int b = 0; b < 2; ++b)
#pragma unroll
            for (int m = 0; m < 4; ++m)
#pragma unroll
                for (int n = 0; n < 2; ++n) acc[a][b][m][n] = (f32x4){0.f, 0.f, 0.f, 0.f};
    bf16x8 At[4][2], B0[2][2], B1[2][2];
    const char* cA = (const char*)g.A + (size_t)cur.pm * tstep; const char* cB = (const char*)g.Bt + (size_t)cur.pn * tstep;
    S.a_ready(cur);
    if constexpr (SP2) {
        PG8_STAGE(PG8_SB(0, 0), cB, voffB); PG8_STAGE(PG8_SB(0, 1), cB + hstep, voffB); PG8_STAGE(PG8_SA(0, 0), cA, voffA); PG8_STAGE(PG8_SA(0, 1), cA + hstep, voffA);
        if (wr == 1) PG8_BAR;
        PG8_WAIT_V(2); PG8_BAR;
        PG8_STAGE(PG8_SB(1, 0), cB + kstep, voffB); PG8_STAGE(PG8_SA(1, 0), cA + kstep, voffA); PG8_STAGE(PG8_SB(1, 1), cB + hstep + kstep, voffB);
        PG8_WAIT_V(6); PG8_BAR;
    } else {
        PG8_STAGE(PG8_SB(0, 0), cB, voffB); PG8_STAGE(PG8_SA(0, 0), cA, voffA); PG8_STAGE(PG8_SB(0, 1), cB + hstep, voffB); PG8_STAGE(PG8_SA(0, 1), cA + hstep, voffA);
        if (wr == 1) PG8_BAR;
        PG8_WAIT_V(4); PG8_BAR;
        PG8_STAGE(PG8_SB(1, 0), cB + kstep, voffB); PG8_STAGE(PG8_SA(1, 0), cA + kstep, voffA); PG8_STAGE(PG8_SB(1, 1), cB + hstep + kstep, voffB);
        PG8_WAIT_V(6); PG8_BAR;
    }
    for (;;) {
        const bool has_next = S.next(HS ? ((ui + 1) >> 2) : (ui + 1), nxt); nxt.idx = HS ? ((ui + 1) >> 2) : (ui + 1);
        const size_t nko = HS ? (size_t)((ui + 1) & 3) * HSTEP : 0;
        const char* nA = has_next ? (const char*)g.A + (size_t)nxt.pm * tstep + nko : cA; const char* nB = has_next ? (const char*)g.Bt + (size_t)nxt.pn * tstep + nko : cB;
#pragma nounroll
        for (int t = 0; t < nt; t += 2) {
            const bool last = (t == nt - 2);
            const char* a1 = cA + (size_t)(t + 1) * kstep;
            const char* a2 = last ? nA : cA + (size_t)(t + 2) * kstep; const char* b2 = last ? nB : cB + (size_t)(t + 2) * kstep;
            const char* a3 = a2 + kstep; const char* b3 = b2 + kstep;
            if (last && has_next) S.a_ready(nxt);
            if constexpr (SP2) {
            PG8_LDB(B0, 0, 0); PG8_LDB(B1, 0, 1); PG8_SCHED; PG8_LDA(At, 0, 0); PG8_STAGE(PG8_SA(1, 1), a1 + hstep, voffA);
            PG8_WAIT_V(8); PG8_WAIT_L(0); PG8_BAR; PG8_MMA(0, 0, At, B0); PG8_MMA(0, 1, At, B1); PG8_BAR; PG8_SCHED;
            PG8_LDA(At, 0, 1); PG8_STAGE(PG8_SB(0, 0), b2, voffB); PG8_STAGE(PG8_SB(0, 1), b2 + hstep, voffB); PG8_STAGE(PG8_SA(0, 0), a2, voffA);
            PG8_WAIT_V(8); PG8_WAIT_L(0); PG8_BAR; PG8_MMA(1, 0, At, B0); PG8_MMA(1, 1, At, B1); PG8_BAR; PG8_SCHED;
            PG8_LDB(B0, 1, 0); PG8_LDB(B1, 1, 1); PG8_SCHED; PG8_LDA(At, 1, 0); PG8_STAGE(PG8_SA(0, 1), a2 + hstep, voffA);
            PG8_WAIT_V(8); PG8_WAIT_L(0); PG8_BAR; PG8_MMA(0, 0, At, B0); PG8_MMA(0, 1, At, B1); PG8_BAR; PG8_SCHED;
            PG8_LDA(At, 1, 1); PG8_STAGE(PG8_SB(1, 0), b3, voffB); PG8_STAGE(PG8_SB(1, 1), b3 + hstep, voffB); PG8_STAGE(PG8_SA(1, 0), a3, voffA);
            PG8_WAIT_V(8); PG8_WAIT_L(0); PG8_BAR; PG8_MMA(1, 0, At, B0); PG8_MMA(1, 1, At, B1); PG8_BAR; PG8_SCHED;
            } else {
            PG8_LDB(B0, 0, 0); PG8_SCHED; PG8_LDA(At, 0, 0); PG8_STAGE(PG8_SA(1, 1), a1 + hstep, voffA);
            PG8_WAIT_L(8); PG8_BAR; PG8_WAIT_L(0); PG8_MMA(0, 0, At, B0); PG8_BAR; PG8_SCHED;
            PG8_LDB(B1, 0, 1); PG8_STAGE(PG8_SB(0, 0), b2, voffB);
            PG8_BAR; PG8_WAIT_L(0); PG8_MMA(0, 1, At, B1); PG8_BAR;
            PG8_LDA(At, 0, 1); PG8_STAGE(PG8_SA(0, 0), a2, voffA);
            PG8_BAR; PG8_WAIT_L(0); PG8_MMA(1, 0, At, B0); PG8_BAR; PG8_SCHED;
            PG8_STAGE(PG8_SB(0, 1), b2 + hstep, voffB);
            PG8_WAIT_V(6); PG8_BAR; PG8_MMA(1, 1, At, B1); PG8_BAR;
            PG8_LDB(B0, 1, 0); PG8_SCHED; PG8_LDA(At, 1, 0); PG8_STAGE(PG8_SA(0, 1), a2 + hstep, voffA);
            PG8_WAIT_L(8); PG8_BAR; PG8_WAIT_L(0); PG8_MMA(0, 0, At, B0); PG8_BAR; PG8_SCHED;
            PG8_LDB(B1, 1, 1); PG8_STAGE(PG8_SB(1, 0), b3, voffB);
            PG8_BAR; PG8_WAIT_L(0); PG8_MMA(0, 1, At, B1); PG8_BAR;
            PG8_LDA(At, 1, 1); PG8_STAGE(PG8_SA(1, 0), a3, voffA);
            PG8_BAR; PG8_WAIT_L(0); PG8_MMA(1, 0, At, B0); PG8_BAR; PG8_SCHED;
            PG8_STAGE(PG8_SB(1, 1), b3 + hstep, voffB);
            PG8_WAIT_V(6); PG8_BAR; PG8_MMA(1, 1, At, B1); PG8_BAR;
            }
        }
        if constexpr (HS) { PG8_RESCALE(ui & 3); }
        const bool tile_done = !HS || (ui & 3) == 3;
        if (tile_done) {
        if constexpr (ALIGN_EPI) { if (wr == 0) PG8_BAR; }
        if constexpr (!Epi::AFTER_DRAIN) { E(acc, cur, wr, wc, fr, fq); S.done(cur); }
        }
        if (!has_next) break;
        if (tile_done) {
#pragma unroll
        for (int a = 0; a < 2; ++a)
#pragma unroll
            for (int b = 0; b < 2; ++b)
#pragma unroll
                for (int m = 0; m < 4; ++m)
#pragma unroll
                    for (int n = 0; n < 2; ++n) acc[a][b][m][n] = (f32x4){0.f, 0.f, 0.f, 0.f};
        }
        cur = nxt; cA = nA; cB = nB; ++ui;
        if (tile_done) { if constexpr (ALIGN_EPI) { if (wr == 1) PG8_BAR; } }
    }
    PG8_WAIT_V(0);
    if constexpr (!ALIGN_EPI) { if (wr == 0) PG8_BAR; }
    PG8_BAR;
#undef PG8_SA
#undef PG8_SB
#undef PG8_STAGE
#undef PG8_LDA
#undef PG8_LDB
#undef PG8_MMA
#undef PG8_WAIT_V
#undef PG8_RESCALE
#undef PG8_WAIT_L
#undef PG8_BAR
#undef PG8_SCHED
}
}

constexpr size_t MiB = 1u << 20;
constexpr size_t WS_CTL = 0, CTL_ZERO_BYTES = 1 * MiB;
constexpr size_t WS_COS = 2 * MiB, WS_SIN = 3 * MiB;
constexpr size_t WS_WG8 = 4 * MiB;
constexpr size_t WS_GATES = 5 * MiB;
constexpr size_t WS_LSE = 6 * MiB;
constexpr size_t WS_SSQ0 = 8 * MiB, WS_SSQ1 = 10 * MiB;
constexpr size_t WS_SSQH = 12 * MiB;
constexpr size_t WS_WINA = 16 * MiB;
constexpr size_t WS_WOUTA = 32 * MiB;
constexpr size_t WS_WINB0 = 36 * MiB;
constexpr size_t WS_WINB1 = 42 * MiB;
constexpr size_t WS_WOUTB = 46 * MiB;
constexpr size_t WS_WGATE = 48 * MiB;
constexpr size_t WS_WPLE = 56 * MiB;
constexpr size_t WS_HB0 = 64 * MiB, WS_HB1 = 128 * MiB;
constexpr size_t WS_PB = 192 * MiB;
constexpr size_t WS_S0 = WS_S0_, WS_S1 = WS_S1_, WS_S2 = WS_S2_, WS_S3 = WS_S3_, WS_END = 464 * MiB;
constexpr int CW_BAR = 4096;

#define XB_TMO      128
#define XB_XCNT(j)  (256  + 64 * (j))
#define XB_XSUB(j)  (1280 + 64 * (j))
#define XB_XGEN(j)  (2304 + 64 * (j))
#define XB_TOP      3328
#define XB_TOPGEN   3392
#define XCD_BAR_WORDS 3456
#define XB_SPIN_CAP (1u << 18)
__device__ __forceinline__ unsigned xb_ld(unsigned* p)              { return __hip_atomic_load(p, __ATOMIC_RELAXED, __HIP_MEMORY_SCOPE_AGENT); }
__device__ __forceinline__ unsigned xb_add(unsigned* p, unsigned v) { return __hip_atomic_fetch_add(p, v, __ATOMIC_RELAXED, __HIP_MEMORY_SCOPE_AGENT); }
__device__ __forceinline__ unsigned xb_xcc_id() { return (unsigned)__builtin_amdgcn_s_getreg((3 << 11) | 20) & 0xFu; }
#define XB_SPIN(cond, bar) do { unsigned _sp = 0; while (cond) { __builtin_amdgcn_s_sleep(1); \
    if ((++_sp & 255u) == 0u) { if (xb_ld(&(bar)[XB_TMO])) break; if (_sp > XB_SPIN_CAP) { atomicAdd(&(bar)[XB_TMO], 1u); break; } } } } while (0)
struct XcdBarrier { unsigned* bar; unsigned x; volatile LAS unsigned* st; };
__device__ __forceinline__ XcdBarrier xcd_barrier_post(unsigned* bar, volatile LAS unsigned* st) {
    XcdBarrier b; b.bar = bar; b.x = xb_xcc_id(); b.st = st;
    if (threadIdx.x == 0) (void)xb_add(&bar[XB_XCNT(b.x)], 1u);
    return b;
}
__device__ __forceinline__ void xcd_barrier_complete(unsigned* bar, unsigned x, unsigned& nloc, unsigned& nx) {
    const unsigned G = gridDim.x * gridDim.y * gridDim.z;
    unsigned sum, cnt, mine, sp = 0u;
    for (;;) {
        sum = 0u; cnt = 0u; mine = 0u;
#pragma unroll
        for (unsigned j = 0; j < 16; ++j) { const unsigned c = xb_ld(&bar[XB_XCNT(j)]); sum += c; cnt += (c > 0u) ? 1u : 0u; mine = (j == x) ? c : mine; }
        if (sum == G) break;
        __builtin_amdgcn_s_sleep(1);
        if ((++sp & 255u) == 0u) { if (xb_ld(&bar[XB_TMO])) break; if (sp > XB_SPIN_CAP) { atomicAdd(&bar[XB_TMO], 1u); break; } }
    }
    nloc = mine > 0u ? mine : 1u; nx = cnt > 0u ? cnt : 1u;
}
__device__ __forceinline__ void xcd_barrier(const XcdBarrier& b) {
    asm volatile("s_waitcnt vmcnt(0)" ::: "memory");
    __syncthreads();
    if (threadIdx.x == 0) {
        unsigned* bar = b.bar;
        __builtin_amdgcn_s_waitcnt(0);
        unsigned nloc = b.st[0], nx = b.st[1];
        if (nloc == 0u) { xcd_barrier_complete(bar, b.x, nloc, nx); b.st[0] = nloc; b.st[1] = nx; }
        const unsigned old = xb_add(&bar[XB_XSUB(b.x)], 1u);
        const unsigned gen = old / nloc;
        if (old + 1u == (gen + 1u) * nloc) {
            __builtin_amdgcn_fence(__ATOMIC_RELEASE, "agent");
            asm volatile("s_waitcnt vmcnt(0)" ::: "memory");
            const unsigned og = xb_add(&bar[XB_TOP], 1u);
            const unsigned tg = og / nx;
            if (og + 1u == (tg + 1u) * nx) xb_add(&bar[XB_TOPGEN], 1u);
            else XB_SPIN(xb_ld(&bar[XB_TOPGEN]) == tg, bar);
            __builtin_amdgcn_fence(__ATOMIC_ACQUIRE, "agent");
            xb_add(&bar[XB_XGEN(b.x)], 1u);
            asm volatile("s_waitcnt vmcnt(0)" ::: "memory");
        } else {
            XB_SPIN(xb_ld(&bar[XB_XGEN(b.x)]) == gen, bar);
            __builtin_amdgcn_fence(__ATOMIC_ACQUIRE, "agent");
            asm volatile("s_waitcnt vmcnt(0)" ::: "memory");
        }
    }
    __syncthreads();
}

struct Args {
    const float* x; const float* p; const float* norm_a; const float* w_in_a; const float* conv_a; const float* b_gate_a; const float* hnorm_a; const float* w_out_a;
    const float* norm_kv; const float* w_kv; const float* knorm; const float* norm_b; const float* w_in_b; const float* qnorm_b; const float* w_out_b;
    const float* ple_norm; const float* w_ple_gate; const float* w_ple;
    float* out; unsigned char* ws;
};

constexpr int NWAVES = 8, NTHR = 512;
constexpr int RING_OFF = 0;
constexpr int MISC_OFF = 160 * 1024 - 256;
constexpr int LDS_BYTES = 160 * 1024;

#define LDS_WAIT() asm volatile("s_waitcnt lgkmcnt(0)" ::: "memory")
#define LDS_BARRIER() do { asm volatile("s_waitcnt lgkmcnt(0)" ::: "memory"); __builtin_amdgcn_s_barrier(); asm volatile("" ::: "memory"); } while (0)

__device__ __forceinline__ void transpose_item(const float* W, int K, int ldw, int ncol0, int nblk, const float* gain, bf16_t* WT, int row_off, int nperm, LAS float* scr, int item, int lane) {
    const int kb = item / nblk, nb = item % nblk, k0 = 64 * kb, n0 = 32 * nb;
    {
        const int kr = lane >> 3, n4 = (lane & 7) * 4;
        f32x4 wv[8]; float gv[8];
#pragma unroll
        for (int i = 0; i < 8; ++i) { wv[i] = *(const f32x4*)(W + (size_t)(k0 + 8 * i + kr) * ldw + ncol0 + n0 + n4); gv[i] = gain ? gain[k0 + 8 * i + kr] : 1.f; }
#pragma unroll
        for (int i = 0; i < 8; ++i) { LAS float* d = scr + (8 * i + kr) * 33 + n4; d[0] = wv[i].x * gv[i]; d[1] = wv[i].y * gv[i]; d[2] = wv[i].z * gv[i]; d[3] = wv[i].w * gv[i]; }
    }
    LDS_WAIT(); asm volatile("" ::: "memory");
    const int c = lane & 7;
#pragma unroll
    for (int j = 0; j < 4; ++j) { const int n = (lane >> 3) + 8 * j; const LAS float* s = scr + (8 * c) * 33 + n;
        u32x4 o; o.x = cvt_pk_bf16(s[0 * 33], s[1 * 33]); o.y = cvt_pk_bf16(s[2 * 33], s[3 * 33]); o.z = cvt_pk_bf16(s[4 * 33], s[5 * 33]); o.w = cvt_pk_bf16(s[6 * 33], s[7 * 33]);
        int col = n0 + n; if (col < nperm) { const int d = col & 127; col = (col & ~127) + 32 * ((d & 63) >> 4) + 8 * ((d >> 2) & 3) + 4 * (d >> 6) + (d & 3); }
        *(u32x4*)(WT + (size_t)(row_off + col) * K + k0 + 8 * c) = o; }
    LDS_WAIT(); asm volatile("" ::: "memory");
}

__device__ __forceinline__ void prologue(const Args& a, LAS unsigned char* lds, int gw, int NGW, int lane, int wave) {
    unsigned char* ws = a.ws;
    LAS float* scr = (LAS float*)(lds + wave * 16384);
    struct TJ { const float* W; int K, ldw, ncol0, ncols; const float* gain; bf16_t* dst; int row_off, nperm; };
    int it = gw;
    for (int job = 0; job < 17; ++job) {
        TJ j;
        if (job < 2)       j = TJ{a.w_in_a + (size_t)job * 1024 * A_COLS, 1024, A_COLS, 0, 4096, a.norm_a + job * 1024, (bf16_t*)(ws + WS_WINA) + (size_t)job * 4096 * 1024, 0, 0};
        else if (job < 4)  j = TJ{a.w_out_a + (size_t)(job - 2) * 1024 * 1024, 1024, 1024, 0, 1024, a.hnorm_a + (job - 2) * 1024, (bf16_t*)(ws + WS_WOUTA) + (size_t)(job - 2) * 1024 * 1024, 0, 0};
        else if (job == 4) j = TJ{a.w_in_b, 1024, 2048, 0, 2048, a.norm_b, (bf16_t*)(ws + WS_WINB0), 0, 1536};
        else if (job == 5) j = TJ{a.w_in_b + (size_t)1024 * 2048, 1024, 2048, 0, 2048, a.norm_b + 1024, (bf16_t*)(ws + WS_WINB1), 0, 1536};
        else if (job == 6) j = TJ{a.w_kv, 1024, 1024, 0, 1024, a.norm_kv, (bf16_t*)(ws + WS_WINB0), 2048, 512};
        else if (job < 9)  j = TJ{a.w_out_b + (size_t)(job - 7) * 512 * 1024, 512, 1024, 0, 1024, nullptr, (bf16_t*)(ws + WS_WOUTB) + (size_t)(job - 7) * 1024 * 512, 0, 0};
        else if (job < 13) j = TJ{a.w_ple_gate + (size_t)(job - 9) * 1024 * 1024, 1024, 1024, 0, 1024, a.ple_norm + (job - 9) * 1024, (bf16_t*)(ws + WS_WGATE) + (size_t)(job - 9) * 1024 * 1024, 0, 0};
        else               j = TJ{a.w_ple + (size_t)(job - 13) * 256 * 1024, 256, 1024, 0, 1024, nullptr, (bf16_t*)(ws + WS_WPLE) + (size_t)(job - 13) * 1024 * 256, 0, 0};
        const int nblk = j.ncols / 32, nitems = (j.K / 64) * nblk;
        for (; it < nitems; it += NGW) transpose_item(j.W, j.K, j.ldw, j.ncol0, nblk, j.gain, j.dst, j.row_off, j.nperm, scr, it, lane);
        it -= nitems;
    }
    {
        bf16_t* HB = (bf16_t*)(ws + WS_HB0); float* SSQ = (float*)(ws + WS_SSQ0);
        for (int m0 = gw * 4; m0 < T; m0 += NGW * 4) {
            f32x4 v[4][4];
#pragma unroll
            for (int r = 0; r < 4; ++r) { const f32x4* xr = (const f32x4*)(a.x + (size_t)(m0 + r) * D) + lane;
#pragma unroll
                for (int jj = 0; jj < 4; ++jj) v[r][jj] = xr[64 * jj]; }
#pragma unroll
            for (int r = 0; r < 4; ++r) {
                float sq = 0.f;
#pragma unroll
                for (int jj = 0; jj < 4; ++jj) sq += (v[r][jj].x * v[r][jj].x + v[r][jj].y * v[r][jj].y) + (v[r][jj].z * v[r][jj].z + v[r][jj].w * v[r][jj].w);
#pragma unroll
                for (int o = 1; o < 64; o <<= 1) sq += __shfl_xor(sq, o);
                u32x2* o8 = (u32x2*)(HB + (size_t)(m0 + r) * D) + lane;
#pragma unroll
                for (int jj = 0; jj < 4; ++jj) { u32x2 w; w.x = cvt_pk_bf16(v[r][jj].x, v[r][jj].y); w.y = cvt_pk_bf16(v[r][jj].z, v[r][jj].w); o8[64 * jj] = w; }
                if (lane < 16) SSQ[(size_t)(m0 + r) * 16 + lane] = lane == 0 ? sq : 0.f;
            }
        }
    }
    {
        float* COS = (float*)(ws + WS_COS); float* SIN = (float*)(ws + WS_SIN);
        for (int i = gw * 64 + lane; i < SEQ * 64; i += NGW * 64) {
            const int pos = i >> 6, fi = i & 63;
            const float crev = exp2f(-(float)fi * (13.287712379549449f / 64.0f)) * 0.15915494309189535f;
            float tr = (float)pos * crev; tr -= rintf(tr);
            COS[i] = __builtin_amdgcn_cosf(tr); SIN[i] = __builtin_amdgcn_sinf(tr);
        }
    }
    {
        bf16_t* WG = (bf16_t*)(ws + WS_WG8);
        for (int i = gw * 64 + lane; i < 2 * 16 * 1024; i += NGW * 64) {
            const int l = i >> 14, jj = (i >> 10) & 15, k = i & 1023;
            WG[i] = (jj < 8) ? f2bf(a.w_in_a[(size_t)l * 1024 * A_COLS + (size_t)k * A_COLS + 4096 + jj] * a.norm_a[l * 1024 + k]) : (bf16_t)0;
        }
    }
}

__device__ __forceinline__ void convert_p(const Args& a, int layer, int gtid, int NGT) {
    const f32x4* src = (const f32x4*)(a.p + (size_t)layer * T * PLE);
    u32x4* dst = (u32x4*)(a.ws + WS_PB);
    for (int i0 = gtid; i0 < T * PLE / 8; i0 += 8 * NGT) {
        f32x4 v[8][2];
#pragma unroll
        for (int q = 0; q < 8; ++q) { const int i = i0 + q * NGT; if (i < T * PLE / 8) { v[q][0] = src[2 * i]; v[q][1] = src[2 * i + 1]; } }
#pragma unroll
        for (int q = 0; q < 8; ++q) { const int i = i0 + q * NGT; if (i < T * PLE / 8) {
            u32x4 w; w.x = cvt_pk_bf16(v[q][0].x, v[q][0].y); w.y = cvt_pk_bf16(v[q][0].z, v[q][0].w); w.z = cvt_pk_bf16(v[q][1].x, v[q][1].y); w.w = cvt_pk_bf16(v[q][1].z, v[q][1].w);
            dst[i] = w; } }
    }
}

__device__ __forceinline__ void gates_job(const Args& a, int layer, const bf16_t* HB, const float* SSQ, int gw, int NGW, int lane) {
    const bf16_t* WG = (const bf16_t*)(a.ws + WS_WG8) + (size_t)layer * 16 * 1024;
    float* GATES = (float*)(a.ws + WS_GATES);
    const int ql = lane & 15, grp = lane >> 4;
#pragma nounroll
    for (int t0 = gw * 16; t0 < T; t0 += NGW * 16) {
        const bf16_t* arow = HB + (size_t)(t0 + ql) * D + 8 * grp;
        const bf16_t* brow = WG + ql * 1024 + 8 * grp;
        f32x4 acc = (f32x4){0.f, 0.f, 0.f, 0.f};
#pragma unroll 8
        for (int ks = 0; ks < 32; ++ks) acc = __builtin_amdgcn_mfma_f32_16x16x32_bf16(*(const bf16x8*)(arow + 32 * ks), *(const bf16x8*)(brow + 32 * ks), acc, 0, 0, 0);
        if (ql < 8) {
            const float bias = a.b_gate_a[layer * 8 + ql];
#pragma unroll
            for (int ii = 0; ii < 4; ++ii) { const int t = t0 + 4 * grp + ii; GATES[(size_t)t * 8 + ql] = acc[ii] * ssq16_rstd(SSQ, t) + bias; }
        }
    }
}

__device__ __forceinline__ void conv_phase(const Args& a, int layer, int gtid, int NGT, int gw, int NGW, int lane) {
    const bf16_t* QKb = (const bf16_t*)(a.ws + WS_S0); bf16_t* QC = (bf16_t*)(a.ws + WS_HB1);
#pragma nounroll
    for (int task = gtid; task < (T / 16) * 128; task += NGT) {
        const int cgp = task & 127, run = task >> 7, t0 = run * 16, ch0 = cgp * 8;
        float cw[4][8];
#pragma unroll
        for (int jj = 0; jj < 4; ++jj) { const f32x4 c0 = *(const f32x4*)(a.conv_a + (size_t)layer * 4096 + jj * 1024 + ch0), c1 = *(const f32x4*)(a.conv_a + (size_t)layer * 4096 + jj * 1024 + ch0 + 4);
            cw[jj][0] = c0.x; cw[jj][1] = c0.y; cw[jj][2] = c0.z; cw[jj][3] = c0.w; cw[jj][4] = c1.x; cw[jj][5] = c1.y; cw[jj][6] = c1.z; cw[jj][7] = c1.w; }
        const float scl = (ch0 >= 512) ? 0.08838834764831845f : 1.f;
        const bool first = (t0 & (SEQ - 1)) == 0;
        const bf16_t* src = QKb + (size_t)t0 * 1024 + ch0; bf16_t* dst = QC + (size_t)t0 * 1024 + ch0;
        u32x4 r[19];
#pragma unroll
        for (int q = 0; q < 19; ++q) r[q] = (q < 3 && first) ? (u32x4){0u, 0u, 0u, 0u} : *(const u32x4*)(src + (q - 3) * 1024);
#pragma unroll
        for (int q = 0; q < 16; ++q) {
            const unsigned w0[4] = {r[q].x, r[q].y, r[q].z, r[q].w}, w1[4] = {r[q + 1].x, r[q + 1].y, r[q + 1].z, r[q + 1].w}, w2[4] = {r[q + 2].x, r[q + 2].y, r[q + 2].z, r[q + 2].w}, w3[4] = {r[q + 3].x, r[q + 3].y, r[q + 3].z, r[q + 3].w};
            unsigned ow[4];
#pragma unroll
            for (int e = 0; e < 4; ++e) {
                float u0 = cw[0][2 * e] * bf_lo(w0[e]) + cw[1][2 * e] * bf_lo(w1[e]) + cw[2][2 * e] * bf_lo(w2[e]) + cw[3][2 * e] * bf_lo(w3[e]);
                float u1 = cw[0][2 * e + 1] * bf_hi(w0[e]) + cw[1][2 * e + 1] * bf_hi(w1[e]) + cw[2][2 * e + 1] * bf_hi(w2[e]) + cw[3][2 * e + 1] * bf_hi(w3[e]);
                u0 = u0 * sigmoidf_(u0) * scl; u1 = u1 * sigmoidf_(u1) * scl;
                ow[e] = cvt_pk_bf16(u0, u1);
            }
            *(u32x4*)(dst + (size_t)q * 1024) = (u32x4){ow[0], ow[1], ow[2], ow[3]};
        }
    }
    const float* GATES = (const float*)(a.ws + WS_GATES); float* TAB = (float*)(a.ws + WS_LSE);
#pragma nounroll
    for (int task = gw; task < 32 * 64; task += NGW) {
        const int bh = task >> 6, cc = task & 63, b = bh >> 2, h = bh & 3, t = cc * 64 + lane;
        const float gi = GATES[((size_t)b * SEQ + t) * 8 + h], gf = GATES[((size_t)b * SEQ + t) * 8 + 4 + h];
        const float lf = fminf(gf, 0.f) - log1pf(expf(-fabsf(gf)));
        float bc = lf;
#pragma unroll
        for (int o = 1; o < 64; o <<= 1) { const float tt = __shfl_up(bc, o); if (lane >= o) bc += tt; }
        const float av = gi - bc;
        float pm = av;
#pragma unroll
        for (int o = 1; o < 64; o <<= 1) { const float tt = __shfl_up(pm, o); if (lane >= o) pm = fmaxf(pm, tt); }
        float* tb = TAB + (size_t)bh * 3 * SEQ + t;
        tb[0] = av; tb[SEQ] = pm; tb[2 * SEQ] = bc;
    }
}

namespace scan {
constexpr int QS = 0, KS = 18432, VS = 36864, EA = 41984, IMG = 42240, CS = 2 * IMG, HSB = CS + 26112, HS1 = 0, HS2 = 8448, GD = 16896, HSZ = 16896 + 768;
constexpr int QSTR = 288, VSTR = 80, CSTR = 272, CBUF = 48 * 272;
constexpr int O_D1 = 0, O_D2 = 64, O_FL = 128;
static_assert(HSB + 2 * HSZ <= MISC_OFF, "scan LDS map");
typedef short s16x4 __attribute__((ext_vector_type(4)));

__device__ __forceinline__ void flush_out(const LAS unsigned char* hb, bf16_t* OGb, float* SSQH, size_t row, int vcol, int tokv, int c4, int h, int s, u32x4 ograw, u32x4 szraw) {
    const LAS float* hs1 = (const LAS float*)(hb + HS1) + tokv * 33 + 8 * c4; const LAS float* hs2 = (const LAS float*)(hb + HS2) + tokv * 33 + 8 * c4;
    const LAS float* ga = (const LAS float*)(hb + GD);
    const float rden = __builtin_amdgcn_rcpf(fmaxf(fabsf(ga[O_D1 + tokv] + ga[O_D2 + tokv]), ga[O_FL + tokv]));
    const unsigned ow[4] = {ograw.x, ograw.y, ograw.z, ograw.w}, zw[4] = {szraw.x, szraw.y, szraw.z, szraw.w};
    float sq = 0.f; unsigned outw[4];
#pragma unroll
    for (int e = 0; e < 4; ++e) {
        const float g0 = bf_lo(ow[e]) * ((hs1[2 * e] + hs2[2 * e]) * rden), g1 = bf_hi(ow[e]) * ((hs1[2 * e + 1] + hs2[2 * e + 1]) * rden);
        sq += g0 * g0 + g1 * g1;
        outw[e] = cvt_pk_bf16(g0 * bf_lo(zw[e]), g1 * bf_hi(zw[e]));
    }
    sq += __shfl_xor(sq, 1); sq += __shfl_xor(sq, 2);
    *(u32x4*)(OGb + row * 1024 + vcol) = (u32x4){outw[0], outw[1], outw[2], outw[3]};
    if (c4 == 0) SSQH[row * 32 + h * 8 + s] = sq;
}

struct Ctx { const bf16_t* QCb; const bf16_t* Vb; bf16_t* OGb; const bf16_t* SZb; float* SSQH; const float* TAB; size_t rowbase; int h, s; };

__device__ __forceinline__ void stage_chunk(LAS unsigned char* img, int tl, const u32x4 (&qk)[4], u32x4 vraw, float ta, float tpm) {
    const int lane = tl & 63, tokv = (tl >> 2) & 63, c4 = tl & 3;
    const int p0 = tl, p1 = tl + 512;
    *(LAS u32x4*)(img + QS + (p0 >> 4) * QSTR + (p0 & 15) * 16) = qk[0];
    *(LAS u32x4*)(img + QS + (p1 >> 4) * QSTR + (p1 & 15) * 16) = qk[1];
    *(LAS u32x4*)(img + KS + (p0 >> 4) * QSTR + (p0 & 15) * 16) = qk[2];
    *(LAS u32x4*)(img + KS + (p1 >> 4) * QSTR + (p1 & 15) * 16) = qk[3];
    const float cmax = __shfl(tpm, 63);
    const float eal = __expf(ta - cmax);
    const float ea = __shfl(eal, tokv);
    if (tl < 256) {
        u32x4 vs; vs.x = cvt_pk_bf16(bf_lo(vraw.x) * ea, bf_hi(vraw.x) * ea); vs.y = cvt_pk_bf16(bf_lo(vraw.y) * ea, bf_hi(vraw.y) * ea);
        vs.z = cvt_pk_bf16(bf_lo(vraw.z) * ea, bf_hi(vraw.z) * ea); vs.w = cvt_pk_bf16(bf_lo(vraw.w) * ea, bf_hi(vraw.w) * ea);
        *(LAS u32x4*)(img + VS + tokv * VSTR + c4 * 16) = vs;
    }
    if (tl >= 448) ((LAS float*)(img + EA))[lane] = eal;
}
__device__ __forceinline__ void load_chunk(const Ctx& x, int tl, int c, u32x4 (&qk)[4], u32x4& vraw) {
    const int tokv = (tl >> 2) & 63, c4 = tl & 3;
#pragma unroll
    for (int i = 0; i < 4; ++i) { const int p = (tl + 512 * i) & 1023, row = p >> 4, c16 = p & 15;
        qk[i] = *(const u32x4*)(x.QCb + (x.rowbase + c * 64 + row) * 1024 + (i >= 2 ? 512 : 0) + x.h * 128 + c16 * 8); }
    if (tl < 256) vraw = *(const u32x4*)(x.Vb + (x.rowbase + c * 64 + tokv) * 1024 + x.h * 256 + x.s * 32 + 8 * c4);
}

template <int VAR>
__device__ __forceinline__ void scan_iter(const Ctx& x, LAS unsigned char* lds, int tid, int c, u32x4 (&qkX)[4], u32x4& vX, u32x4& ograw, u32x4& szraw,
                                          float& t0a, float& t0pm, float& t0b, float& t1a, float& t1pm, float& t1b, float& t2a, float& t2pm, float& t2b, float& mprev, f32x4 (&Cacc)[3][2]) {
    int tl = tid; asm volatile("" : "+v"(tl));
    const int w = __builtin_amdgcn_readfirstlane(tl >> 6), lane = tl & 63, grp = lane >> 4, ql = lane & 15;
    const int tokv = (tl >> 2) & 63, c4 = tl & 3;
    const int vcol = x.h * 256 + x.s * 32 + 8 * c4;
    const int cur = c & 1, nxt = cur ^ 1;
    LAS unsigned char* imgc = lds + cur * IMG; LAS unsigned char* imgn = lds + nxt * IMG;
    LAS unsigned char* hbc = lds + HSB + cur * HSZ; const LAS unsigned char* hbp = lds + HSB + nxt * HSZ;
    if (c < 63) stage_chunk(imgn, tl, qkX, vX, t1a, t1pm);
    if (VAR == 0) { if (c + 3 < 64) load_chunk(x, tl, c + 3, qkX, vX); }
    if (c > 0 && tl < 256) flush_out(hbp, x.OGb, x.SSQH, x.rowbase + (c - 1) * 64 + tokv, vcol, tokv, c4, x.h, x.s, ograw, szraw);
    if (VAR == 0) { if (tl < 256) { const size_t row = x.rowbase + c * 64 + tokv; ograw = *(const u32x4*)(x.OGb + row * 1024 + vcol); szraw = *(const u32x4*)(x.SZb + row * 1024 + vcol); } }
    float n3a = 0.f, n3pm = 0.f, n3b = 0.f;
    if (c + 3 < 64) { const float* tp = x.TAB + (c + 3) * 64 + lane; n3a = tp[0]; n3pm = tp[SEQ]; n3b = tp[2 * SEQ]; }
    const float mcur = mprev;
    const float cmax = __shfl(t0pm, 63);
    const float Mlast = fmaxf(mcur, cmax);
    const float decay = __expf(mcur - Mlast), sB = __expf(cmax - Mlast);
    mprev = __shfl(t0b, 63) + Mlast;
    const LAS unsigned char* vbase = imgc + VS + (4 * grp + (ql >> 2)) * VSTR + (ql & 3) * 8;
    const LAS float* eap = (const LAS float*)(imgc + EA);
    if (w < 4) {
        const int ti = w, i = 16 * ti + ql;
        bf16x8 Qf[4];
        {
            const LAS unsigned char* qb = imgc + QS + i * QSTR + grp * 16;
#pragma unroll
            for (int ks = 0; ks < 4; ++ks) Qf[ks] = *(const LAS bf16x8*)(qb + ks * 64);
        }
        const float Mi = fmaxf(mcur, __shfl(t0pm, i)), eb = __expf(cmax - Mi), flr = __expf(-(__shfl(t0b, i) + Mi));
        f32x4 wt[4];
        const LAS unsigned char* kb = imgc + KS + ql * QSTR + grp * 16;
#pragma unroll
        for (int tj = 0; tj < 4; ++tj) {
            f32x4 sacc = (f32x4){0.f, 0.f, 0.f, 0.f};
            if (tj <= ti) {
#pragma unroll
                for (int ks = 0; ks < 4; ++ks) sacc = __builtin_amdgcn_mfma_f32_16x16x32_bf16(*(const LAS bf16x8*)(kb + tj * 16 * QSTR + ks * 64), Qf[ks], sacc, 0, 0, 0);
            }
            if (tj == ti) {
#pragma unroll
                for (int ii = 0; ii < 4; ++ii) sacc[ii] = (4 * grp + ii <= ql) ? sacc[ii] : 0.f;
            }
            wt[tj] = sacc;
        }
        f32x4 acc1[3];
#pragma unroll
        for (int vt = 0; vt < 3; ++vt) acc1[vt] = (f32x4){0.f, 0.f, 0.f, 0.f};
#pragma unroll
        for (int p = 0; p < 2; ++p) {
            u32x4 pw; pw.x = cvt_pk_bf16(wt[2 * p][0], wt[2 * p][1]); pw.y = cvt_pk_bf16(wt[2 * p][2], wt[2 * p][3]); pw.z = cvt_pk_bf16(wt[2 * p + 1][0], wt[2 * p + 1][1]); pw.w = cvt_pk_bf16(wt[2 * p + 1][2], wt[2 * p + 1][3]);
            const bf16x8 Pf = __builtin_bit_cast(bf16x8, pw);
#pragma unroll
            for (int vt = 0; vt < 2; ++vt) {
                const s16x4 lo = __builtin_amdgcn_ds_read_tr16_b64_v4i16((LAS s16x4*)(vbase + (32 * p) * VSTR + vt * 32));
                const s16x4 hi = __builtin_amdgcn_ds_read_tr16_b64_v4i16((LAS s16x4*)(vbase + (32 * p + 16) * VSTR + vt * 32));
                acc1[vt] = __builtin_amdgcn_mfma_f32_16x16x32_bf16((bf16x8){lo[0], lo[1], lo[2], lo[3], hi[0], hi[1], hi[2], hi[3]}, Pf, acc1[vt], 0, 0, 0);
            }
            const f32x4 e0 = *(const LAS f32x4*)(eap + 32 * p + 4 * grp), e1 = *(const LAS f32x4*)(eap + 32 * p + 16 + 4 * grp);
            u32x4 aw; aw.x = cvt_pk_bf16(e0[0], e0[1]); aw.y = cvt_pk_bf16(e0[2], e0[3]); aw.z = cvt_pk_bf16(e1[0], e1[1]); aw.w = cvt_pk_bf16(e1[2], e1[3]);
            if (ql != 0) aw = (u32x4){0u, 0u, 0u, 0u};
            acc1[2] = __builtin_amdgcn_mfma_f32_16x16x32_bf16(__builtin_bit_cast(bf16x8, aw), Pf, acc1[2], 0, 0, 0);
        }
        LAS float* hsw = (LAS float*)(hbc + HS1) + i * 33 + 4 * grp;
#pragma unroll
        for (int vt = 0; vt < 2; ++vt)
#pragma unroll
            for (int ii = 0; ii < 4; ++ii) hsw[16 * vt + ii] = acc1[vt][ii] * eb;
        if (grp == 0) { ((LAS float*)(hbc + GD))[O_D1 + i] = acc1[2][0] * eb; ((LAS float*)(hbc + GD))[O_FL + i] = flr; }
    } else {
        const int wb = w - 4, i = 16 * wb + ql;
        {
            bf16x8 Qf[4];
            const LAS unsigned char* qb = imgc + QS + i * QSTR + grp * 16;
#pragma unroll
            for (int ks = 0; ks < 4; ++ks) Qf[ks] = *(const LAS bf16x8*)(qb + ks * 64);
            f32x4 acc2[3];
#pragma unroll
            for (int vt = 0; vt < 3; ++vt) acc2[vt] = (f32x4){0.f, 0.f, 0.f, 0.f};
            const LAS unsigned char* cb = lds + CS + cur * CBUF + ql * CSTR + grp * 16;
#pragma unroll
            for (int vt = 0; vt < 3; ++vt)
#pragma unroll
                for (int ks = 0; ks < 4; ++ks) acc2[vt] = __builtin_amdgcn_mfma_f32_16x16x32_bf16(*(const LAS bf16x8*)(cb + vt * 16 * CSTR + ks * 64), Qf[ks], acc2[vt], 0, 0, 0);
            const float inter = __expf(mcur - fmaxf(mcur, __shfl(t0pm, i)));
            LAS float* hsw = (LAS float*)(hbc + HS2) + i * 33 + 4 * grp;
#pragma unroll
            for (int vt = 0; vt < 2; ++vt)
#pragma unroll
                for (int ii = 0; ii < 4; ++ii) hsw[16 * vt + ii] = acc2[vt][ii] * inter;
            if (grp == 0) ((LAS float*)(hbc + GD))[O_D2 + i] = acc2[2][0] * inter;
        }
        f32x4 U[3][2];
#pragma unroll
        for (int vt = 0; vt < 3; ++vt) { U[vt][0] = (f32x4){0.f, 0.f, 0.f, 0.f}; U[vt][1] = (f32x4){0.f, 0.f, 0.f, 0.f}; }
        const LAS unsigned char* kbase = imgc + KS + (4 * grp + (ql >> 2)) * QSTR + (ql & 3) * 8 + wb * 64;
#pragma unroll
        for (int p = 0; p < 2; ++p) {
            bf16x8 Af[3];
#pragma unroll
            for (int vt = 0; vt < 2; ++vt) {
                const s16x4 lo = __builtin_amdgcn_ds_read_tr16_b64_v4i16((LAS s16x4*)(vbase + (32 * p) * VSTR + vt * 32));
                const s16x4 hi = __builtin_amdgcn_ds_read_tr16_b64_v4i16((LAS s16x4*)(vbase + (32 * p + 16) * VSTR + vt * 32));
                Af[vt] = (bf16x8){lo[0], lo[1], lo[2], lo[3], hi[0], hi[1], hi[2], hi[3]};
            }
            { const f32x4 e0 = *(const LAS f32x4*)(eap + 32 * p + 4 * grp), e1 = *(const LAS f32x4*)(eap + 32 * p + 16 + 4 * grp);
              u32x4 aw; aw.x = cvt_pk_bf16(e0[0], e0[1]); aw.y = cvt_pk_bf16(e0[2], e0[3]); aw.z = cvt_pk_bf16(e1[0], e1[1]); aw.w = cvt_pk_bf16(e1[2], e1[3]);
              if (ql != 0) aw = (u32x4){0u, 0u, 0u, 0u};
              Af[2] = __builtin_bit_cast(bf16x8, aw); }
#pragma unroll
            for (int dl = 0; dl < 2; ++dl) {
                const s16x4 lo = __builtin_amdgcn_ds_read_tr16_b64_v4i16((LAS s16x4*)(kbase + (32 * p) * QSTR + dl * 32));
                const s16x4 hi = __builtin_amdgcn_ds_read_tr16_b64_v4i16((LAS s16x4*)(kbase + (32 * p + 16) * QSTR + dl * 32));
                const bf16x8 Bk = (bf16x8){lo[0], lo[1], lo[2], lo[3], hi[0], hi[1], hi[2], hi[3]};
#pragma unroll
                for (int vt = 0; vt < 3; ++vt) U[vt][dl] = __builtin_amdgcn_mfma_f32_16x16x32_bf16(Af[vt], Bk, U[vt][dl], 0, 0, 0);
            }
        }
#pragma unroll
        for (int vt = 0; vt < 3; ++vt)
#pragma unroll
            for (int dl = 0; dl < 2; ++dl) Cacc[vt][dl] = Cacc[vt][dl] * decay + U[vt][dl] * sB;
        LAS unsigned char* cw_ = lds + CS + nxt * CBUF + (4 * grp) * CSTR + (32 * wb + ql) * 2;
#pragma unroll
        for (int dl = 0; dl < 2; ++dl) {
#pragma unroll
            for (int vt = 0; vt < 2; ++vt)
#pragma unroll
                for (int ii = 0; ii < 4; ++ii) *(LAS bf16_t*)(cw_ + (16 * vt + ii) * CSTR + dl * 32) = f2bf(Cacc[vt][dl][ii]);
            if (grp == 0) *(LAS bf16_t*)(cw_ + 32 * CSTR + dl * 32) = f2bf(Cacc[2][dl][0]);
        }
    }
    t0a = t1a; t0pm = t1pm; t0b = t1b; t1a = t2a; t1pm = t2pm; t1b = t2b; t2a = n3a; t2pm = n3pm; t2b = n3b;
    LDS_BARRIER();
}

template <int VAR>
__device__ __forceinline__ void phase(const Args& a, LAS unsigned char* lds, int layer, int G) {
    int tid = threadIdx.x; asm volatile("" : "+v"(tid));
    unsigned char* ws = a.ws; (void)layer;
    for (int item = blockIdx.x; item < 256; item += G) {
        const int xx = item & 7, kk = item >> 3, bh = xx * 4 + (kk >> 3), s = kk & 7, b = bh >> 2, h = bh & 3;
        Ctx x; x.QCb = (const bf16_t*)(ws + WS_HB1); x.Vb = (const bf16_t*)(ws + WS_S1); x.OGb = (bf16_t*)(ws + WS_S2); x.SZb = (const bf16_t*)(ws + WS_S3); x.SSQH = (float*)(ws + WS_SSQH);
        x.TAB = (const float*)(ws + WS_LSE) + (size_t)bh * 3 * SEQ; x.rowbase = (size_t)b * SEQ; x.h = h; x.s = s;
        {
            unsigned z0 = 0u; asm volatile("" : "+v"(z0));
            for (int i = tid; i < 2 * CBUF / 4; i += NTHR) ((LAS unsigned*)(lds + CS))[i] = z0;
        }
        f32x4 Cacc[3][2];
#pragma unroll
        for (int vt = 0; vt < 3; ++vt) { Cacc[vt][0] = (f32x4){0.f, 0.f, 0.f, 0.f}; Cacc[vt][1] = (f32x4){0.f, 0.f, 0.f, 0.f}; }
        float mprev = 0.f;
        u32x4 qk0[4], qk1[4]; u32x4 v0 = (u32x4){0u, 0u, 0u, 0u}, v1 = v0, ograw = v0, szraw = v0;
        float t0a, t0pm, t0b, t1a, t1pm, t1b, t2a, t2pm, t2b;
        {
            const int lane = tid & 63;
            load_chunk(x, tid, 0, qk0, v0); load_chunk(x, tid, 1, qk1, v1);
            t0a = x.TAB[lane]; t0pm = x.TAB[SEQ + lane]; t0b = x.TAB[2 * SEQ + lane];
            t1a = x.TAB[64 + lane]; t1pm = x.TAB[SEQ + 64 + lane]; t1b = x.TAB[2 * SEQ + 64 + lane];
            t2a = x.TAB[128 + lane]; t2pm = x.TAB[SEQ + 128 + lane]; t2b = x.TAB[2 * SEQ + 128 + lane];
            stage_chunk(lds, tid, qk0, v0, t0a, t0pm);
            load_chunk(x, tid, 2, qk0, v0);
        }
        __syncthreads();
#pragma nounroll
        for (int c = 0; c < 64; c += 2) {
            scan_iter<VAR>(x, lds, tid, c, qk1, v1, ograw, szraw, t0a, t0pm, t0b, t1a, t1pm, t1b, t2a, t2pm, t2b, mprev, Cacc);
            scan_iter<VAR>(x, lds, tid, c + 1, qk0, v0, ograw, szraw, t0a, t0pm, t0b, t1a, t1pm, t1b, t2a, t2pm, t2b, mprev, Cacc);
        }
        if (tid < 256) flush_out(lds + HSB + HSZ, x.OGb, x.SSQH, x.rowbase + 63 * 64 + ((tid >> 2) & 63), h * 256 + s * 32 + 8 * (tid & 3), (tid >> 2) & 63, tid & 3, h, s, ograw, szraw);
        __syncthreads();
    }
}
}

__device__ __forceinline__ void mlstm_norm_phase(const Args& a, int gtid, int NGT) {
    const u32x4* A = (const u32x4*)(a.ws + WS_S2); u32x4* Y = (u32x4*)(a.ws + WS_S0); const float* SSQH = (const float*)(a.ws + WS_SSQH);
    for (int i = gtid; i < T * 128; i += NGT) {
        const int t = i >> 7, c8 = i & 127, h = c8 >> 5;
        const f32x4 s0 = *(const f32x4*)(SSQH + (size_t)t * 32 + h * 8), s1 = *(const f32x4*)(SSQH + (size_t)t * 32 + h * 8 + 4);
        const float rs = rsqrtf((((s0.x + s0.y) + (s0.z + s0.w)) + ((s1.x + s1.y) + (s1.z + s1.w))) * (1.f / 256.f) + EPS);
        const u32x4 v = A[i]; u32x4 o;
        o.x = cvt_pk_bf16(bf_lo(v.x) * rs, bf_hi(v.x) * rs); o.y = cvt_pk_bf16(bf_lo(v.y) * rs, bf_hi(v.y) * rs);
        o.z = cvt_pk_bf16(bf_lo(v.z) * rs, bf_hi(v.z) * rs); o.w = cvt_pk_bf16(bf_lo(v.w) * rs, bf_hi(v.w) * rs);
        Y[i] = o;
    }
}

namespace attn {
constexpr int KS = 0, VS = 69632;
constexpr int KSTR = 272, VSTR = 288;
typedef short s16x4 __attribute__((ext_vector_type(4)));
struct Item { int b, head, g, res, blk, r; };
__device__ __forceinline__ Item decode(int item) {
    const int xcd = item & 7, q = item >> 3, bhh = xcd + 8 * (q / 96), gi = q % 96;
    Item it; it.b = bhh >> 2; it.head = bhh & 3;
    if (gi < 32) { it.g = 0; it.res = 0; it.blk = gi; it.r = 1; } else if (gi < 64) { it.g = 1; it.res = (gi - 32) >> 3; it.blk = (gi - 32) & 7; it.r = 4; } else { it.g = 2; it.res = (gi - 64) >> 1; it.blk = (gi - 64) & 1; it.r = 16; }
    return it;
}
template <int VAR>
__device__ __forceinline__ void phase(const Args& a, LAS unsigned char* lds, int jl, int G) {
    int tid = threadIdx.x; asm volatile("" : "+v"(tid));
    unsigned char* ws = a.ws; (void)jl;
    const bf16_t* Kb = (const bf16_t*)(ws + WS_S0); const bf16_t* Vb = (const bf16_t*)(ws + WS_S0 + 32 * MiB);
    bf16_t* Qb = (bf16_t*)(ws + WS_S1);
    float* LSE = (float*)(ws + WS_LSE);
    { unsigned z0 = 0u; asm volatile("" : "+v"(z0)); if (tid < 16 * 18) *(LAS u32x4*)(lds + VS + 256 * VSTR + tid * 16) = (u32x4){z0, z0, z0, z0}; }
    u32x4 kreg[8], vreg[8]; bf16x8 qreg[4];
#define ATTN_LOAD(itm) do { const Item it_ = decode(itm); const size_t rb_ = (size_t)it_.b * SEQ; \
        _Pragma("unroll") for (int c_ = 0; c_ < (VAR == 3 ? 4 : 8); ++c_) { const int p_ = tid + 512 * c_, kj_ = p_ >> 4, u_ = (it_.blk - 1) * 128 + kj_, pos_ = u_ >= 0 ? u_ * it_.r + it_.res : 0; \
            const size_t off_ = (rb_ + pos_) * 512 + it_.head * 128 + (p_ & 15) * 8; kreg[c_] = *(const u32x4*)(Kb + off_); vreg[c_] = *(const u32x4*)(Vb + off_); } \
        const int lane_ = tid & 63, w_ = tid >> 6, posq_ = (128 * it_.blk + 16 * w_ + (lane_ & 15)) * it_.r + it_.res; \
        const bf16_t* qs_ = Qb + (rb_ + posq_) * 1536 + (it_.g * 4 + it_.head) * 128 + 8 * (lane_ >> 4); \
        _Pragma("unroll") for (int ks2_ = 0; ks2_ < 4; ++ks2_) qreg[ks2_] = *(const bf16x8*)(qs_ + 32 * ks2_); } while (0)
    int bx0 = blockIdx.x; asm volatile("" : "+s"(bx0));
    if (bx0 < 3072) ATTN_LOAD(bx0);
    if (VAR == 1) { _Pragma("unroll") for (int c_ = 0; c_ < 8; ++c_) asm volatile("" : "+v"(kreg[c_]), "+v"(vreg[c_])); }
#pragma nounroll
    for (int item = bx0; item < 3072; item += G) {
        int tl = tid; asm volatile("" : "+v"(tl));
        const int w = __builtin_amdgcn_readfirstlane(tl >> 6), lane = tl & 63, grp = lane >> 4, ql = lane & 15;
        const Item it = decode(item);
        const int blk = it.blk;
        const size_t rowbase = (size_t)it.b * SEQ;
#pragma unroll
        for (int c = 0; c < 8; ++c) {
            const int p = tl + 512 * c, kj = p >> 4, ch = p & 15;
            u32x4 kv = kreg[c], vv = vreg[c];
            if (blk == 0 && kj < 128) { kv = (u32x4){0u, 0u, 0u, 0u}; vv = kv; }
            *(LAS u32x4*)(lds + KS + kj * KSTR + ch * 16) = kv; *(LAS u32x4*)(lds + VS + kj * VSTR + ch * 16) = vv;
        }
        bf16x8 Qf[4];
#pragma unroll
        for (int ks = 0; ks < 4; ++ks) Qf[ks] = qreg[ks];
        const int qi = 16 * w + ql;
        const int posq = (128 * blk + qi) * it.r + it.res;
        bf16_t* orow = Qb + (rowbase + posq) * 1536 + (it.g * 4 + it.head) * 128 + 4 * grp;
        LDS_BARRIER();
        float mx = -__builtin_inff(); float den = 0.f;
        f32x4 oacc[8];
#pragma unroll
        for (int dt = 0; dt < 8; ++dt) oacc[dt] = (f32x4){0.f, 0.f, 0.f, 0.f};
        if (VAR != 2) {
        f32x4 sc[9];
        const int dbase = 128 + ql - 4 * grp; const unsigned dmax = (blk > 0) ? 128u : (unsigned)qi;
        const LAS unsigned char* kbase = lds + KS + (16 * w + ql) * KSTR + grp * 16;
        bf16x8 kf[2][4];
#pragma unroll
        for (int ks = 0; ks < 4; ++ks) kf[0][ks] = *(const LAS bf16x8*)(kbase + ks * 64);
#pragma unroll
        for (int tt = 0; tt < 9; ++tt) {
            if (tt < 8) {
#pragma unroll
                for (int ks = 0; ks < 4; ++ks) kf[(tt + 1) & 1][ks] = *(const LAS bf16x8*)(kbase + (tt + 1) * 16 * KSTR + ks * 64);
            }
            f32x4 acc = (f32x4){0.f, 0.f, 0.f, 0.f};
#pragma unroll
            for (int ks = 0; ks < 4; ++ks) acc = __builtin_amdgcn_mfma_f32_16x16x32_bf16(kf[tt & 1][ks], Qf[ks], acc, 0, 0, 0);
#pragma unroll
            for (int ii = 0; ii < 4; ++ii) {
                const int dist = dbase - 16 * tt - ii;
                const float v = ((unsigned)dist <= dmax) ? acc[ii] * 0.08838834764831845f : -__builtin_inff();
                sc[tt][ii] = v; mx = fmaxf(mx, v);
            }
        }
        if (VAR != 1) { if (item + G < 3072) ATTN_LOAD(item + G); }
        mx = fmaxf(mx, __shfl_xor(mx, 16)); mx = fmaxf(mx, __shfl_xor(mx, 32));
#pragma unroll
        for (int tt = 0; tt < 9; ++tt)
#pragma unroll
            for (int ii = 0; ii < 4; ++ii) { const float e = __expf(sc[tt][ii] - mx); sc[tt][ii] = e; den += e; }
        den += __shfl_xor(den, 16); den += __shfl_xor(den, 32);
        const LAS unsigned char* vbase = lds + VS + (16 * w + 4 * grp + (ql >> 2)) * VSTR + (ql & 3) * 8;
#pragma unroll
        for (int pp = 0; pp < 5; ++pp) {
            u32x4 pw;
            pw.x = cvt_pk_bf16(sc[2 * pp][0], sc[2 * pp][1]); pw.y = cvt_pk_bf16(sc[2 * pp][2], sc[2 * pp][3]);
            if (pp < 4) { pw.z = cvt_pk_bf16(sc[2 * pp + 1][0], sc[2 * pp + 1][1]); pw.w = cvt_pk_bf16(sc[2 * pp + 1][2], sc[2 * pp + 1][3]); } else { pw.z = 0u; pw.w = 0u; }
            const bf16x8 Pf = __builtin_bit_cast(bf16x8, pw);
#pragma unroll
            for (int dh = 0; dh < 2; ++dh) {
                s16x4 lo[4], hi[4];
#pragma unroll
                for (int d4 = 0; d4 < 4; ++d4) {
                    lo[d4] = __builtin_amdgcn_ds_read_tr16_b64_v4i16((LAS s16x4*)(vbase + pp * 32 * VSTR + (4 * dh + d4) * 32));
                    hi[d4] = __builtin_amdgcn_ds_read_tr16_b64_v4i16((LAS s16x4*)(vbase + pp * 32 * VSTR + 16 * VSTR + (4 * dh + d4) * 32));
                }
#pragma unroll
                for (int d4 = 0; d4 < 4; ++d4) {
                    const bf16x8 av = (bf16x8){lo[d4][0], lo[d4][1], lo[d4][2], lo[d4][3], hi[d4][0], hi[d4][1], hi[d4][2], hi[d4][3]};
                    oacc[4 * dh + d4] = __builtin_amdgcn_mfma_f32_16x16x32_bf16(av, Pf, oacc[4 * dh + d4], 0, 0, 0);
                }
            }
        }
        } else { den = 1.f; mx = 0.f; if (item + G < 3072) ATTN_LOAD(item + G); }
        const float inv = __builtin_amdgcn_rcpf(den);
#pragma unroll
        for (int dt = 0; dt < 8; ++dt) { u32x2 o; o.x = cvt_pk_bf16(oacc[dt][0] * inv, oacc[dt][1] * inv); o.y = cvt_pk_bf16(oacc[dt][2] * inv, oacc[dt][3] * inv);
            *(u32x2*)(orow + 16 * dt) = o; }
        if (grp == 0) LSE[((size_t)it.g * T + rowbase + posq) * 4 + it.head] = mx + __logf(den);
        LDS_BARRIER();
    }
#undef ATTN_LOAD
}
}

__device__ __forceinline__ void attn_combine_phase(const Args& a, int gtid, int NGT) {
    const bf16_t* O = (const bf16_t*)(a.ws + WS_S1); const u32x4* SZ = (const u32x4*)(a.ws + WS_S3); u32x4* Y = (u32x4*)(a.ws + WS_S3 + 32 * MiB);
    const float* LSE = (const float*)(a.ws + WS_LSE);
    for (int i = gtid; i < T * 64; i += NGT) {
        const int t = i >> 6, c8 = i & 63, h = c8 >> 4;
        const float l0 = LSE[((size_t)0 * T + t) * 4 + h], l1 = LSE[((size_t)1 * T + t) * 4 + h], l2 = LSE[((size_t)2 * T + t) * 4 + h];
        const float m = fmaxf(l0, fmaxf(l1, l2));
        float w0 = __expf(l0 - m), w1 = __expf(l1 - m), w2 = __expf(l2 - m);
        const float inv = __builtin_amdgcn_rcpf(w0 + w1 + w2); w0 *= inv; w1 *= inv; w2 *= inv;
        const u32x4 o0 = *(const u32x4*)(O + (size_t)t * 1536 + c8 * 8), o1 = *(const u32x4*)(O + (size_t)t * 1536 + 512 + c8 * 8), o2 = *(const u32x4*)(O + (size_t)t * 1536 + 1024 + c8 * 8);
        const u32x4 z = SZ[i];
        const unsigned a0[4] = {o0.x, o0.y, o0.z, o0.w}, a1[4] = {o1.x, o1.y, o1.z, o1.w}, a2[4] = {o2.x, o2.y, o2.z, o2.w}, zz[4] = {z.x, z.y, z.z, z.w};
        unsigned ow[4];
#pragma unroll
        for (int e = 0; e < 4; ++e) {
            const float lo = (w0 * bf_lo(a0[e]) + w1 * bf_lo(a1[e]) + w2 * bf_lo(a2[e])) * bf_lo(zz[e]);
            const float hi = (w0 * bf_hi(a0[e]) + w1 * bf_hi(a1[e]) + w2 * bf_hi(a2[e])) * bf_hi(zz[e]);
            ow[e] = cvt_pk_bf16(lo, hi);
        }
        Y[i] = (u32x4){ow[0], ow[1], ow[2], ow[3]};
    }
}

typedef const __attribute__((address_space(4))) Args* KArgs;
#define LOADARGS(name) Args name; { KArgs _k = kp; asm volatile("" : "+s"(_k)); name = *_k; }

__global__ void __launch_bounds__(NTHR, 2) fwd_megakernel(Args args_unused) {
#if defined(__HIP_DEVICE_COMPILE__)
    extern __shared__ __attribute__((aligned(16))) unsigned char lds_raw[];
    LAS unsigned char* lds = (LAS unsigned char*)lds_raw;
    KArgs kp = (KArgs)__builtin_amdgcn_kernarg_segment_ptr();
    const int G = gridDim.x, bx = blockIdx.x;
    {
        const int tid = threadIdx.x;
        volatile LAS unsigned* MISC0 = (volatile LAS unsigned*)(lds + MISC_OFF);
        if (tid < 64) MISC0[tid] = 0u;
        __syncthreads();
    }
    { LOADARGS(a); (void)xcd_barrier_post((unsigned*)(a.ws + WS_CTL) + CW_BAR, (volatile LAS unsigned*)(lds + MISC_OFF) + 8); }
#define GRID_BAR() do { LOADARGS(a_); XcdBarrier b_; b_.bar = (unsigned*)(a_.ws + WS_CTL) + CW_BAR; b_.x = xb_xcc_id(); b_.st = (volatile LAS unsigned*)(lds + MISC_OFF) + 8; xcd_barrier(b_); } while (0)
#define THREAD_IDS() int tid = threadIdx.x; asm volatile("" : "+v"(tid)); const int lane = tid & 63, wave = __builtin_amdgcn_readfirstlane(tid >> 6); \
    const int vcu = (G % 8 == 0) ? (bx % 8) * (G / 8) + bx / 8 : bx; const int gw = vcu * NWAVES + wave, NGW = G * NWAVES, gtid = vcu * NTHR + tid, NGT = G * NTHR; (void)lane; (void)gw; (void)NGW; (void)gtid; (void)NGT;

#define FILL_RS(S_, ssq_) { THREAD_IDS(); (void)wave; \
        int pm_[4]; _Pragma("unroll") for (int q_ = 0; q_ < 4; ++q_) { pg8::Unit uu_; pm_[q_] = S_.next((tid >> 8) + 2 * q_, uu_) ? uu_.pm : -1; } \
        f32x4 sv_[4][4]; \
        _Pragma("unroll") for (int q_ = 0; q_ < 4; ++q_) { const f32x4* sp_ = (const f32x4*)((ssq_) + (size_t)((pm_[q_] < 0 ? 0 : pm_[q_]) * 256 + (tid & 255)) * 16); \
            _Pragma("unroll") for (int e_ = 0; e_ < 4; ++e_) sv_[q_][e_] = sp_[e_]; } \
        _Pragma("unroll") for (int q_ = 0; q_ < 4; ++q_) { float t_ = 0.f; _Pragma("unroll") for (int e_ = 0; e_ < 4; ++e_) t_ += (sv_[q_][e_].x + sv_[q_][e_].y) + (sv_[q_][e_].z + sv_[q_][e_].w); \
            if (pm_[q_] >= 0) ((LAS float*)(lds + RS_OFF))[((tid >> 8) + 2 * q_) * 256 + (tid & 255)] = rsqrtf(t_ * (1.f / 1024.f) + EPS); } \
        __syncthreads(); }
#define PH_PROLOGUE() { LOADARGS(a); THREAD_IDS(); prologue(a, lds, gw, NGW, lane, wave); }
#define PH_P1A(layer) { \
            { LOADARGS(a); unsigned char* ws = a.ws; \
              pg8::Gemm g{(const bf16_t*)(ws + WS_HB0), (const bf16_t*)(ws + WS_WINA) + (size_t)(layer) * 4096 * 1024, T, 4096, 1024}; \
              pg8::StaticOrder S; S.init(T, 4096, G, bx); \
              pg8::EpiP E{0, (const float*)(ws + WS_SSQ0), ws, nullptr, nullptr, lds}; \
              FILL_RS(S, (const float*)(ws + WS_SSQ0)); \
              pg8::gemm_phase<pg8::EpiP, pg8::StaticOrder, true, true>(lds + RING_OFF, g, S, E); } \
            { LOADARGS(a); THREAD_IDS(); gates_job(a, (layer), (const bf16_t*)(a.ws + WS_HB0), (const float*)(a.ws + WS_SSQ0), gw, NGW, lane); } \
            { LOADARGS(a); THREAD_IDS(); convert_p(a, (layer), gtid, NGT); } }
#define PH_CONV(layer) { LOADARGS(a); THREAD_IDS(); conv_phase(a, (layer), gtid, NGT, gw, NGW, lane); }
#if defined(PROBE_VARIANT) && PROBE_KIND == 2
#define PH_SCAN(layer) { LOADARGS(a); if (pass == 0 && r_ > 0) scan::phase<PROBE_VARIANT>(a, lds, (layer), G); else scan::phase<0>(a, lds, (layer), G); }
#else
#define PH_SCAN(layer) { LOADARGS(a); scan::phase<0>(a, lds, (layer), G); }
#endif
#define PH_NORM() { LOADARGS(a); THREAD_IDS(); mlstm_norm_phase(a, gtid, NGT); }
#define PH_P3A(layer) { \
              LOADARGS(a); unsigned char* ws = a.ws; \
              pg8::Gemm g{(const bf16_t*)(ws + WS_S2), (const bf16_t*)(ws + WS_WOUTA) + (size_t)(layer) * 1024 * 1024, T, 1024, 1024}; \
              pg8::StaticOrder S; S.init(T, 1024, G, bx); \
              LAS float* RT_ = (LAS float*)(lds + 131072); \
              { THREAD_IDS(); int bxl_ = bx; asm volatile("" : "+s"(bxl_)); pg8::StaticOrder S2_; S2_.init(T, 1024, G, bxl_); pg8::Unit u0_, u1_; const bool v0_ = S2_.next(0, u0_), v1_ = S2_.next(1, u1_); const int pm_ = (tid >> 8) ? u1_.pm : u0_.pm; if ((tid >> 8) ? v1_ : v0_) { const float* sp_ = (const float*)(ws + WS_SSQH) + (size_t)(pm_ * 256 + (tid & 255)) * 32; float r_[4]; \
                  _Pragma("unroll") for (int h_ = 0; h_ < 4; ++h_) { const f32x4 s0_ = *(const f32x4*)(sp_ + 8 * h_), s1_ = *(const f32x4*)(sp_ + 8 * h_ + 4); r_[h_] = rsqrtf((((s0_.x + s0_.y) + (s0_.z + s0_.w)) + ((s1_.x + s1_.y) + (s1_.z + s1_.w))) * (1.f / 256.f) + EPS); } \
                  *(LAS f32x4*)(RT_ + (size_t)tid * 4) = (f32x4){r_[0] / r_[1], r_[1] / r_[2], r_[2] / r_[3], r_[3]}; } \
                __syncthreads(); } \
              pg8::EpiF E{0, (const bf16_t*)(ws + WS_HB0), (bf16_t*)(ws + WS_HB1), (float*)(ws + WS_SSQ1), nullptr, nullptr, nullptr, lds}; \
              pg8::gemm_phase<pg8::EpiF, pg8::StaticOrder, true, true, true>(lds + RING_OFF, g, S, E, RT_); }
#define PH_P1B(jl, layer) { \
            { LOADARGS(a); unsigned char* ws = a.ws; \
              const int N = ((jl) == 0) ? 3072 : 2048; \
              pg8::Gemm g{(const bf16_t*)(ws + WS_HB0), (const bf16_t*)(ws + ((jl) == 0 ? WS_WINB0 : WS_WINB1)), T, N, 1024}; \
              pg8::StaticOrder S; S.init(T, N, G, bx); \
              pg8::EpiP E{1, (const float*)(ws + WS_SSQ0), ws, a.qnorm_b + (jl) * 128, a.knorm, lds}; \
              FILL_RS(S, (const float*)(ws + WS_SSQ0)); \
              pg8::gemm_phase<pg8::EpiP, pg8::StaticOrder, true, true>(lds + RING_OFF, g, S, E); } \
            { LOADARGS(a); THREAD_IDS(); convert_p(a, (layer), gtid, NGT); } }
#if defined(PROBE_VARIANT) && PROBE_KIND == 3
#define PH_ATTN(jl) { LOADARGS(a); if (pass == 0 && r_ > 0) attn::phase<PROBE_VARIANT>(a, lds, (jl), G); else attn::phase<0>(a, lds, (jl), G); }
#else
#define PH_ATTN(jl) { LOADARGS(a); attn::phase<0>(a, lds, (jl), G); }
#endif
#define PH_COMBINE() { LOADARGS(a); THREAD_IDS(); attn_combine_phase(a, gtid, NGT); }
#define PH_P3B(jl) { \
              LOADARGS(a); unsigned char* ws = a.ws; \
              pg8::Gemm g{(const bf16_t*)(ws + WS_S3 + 32 * MiB), (const bf16_t*)(ws + WS_WOUTB) + (size_t)(jl) * 1024 * 512, T, 1024, 512}; \
              pg8::StaticOrder S; S.init(T, 1024, G, bx); \
              pg8::EpiF E{0, (const bf16_t*)(ws + WS_HB0), (bf16_t*)(ws + WS_HB1), (float*)(ws + WS_SSQ1), nullptr, nullptr, nullptr, lds}; \
              pg8::gemm_phase<pg8::EpiF, pg8::StaticOrder, true, true>(lds + RING_OFF, g, S, E); }
#define PH_PP(layer) { \
            LOADARGS(a); unsigned char* ws = a.ws; \
            pg8::Gemm g2{(const bf16_t*)(ws + WS_PB), (const bf16_t*)(ws + WS_WPLE) + (size_t)(layer) * 1024 * 256, T, 1024, 256}; \
            pg8::StaticOrder S; S.init(T, 1024, G, bx); \
            pg8::EpiP E2{2, nullptr, ws, nullptr, nullptr, lds}; \
            pg8::gemm_phase<pg8::EpiP, pg8::StaticOrder, true, true>(lds + RING_OFF, g2, S, E2); }
#define PH_P4(layer) { \
            LOADARGS(a); unsigned char* ws = a.ws; \
            pg8::Gemm g{(const bf16_t*)(ws + WS_HB1), (const bf16_t*)(ws + WS_WGATE) + (size_t)(layer) * 1024 * 1024, T, 1024, 1024}; \
            pg8::StaticOrder S; S.init(T, 1024, G, bx); \
            pg8::EpiF E{1, (const bf16_t*)(ws + WS_HB1), (bf16_t*)(ws + WS_HB0), (float*)(ws + WS_SSQ0), (const float*)(ws + WS_SSQ1), (const bf16_t*)(ws + WS_S1), ((layer) == DEPTH - 1) ? a.out : nullptr, lds}; \
            FILL_RS(S, (const float*)(ws + WS_SSQ1)); \
            pg8::gemm_phase<pg8::EpiF, pg8::StaticOrder, true, true>(lds + RING_OFF, g, S, E); }

#if defined(PROBE_KIND)
#define REP(kind) _Pragma("nounroll") for (int r_ = 0; r_ < ((PROBE_KIND == (kind) && pass == 0) ? PROBE_REPS : 1); ++r_)
#define LASTBAR() GRID_BAR()
#pragma nounroll
    for (int pass = 0; pass < 2; ++pass) {
#else
#define REP(kind)
#define LASTBAR() if (layer < DEPTH - 1) GRID_BAR()
    {
#endif
    REP(1) { PH_PROLOGUE(); GRID_BAR(); }
#define LAYER_A(layer) { \
        REP(4) { PH_P1A(layer); GRID_BAR(); } \
        REP(12) { PH_CONV(layer); GRID_BAR(); } \
        REP(2) { PH_SCAN(layer); GRID_BAR(); } \
        REP(9) { PH_P3A(layer); } \
        REP(8) { PH_PP(layer); } \
        GRID_BAR(); \
        REP(5) { PH_P4(layer); GRID_BAR(); } }
#define LAYER_B(jl, layer, last) { \
        REP(11) { PH_P1B(jl, layer); GRID_BAR(); } \
        REP(3) { PH_ATTN(jl); GRID_BAR(); } \
        REP(7) { PH_COMBINE(); GRID_BAR(); } \
        REP(10) { PH_P3B(jl); } \
        REP(8) { PH_PP(layer); } \
        GRID_BAR(); \
        REP(5) { PH_P4(layer); if (!(last)) GRID_BAR(); } }
    LAYER_A(0);
    LAYER_A(1);
    LAYER_B(0, 2, false);
#if defined(PROBE_KIND)
    LAYER_B(1, 3, false);
#else
    LAYER_B(1, 3, true);
#endif
    }
#endif
}

extern "C" void kernel_launch(void* const* d_in, const int* in_sizes, int n_in, void* d_out, int out_size, void* d_ws, size_t ws_size, hipStream_t stream) {
    static int grid = 0;
    if (grid == 0) {
        if (n_in != 18 || in_sizes[0] != T * D || out_size != T * D || ws_size < WS_END) { fprintf(stderr, "kernel_launch: unexpected shapes (n_in %d, in0 %d, out %d, ws %zu)\n", n_in, n_in > 0 ? in_sizes[0] : -1, out_size, ws_size); grid = -1; return; }
        int dev = 0, cus = 0, per_cu = 0;
        if (hipGetDevice(&dev) != hipSuccess || hipDeviceGetAttribute(&cus, hipDeviceAttributeMultiprocessorCount, dev) != hipSuccess) { fprintf(stderr, "kernel_launch: device query failed\n"); grid = -1; return; }
        if (hipFuncSetAttribute((const void*)fwd_megakernel, hipFuncAttributeMaxDynamicSharedMemorySize, LDS_BYTES) != hipSuccess) { fprintf(stderr, "kernel_launch: hipFuncSetAttribute failed\n"); grid = -1; return; }
        if (hipOccupancyMaxActiveBlocksPerMultiprocessor(&per_cu, (const void*)fwd_megakernel, NTHR, LDS_BYTES) != hipSuccess || per_cu < 1)
            fprintf(stderr, "kernel_launch: note: occupancy query reports %d workgroups per CU\n", per_cu);
        (void)hipGetLastError();
        grid = cus;
        if (grid > 256) grid = 256;
    }
    if (grid < 0) return;
    if (hipMemsetAsync((char*)d_ws + WS_CTL, 0, CTL_ZERO_BYTES, stream) != hipSuccess) { fprintf(stderr, "kernel_launch: memset failed\n"); return; }
    Args a{};
    a.x = (const float*)d_in[0]; a.p = (const float*)d_in[1]; a.norm_a = (const float*)d_in[2]; a.w_in_a = (const float*)d_in[3]; a.conv_a = (const float*)d_in[4];
    a.b_gate_a = (const float*)d_in[5]; a.hnorm_a = (const float*)d_in[6]; a.w_out_a = (const float*)d_in[7]; a.norm_kv = (const float*)d_in[8]; a.w_kv = (const float*)d_in[9];
    a.knorm = (const float*)d_in[10]; a.norm_b = (const float*)d_in[11]; a.w_in_b = (const float*)d_in[12]; a.qnorm_b = (const float*)d_in[13]; a.w_out_b = (const float*)d_in[14];
    a.ple_norm = (const float*)d_in[15]; a.w_ple_gate = (const float*)d_in[16]; a.w_ple = (const float*)d_in[17];
    a.out = (float*)d_out; a.ws = (unsigned char*)d_ws;
    hipLaunchKernelGGL(fwd_megakernel, dim3(grid), dim3(NTHR), LDS_BYTES, stream, a);
    const hipError_t le = hipPeekAtLastError();
    if (le != hipSuccess) fprintf(stderr, "kernel_launch: launch failed: %s\n", hipGetErrorName(le));
}
```
